# Optimizing an MI355X kernel written in HIP

```python
import jax, jax.numpy as jnp
from jax import lax
import numpy as np

D_MODEL = 1024
BATCH = 8
SEQ = 4096
DEPTH = 1

POOL_WINDOWS = (2, 4, 8, 16)
N_POOL_GROUPS = len(POOL_WINDOWS)
POOL_WIDTH = D_MODEL
POOL_GROUP = POOL_WIDTH // N_POOL_GROUPS
HEAD_DIM = 64
N_Q_HEADS = D_MODEL // HEAD_DIM
N_KV_HEADS = 2
GQA_GROUP = N_Q_HEADS // N_KV_HEADS
WINDOW = 128
BLOCK = 128
ROPE_DIM = HEAD_DIM // 4
ROPE_THETA = 500000.0
Q_WIDTH = N_Q_HEADS * HEAD_DIM
KV_WIDTH = N_KV_HEADS * HEAD_DIM
D_FF = 2816
CONV_WIDTH = 3
EPS = 1e-6
IN_WIDTH = POOL_WIDTH + Q_WIDTH + 2 * KV_WIDTH + 2 * D_MODEL

kernel_name = "hybrid_pool_swa_sink_convglu_block"


def rmsnorm(x, g):
    xf = x.astype(jnp.float32)
    r = lax.rsqrt(jnp.mean(xf * xf, axis=-1, keepdims=True) + EPS)
    return (xf * r * g.astype(jnp.float32)).astype(x.dtype)


def partial_rope(x, positions):
    half = ROPE_DIM // 2
    inv_freq = ROPE_THETA ** (-jnp.arange(0, ROPE_DIM, 2, dtype=jnp.float32) / ROPE_DIM)
    ang = positions.astype(jnp.float32)[..., None] * inv_freq
    cos = jnp.cos(ang)[:, :, None, :]
    sin = jnp.sin(ang)[:, :, None, :]
    xf = x.astype(jnp.float32)
    x1, x2, xp = xf[..., :half], xf[..., half:ROPE_DIM], xf[..., ROPE_DIM:]
    out = jnp.concatenate([x1 * cos - x2 * sin, x2 * cos + x1 * sin, xp], axis=-1)
    return out.astype(x.dtype)


def pool_mixer(u, w_pool, pool_scale):
    B, S, _ = u.shape
    ug = u.reshape(B, S, N_POOL_GROUPS, POOL_GROUP).astype(jnp.float32)
    cs = jnp.cumsum(ug, axis=1)
    t = jnp.arange(S, dtype=jnp.float32)
    pooled = []
    for g, w in enumerate(POOL_WINDOWS):
        csg = cs[:, :, g]
        shifted = jnp.pad(csg, ((0, 0), (w, 0), (0, 0)))[:, :S]
        count = jnp.minimum(t + 1.0, float(w))[None, :, None]
        pooled.append((csg - shifted) / count)
    pooled = jnp.stack(pooled, axis=2) - ug
    mixed = jnp.einsum('bsgc,gcd->bsgd', pooled.astype(u.dtype), w_pool)
    return mixed.reshape(B, S, POOL_WIDTH) * pool_scale


def swa_sink_attention(q, k, v, sinks):
    B, S = q.shape[0], q.shape[1]
    nb = S // BLOCK
    qb = q.reshape(B, nb, BLOCK, N_KV_HEADS, GQA_GROUP, HEAD_DIM)

    def band(t):
        tb = t.reshape(B, nb, BLOCK, N_KV_HEADS, HEAD_DIM)
        prev = jnp.pad(tb, ((0, 0), (1, 0), (0, 0), (0, 0), (0, 0)))[:, :-1]
        return jnp.concatenate([prev, tb], axis=2)

    kb, vb = band(k), band(v)
    s = jnp.einsum('bnqhgd,bnkhd->bhgnqk', qb, kb,
                   preferred_element_type=jnp.float32)
    q_pos = jnp.arange(BLOCK)[:, None] + BLOCK
    k_pos = jnp.arange(2 * BLOCK)[None, :]
    rel_ok = (k_pos <= q_pos) & (q_pos - k_pos < WINDOW)
    blk_ok = (jnp.arange(nb)[:, None, None] > 0) | (k_pos[None] >= BLOCK)
    mask = rel_ok[None] & blk_ok
    s = jnp.where(mask, s, -jnp.inf)
    sink = sinks.astype(jnp.float32).reshape(1, N_KV_HEADS, GQA_GROUP, 1, 1, 1)
    m = jnp.maximum(jnp.max(s, axis=-1, keepdims=True), sink)
    p = jnp.exp(s - m)
    denom = jnp.sum(p, axis=-1, keepdims=True) + jnp.exp(sink - m)
    probs = (p / denom).astype(v.dtype)
    out = jnp.einsum('bhgnqk,bnkhd->bnqhgd', probs, vb)
    return out.reshape(B, S, Q_WIDTH)


def causal_depthwise_conv(u, w, b):
    S = u.shape[1]
    up = jnp.pad(u, ((0, 0), (CONV_WIDTH - 1, 0), (0, 0)))
    y = b
    for j in range(CONV_WIDTH):
        y = y + w[j] * up[:, j:j + S]
    return y


def setup_inputs(seed: int = 0) -> dict:
    key = jax.random.key(seed)
    ks = jax.random.split(key, 18)
    f32 = jnp.float32
    nrm = lambda k, shape, s: jax.random.normal(k, shape, f32) * s
    x = jax.random.normal(ks[0], (BATCH, SEQ, D_MODEL), f32)
    offsets = jax.random.randint(ks[1], (BATCH, 1), 0, 1024, dtype=jnp.int32)
    positions = offsets + jnp.arange(SEQ, dtype=jnp.int32)[None, :]
    return {
        "x": x,
        "positions": positions,
        "attn_norm": 1.0 + nrm(ks[2], (DEPTH, D_MODEL), 0.05),
        "w_in": nrm(ks[3], (DEPTH, D_MODEL, IN_WIDTH), D_MODEL ** -0.5),
        "b_gate": nrm(ks[4], (DEPTH, 2 * D_MODEL), 0.1),
        "w_pool": nrm(ks[5], (DEPTH, N_POOL_GROUPS, POOL_GROUP, POOL_GROUP), POOL_GROUP ** -0.5),
        "pool_scale": 1.0 + nrm(ks[6], (DEPTH, POOL_WIDTH), 0.1),
        "q_norm": 1.0 + nrm(ks[7], (DEPTH, HEAD_DIM), 0.05),
        "k_norm": 1.0 + nrm(ks[8], (DEPTH, HEAD_DIM), 0.05),
        "sinks": nrm(ks[9], (DEPTH, N_Q_HEADS), 0.5),
        "w_out": nrm(ks[10], (DEPTH, D_MODEL, D_MODEL), D_MODEL ** -0.5),
        "ffn_norm": 1.0 + nrm(ks[11], (DEPTH, D_MODEL), 0.05),
        "w_up": nrm(ks[12], (DEPTH, D_MODEL, 2 * D_FF), D_MODEL ** -0.5),
        "conv_w": nrm(ks[13], (DEPTH, CONV_WIDTH, 2 * D_FF), CONV_WIDTH ** -0.5),
        "conv_b": nrm(ks[14], (DEPTH, 2 * D_FF), 0.02),
        "w_down": nrm(ks[15], (DEPTH, D_FF, D_MODEL), D_FF ** -0.5),
    }


def reference(x, positions, attn_norm, w_in, b_gate, w_pool, pool_scale, q_norm, k_norm,
              sinks, w_out, ffn_norm, w_up, conv_w, conv_b, w_down):
    B, S, _ = x.shape
    scale = HEAD_DIM ** -0.5
    for l in range(DEPTH):
        h = rmsnorm(x, attn_norm[l])
        z = h @ w_in[l]
        o1 = POOL_WIDTH
        o2 = o1 + Q_WIDTH
        o3 = o2 + KV_WIDTH
        o4 = o3 + KV_WIDTH
        u_pool = z[..., :o1]
        q = z[..., o1:o2].reshape(B, S, N_Q_HEADS, HEAD_DIM)
        k = z[..., o2:o3].reshape(B, S, N_KV_HEADS, HEAD_DIM)
        v = z[..., o3:o4].reshape(B, S, N_KV_HEADS, HEAD_DIM)
        gates = jax.nn.sigmoid((z[..., o4:] + b_gate[l]).astype(jnp.float32)).astype(x.dtype)
        g_pool, g_attn = gates[..., :D_MODEL], gates[..., D_MODEL:]

        a = pool_mixer(u_pool, w_pool[l], pool_scale[l])

        q = partial_rope(rmsnorm(q, q_norm[l]), positions) * scale
        k = partial_rope(rmsnorm(k, k_norm[l]), positions)
        b = swa_sink_attention(q, k, v, sinks[l])

        x = x + (g_pool * a + g_attn * b) @ w_out[l]

        h = rmsnorm(x, ffn_norm[l])
        up = causal_depthwise_conv(h @ w_up[l], conv_w[l], conv_b[l])
        gate, val = up[..., :D_FF], up[..., D_FF:]
        x = x + (jax.nn.silu(gate) * val) @ w_down[l]
    return x
```

```cpp
#include <hip/hip_runtime.h>
#include <cstdio>
#include <cstdint>
#include <cmath>

#ifndef MK_N_LAUNCHES
#define MK_N_LAUNCHES 0
#endif

constexpr int DM = 1024, NBATCH = 8, SEQ = 4096, M = NBATCH * SEQ;
constexpr int NIN = 4352, DFF = 2816, NUP = 2 * DFF;
constexpr int ZQ = 1024, ZK = 2048, ZV = 2176, ZG = 2304;
constexpr float EPS = 1e-6f, LOG2E = 1.4426950408889634f;

#define GAS __attribute__((address_space(1)))
#define LAS __attribute__((address_space(3)))
typedef unsigned short bf16_t;
typedef unsigned v4u __attribute__((ext_vector_type(4)));
typedef float f32x4 __attribute__((ext_vector_type(4)));
typedef short bf16x8 __attribute__((ext_vector_type(8)));
typedef GAS unsigned gu32;
#define RLX_AGENT __ATOMIC_RELAXED, __HIP_MEMORY_SCOPE_AGENT
#define LDS_WAIT() asm volatile("s_waitcnt lgkmcnt(0)" ::: "memory")
#define VM_WAIT() asm volatile("s_waitcnt vmcnt(0)" ::: "memory")

__device__ __forceinline__ unsigned f2bf(float f) { unsigned u = __builtin_bit_cast(unsigned, f); return (u + 0x7fffu + ((u >> 16) & 1u)) >> 16; }
typedef float f32x2_t __attribute__((ext_vector_type(2))); typedef __bf16 bf16x2_t __attribute__((ext_vector_type(2)));
__device__ __forceinline__ unsigned pk2(float lo, float hi) { f32x2_t v = {lo, hi}; bf16x2_t b = __builtin_convertvector(v, bf16x2_t); return __builtin_bit_cast(unsigned, b); }
__device__ __forceinline__ float bflo(unsigned w) { return __uint_as_float(w << 16); }
__device__ __forceinline__ float bfhi(unsigned w) { return __uint_as_float(w & 0xffff0000u); }
__device__ __forceinline__ void unpack8(const v4u w, float (&f)[8]) { f[0] = bflo(w.x); f[1] = bfhi(w.x); f[2] = bflo(w.y); f[3] = bfhi(w.y); f[4] = bflo(w.z); f[5] = bfhi(w.z); f[6] = bflo(w.w); f[7] = bfhi(w.w); }
__device__ __forceinline__ v4u pack8(const float (&f)[8]) { v4u w; w.x = pk2(f[0], f[1]); w.y = pk2(f[2], f[3]); w.z = pk2(f[4], f[5]); w.w = pk2(f[6], f[7]); return w; }
__device__ __forceinline__ float sigmoidf_(float x) { return __builtin_amdgcn_rcpf(1.f + __builtin_amdgcn_exp2f(-x * LOG2E)); }

namespace pg8 {
constexpr int BM = 256, BK = 64, HALF = 128, HTB = HALF * BK * 2, STAGE_BYTES = 8 * HTB, NXCD = 8, WGM = 8;
__host__ __device__ __forceinline__ int lds_byte(int r, int c) { const int st = (r >> 4) * 2 + (c >> 5), rr = r & 15, cc = c & 31, ob = rr * 64 + cc * 2; return st * 1024 + (ob ^ (((ob >> 9) & 1) << 5)); }
__host__ __device__ __forceinline__ void stage_rc(int b, int& R, int& C) { const int st = b / 1024, sb = b % 1024, swz = sb ^ (((sb >> 9) & 1) << 5); R = (st >> 1) * 16 + swz / 64; C = (st & 1) * 32 + (swz % 64) / 2; }
__host__ __device__ __forceinline__ int perm32(int rho) { const int n = rho >> 4, i = rho & 15; return 8 * (i >> 2) + 4 * n + (i & 3); }

struct Unit { const char* a; const char* b; int pm, pn; };
struct Gemm { int lda, ldb, K; size_t hstepA, hstepB; };

struct TileOrder {
    int nM, nN, nwg, G, c; const char* A; const char* B; size_t sA, sB, sApn;
    __device__ void init(int nM_, int nN_, int G_, int c_, const void* A_, const void* B_, size_t sA_, size_t sB_, size_t sApn_) { nM = nM_; nN = nN_; nwg = nM * nN; G = G_; c = c_; A = (const char*)A_; B = (const char*)B_; sA = sA_; sB = sB_; sApn = sApn_; }
    __device__ bool next(int i, Unit& u) const {
        const long L = (long)i * G + c; if (L >= nwg) return false;
        int wgid = (int)L; { const int q = nwg / NXCD, r = nwg % NXCD, xcd = wgid % NXCD, off = wgid / NXCD; wgid = (xcd < r ? xcd * (q + 1) : r * (q + 1) + (xcd - r) * q) + off; }
        const int nig = WGM * nN, gid = wgid / nig, fm = gid * WGM, gsz = (nM - fm) < WGM ? (nM - fm) : WGM;
        u.pm = fm + ((wgid % nig) % gsz); u.pn = (wgid % nig) / gsz;
        u.a = A + (size_t)u.pm * sA + (size_t)u.pn * sApn; u.b = B + (size_t)u.pn * sB; return true;
    }
};

template <int BMODE> __device__ __forceinline__ int mapB(int R) { return BMODE == 1 ? ((R & ~31) + perm32(R & 31)) : R; }

template <class Epi, class Sched, bool ALIGN_EPI>
__device__ __forceinline__ void gemm_phase(LAS unsigned char* lds, const Gemm g, const Sched& S, const Epi& E) {
    const int tid = threadIdx.x, wid = __builtin_amdgcn_readfirstlane(tid >> 6), lane = tid & 63, wr = wid >> 2, wc = wid & 3, fr = lane & 15, fq = lane >> 4;
    const int nt = g.K / BK;
    unsigned voffA[2], voffB[2];
#pragma unroll
    for (int i = 0; i < 2; ++i) { int R, C; stage_rc(tid * 16 + i * 8192, R, C); const int Rb = mapB<Epi::BMODE>(R);
        voffA[i] = (unsigned)(R * g.lda + C) * 2u; voffB[i] = (unsigned)(Rb * g.ldb + C) * 2u; }
    const size_t kstep = (size_t)(BK * 2);
    const size_t hstepA = g.hstepA, hstepB = g.hstepB;
    const unsigned ldsw = (unsigned)wid * 1024u;
    const int aoff = lds_byte(wr * 64 + fr, fq * 8), boff = lds_byte(wc * 32 + fr, fq * 8);
#define PG8_SA(b, h) (((b) * 2 + (h)) * HTB)
#define PG8_SB(b, h) ((4 + (b) * 2 + (h)) * HTB)
#define PG8_STAGE(bufoff, gbase, voff) do { _Pragma("unroll") for (int _i = 0; _i < 2; ++_i) \
        __builtin_amdgcn_global_load_lds((const unsigned*)((const char*)(gbase) + (voff)[_i]), (LAS unsigned*)(lds + (bufoff) + ldsw + _i * 8192), 16, 0, 0); } while (0)
#define PG8_LDA(dst, b, h) do { _Pragma("unroll") for (int m = 0; m < 4; ++m) _Pragma("unroll") for (int k = 0; k < 2; ++k) dst[m][k] = *(const LAS bf16x8*)(lds + PG8_SA(b, h) + aoff + m * 2048 + k * 1024); } while (0)
#define PG8_LDB(dst, b, h) do { _Pragma("unroll") for (int n = 0; n < 2; ++n) _Pragma("unroll") for (int k = 0; k < 2; ++k) dst[n][k] = *(const LAS bf16x8*)(lds + PG8_SB(b, h) + boff + n * 2048 + k * 1024); } while (0)
#define PG8_MMA(ai, bj, At, Bt) do { __builtin_amdgcn_s_setprio(1); _Pragma("unroll") for (int m = 0; m < 4; ++m) _Pragma("unroll") for (int n = 0; n < 2; ++n) _Pragma("unroll") for (int k = 0; k < 2; ++k) \
        acc[ai][bj][m][n] = __builtin_amdgcn_mfma_f32_16x16x32_bf16(Bt[n][k], At[m][k], acc[ai][bj][m][n], 0, 0, 0); __builtin_amdgcn_s_setprio(0); } while (0)
#define PG8_WAIT_V(n) asm volatile("s_waitcnt vmcnt(" #n ")" ::: "memory")
#define PG8_WAIT_L(n) asm volatile("s_waitcnt lgkmcnt(" #n ")" ::: "memory")
#define PG8_BAR __builtin_amdgcn_s_barrier()
#define PG8_SCHED __builtin_amdgcn_sched_barrier(0)
    Unit cur, nxt; int ui = 0;
    if (!S.next(0, cur)) return;
    f32x4 acc[2][2][4][2];
#pragma unroll
    for (int a = 0; a < 2; ++a)
#pragma unroll
        for (int b = 0; b < 2; ++b)
#pragma unroll
            for (int m = 0; m < 4; ++m)
#pragma unroll
                for (int n = 0; n < 2; ++n) acc[a][b][m][n] = (f32x4){0.f, 0.f, 0.f, 0.f};
    bf16x8 At[4][2], B0[2][2], B1[2][2];
    const char* cA = cur.a; const char* cB = cur.b;
    PG8_STAGE(PG8_SB(0, 0), cB, voffB); PG8_STAGE(PG8_SB(0, 1), cB + hstepB, voffB); PG8_STAGE(PG8_SA(0, 0), cA, voffA); PG8_STAGE(PG8_SA(0, 1), cA + hstepA, voffA);
    if (wr == 1) PG8_BAR;
    PG8_WAIT_V(2); PG8_BAR;
    PG8_STAGE(PG8_SB(1, 0), cB + kstep, voffB); PG8_STAGE(PG8_SA(1, 0), cA + kstep, voffA); PG8_STAGE(PG8_SB(1, 1), cB + hstepB + kstep, voffB);
    PG8_WAIT_V(6); PG8_BAR;
    for (;;) {
        const bool has_next = S.next(ui + 1, nxt);
        const char* nA = has_next ? nxt.a : cA; const char* nB = has_next ? nxt.b : cB;
        for (int t = 0; t < nt; t += 2) {
            const bool last = (t == nt - 2);
            const char* a1 = cA + (size_t)(t + 1) * kstep;
            const char* a2 = last ? nA : cA + (size_t)(t + 2) * kstep; const char* b2 = last ? nB : cB + (size_t)(t + 2) * kstep;
            const char* a3 = a2 + kstep; const char* b3 = b2 + kstep;
            PG8_LDB(B0, 0, 0); PG8_LDB(B1, 0, 1); PG8_SCHED; PG8_LDA(At, 0, 0); PG8_STAGE(PG8_SA(1, 1), a1 + hstepA, voffA);
            PG8_WAIT_V(8); PG8_WAIT_L(0); PG8_BAR; PG8_MMA(0, 0, At, B0); PG8_MMA(0, 1, At, B1); PG8_BAR; PG8_SCHED;
            PG8_LDA(At, 0, 1); PG8_STAGE(PG8_SB(0, 0), b2, voffB); PG8_STAGE(PG8_SB(0, 1), b2 + hstepB, voffB); PG8_STAGE(PG8_SA(0, 0), a2, voffA);
            PG8_WAIT_V(8); PG8_WAIT_L(0); PG8_BAR; PG8_MMA(1, 0, At, B0); PG8_MMA(1, 1, At, B1); PG8_BAR; PG8_SCHED;
            PG8_LDB(B0, 1, 0); PG8_LDB(B1, 1, 1); PG8_SCHED; PG8_LDA(At, 1, 0); PG8_STAGE(PG8_SA(0, 1), a2 + hstepA, voffA);
            PG8_WAIT_V(8); PG8_WAIT_L(0); PG8_BAR; PG8_MMA(0, 0, At, B0); PG8_MMA(0, 1, At, B1); PG8_BAR; PG8_SCHED;
            PG8_LDA(At, 1, 1); PG8_STAGE(PG8_SB(1, 0), b3, voffB); PG8_STAGE(PG8_SB(1, 1), b3 + hstepB, voffB); PG8_STAGE(PG8_SA(1, 0), a3, voffA);
            PG8_WAIT_V(8); PG8_WAIT_L(0); PG8_BAR; PG8_MMA(1, 0, At, B0); PG8_MMA(1, 1, At, B1); PG8_BAR; PG8_SCHED;
        }
        if constexpr (ALIGN_EPI) { if (wr == 0) PG8_BAR; }
        E(acc, cur, wr, wc, fr, fq);
        if (!has_next) break;
#pragma unroll
        for (int a = 0; a < 2; ++a)
#pragma unroll
            for (int b = 0; b < 2; ++b)
#pragma unroll
                for (int m = 0; m < 4; ++m)
#pragma unroll
                    for (int n = 0; n < 2; ++n) acc[a][b][m][n] = (f32x4){0.f, 0.f, 0.f, 0.f};
        cur = nxt; cA = nA; cB = nB; ++ui;
        if constexpr (ALIGN_EPI) { if (wr == 1) PG8_BAR; }
    }
    PG8_WAIT_V(0);
    if constexpr (!ALIGN_EPI) { if (wr == 0) PG8_BAR; }
    PG8_BAR;
#undef PG8_SA
#undef PG8_SB
#undef PG8_STAGE
#undef PG8_LDA
#undef PG8_LDB
#undef PG8_MMA
#undef PG8_WAIT_V
#undef PG8_WAIT_L
#undef PG8_BAR
#undef PG8_SCHED
}

struct EpiStore {
    static constexpr int BMODE = 1;
    bf16_t* O; int ldc; const float* rs;
    __device__ __forceinline__ void operator()(const f32x4 (&acc)[2][2][4][2], const Unit& u, int wr, int wc, int fr, int fq) const {
        const int row0 = u.pm * BM + wr * 64 + fr, col0 = u.pn * BM + wc * 32 + 8 * fq;
#pragma unroll
        for (int ai = 0; ai < 2; ++ai)
#pragma unroll
            for (int m = 0; m < 4; ++m) { const int row = row0 + ai * HALF + m * 16; const float s = rs ? rs[row] : 1.f; bf16_t* rowp = O + (size_t)row * ldc + col0;
#pragma unroll
                for (int bj = 0; bj < 2; ++bj) { const f32x4 v0 = acc[ai][bj][m][0] * s, v1 = acc[ai][bj][m][1] * s;
                    v4u w; w.x = pk2(v0[0], v0[1]); w.y = pk2(v0[2], v0[3]); w.z = pk2(v1[0], v1[1]); w.w = pk2(v1[2], v1[3]);
                    *(v4u*)(rowp + bj * HALF) = w; } }
    }
};
struct EpiRes {
    static constexpr int BMODE = 0;
    const float* base; float* out; int ldc;
    __device__ __forceinline__ void operator()(const f32x4 (&acc)[2][2][4][2], const Unit& u, int wr, int wc, int fr, int fq) const {
        const int row0 = u.pm * BM + wr * 64 + fr, col0 = u.pn * BM + wc * 32 + 4 * fq;
#pragma unroll
        for (int ai = 0; ai < 2; ++ai)
#pragma unroll
            for (int m = 0; m < 4; ++m) { const size_t off = (size_t)(row0 + ai * HALF + m * 16) * ldc + col0;
#pragma unroll
                for (int bj = 0; bj < 2; ++bj)
#pragma unroll
                    for (int n = 0; n < 2; ++n) { const f32x4 b = *(const f32x4*)(base + off + bj * HALF + n * 16); *(f32x4*)(out + off + bj * HALF + n * 16) = b + acc[ai][bj][m][n]; } }
    }
};
}

constexpr int NWAVES = 8, NTHR = NWAVES * 64;
constexpr int N_PHASES = 13;
constexpr size_t MiB = 1u << 20;
constexpr size_t WS_CTL = 0, CTL_ZERO_BYTES = 1 * MiB;
constexpr size_t WS_R1 = 1 * MiB, WS_R2 = WS_R1 + 256 * 1024;
constexpr size_t WS_TAB = 2 * MiB;
constexpr size_t WS_WIN = 4 * MiB, WS_WP = 13 * MiB, WS_WO = 14 * MiB, WS_WU = 16 * MiB, WS_WD = 28 * MiB;
constexpr size_t WS_XB = 34 * MiB;
constexpr size_t WS_Z = 98 * MiB;
constexpr size_t WS_UP = WS_Z, WS_HACT = WS_Z + 176 * MiB;
constexpr size_t WS_B = 370 * MiB;
constexpr size_t WS_AP = 434 * MiB;
constexpr size_t WS_END = 498 * MiB;
static_assert(WS_WIN + (size_t)NIN * DM * 2 <= WS_WP && WS_WU + (size_t)NUP * DM * 2 <= WS_WD && WS_WD + (size_t)DM * DFF * 2 <= WS_XB, "weights map");
static_assert(WS_Z + (size_t)M * NIN * 2 <= WS_B && WS_HACT + (size_t)M * DFF * 2 <= WS_END && (size_t)(M / 2) * NUP * 2 <= 176 * MiB, "activation map");
constexpr int CW_BAR = 4096;
constexpr int RING_BYTES = 131072, LDSCTL_OFF = RING_BYTES, MISC_OFF = LDSCTL_OFF + 320, LDS_BYTES = 147456;

#define XB_TMO      128
#define XB_XCNT(j)  (256  + 64 * (j))
#define XB_XSUB(j)  (1280 + 64 * (j))
#define XB_XGEN(j)  (2304 + 64 * (j))
#define XB_TOP      3328
#define XB_TOPGEN   3392
#define XCD_BAR_WORDS 3456
#define XB_SPIN_CAP (1u << 18)
__device__ __forceinline__ unsigned xb_ld(unsigned* p)              { return __hip_atomic_load(p, __ATOMIC_RELAXED, __HIP_MEMORY_SCOPE_AGENT); }
__device__ __forceinline__ unsigned xb_add(unsigned* p, unsigned v) { return __hip_atomic_fetch_add(p, v, __ATOMIC_RELAXED, __HIP_MEMORY_SCOPE_AGENT); }
__device__ __forceinline__ unsigned xb_xcc_id() { return (unsigned)__builtin_amdgcn_s_getreg((3 << 11) | 20) & 0xFu; }
#define XB_SPIN(cond, bar) do { unsigned _sp = 0; while (cond) { __builtin_amdgcn_s_sleep(1); \
    if ((++_sp & 255u) == 0u) { if (xb_ld(&(bar)[XB_TMO])) break; if (_sp > XB_SPIN_CAP) { atomicAdd(&(bar)[XB_TMO], 1u); break; } } } } while (0)
struct XcdBarrier { unsigned* bar; unsigned x; volatile LAS unsigned* st; };
__device__ __forceinline__ XcdBarrier xcd_barrier_post(unsigned* bar, volatile LAS unsigned* st) {
    XcdBarrier b; b.bar = bar; b.x = xb_xcc_id(); b.st = st;
    if (threadIdx.x == 0) (void)xb_add(&bar[XB_XCNT(b.x)], 1u);
    return b;
}
__device__ __forceinline__ void xcd_barrier_complete(unsigned* bar, unsigned x, unsigned& nloc, unsigned& nx) {
    const unsigned G = gridDim.x * gridDim.y * gridDim.z;
    unsigned sum, cnt, mine, sp = 0u;
    for (;;) {
        sum = 0u; cnt = 0u; mine = 0u;
#pragma unroll
        for (unsigned j = 0; j < 16; ++j) { const unsigned c = xb_ld(&bar[XB_XCNT(j)]); sum += c; cnt += (c > 0u) ? 1u : 0u; mine = (j == x) ? c : mine; }
        if (sum == G) break;
        __builtin_amdgcn_s_sleep(1);
        if ((++sp & 255u) == 0u) { if (xb_ld(&bar[XB_TMO])) break; if (sp > XB_SPIN_CAP) { atomicAdd(&bar[XB_TMO], 1u); break; } }
    }
    nloc = mine > 0u ? mine : 1u; nx = cnt > 0u ? cnt : 1u;
}
__device__ __forceinline__ void xcd_barrier(const XcdBarrier& b) {
    asm volatile("s_waitcnt vmcnt(0)" ::: "memory");
    __syncthreads();
    if (threadIdx.x == 0) {
        unsigned* bar = b.bar;
        __builtin_amdgcn_s_waitcnt(0);
        unsigned nloc = b.st[0], nx = b.st[1];
        if (nloc == 0u) { xcd_barrier_complete(bar, b.x, nloc, nx); b.st[0] = nloc; b.st[1] = nx; }
        const unsigned old = xb_add(&bar[XB_XSUB(b.x)], 1u);
        const unsigned gen = old / nloc;
        if (old + 1u == (gen + 1u) * nloc) {
            __builtin_amdgcn_fence(__ATOMIC_RELEASE, "agent");
            asm volatile("s_waitcnt vmcnt(0)" ::: "memory");
            const unsigned og = xb_add(&bar[XB_TOP], 1u);
            const unsigned tg = og / nx;
            if (og + 1u == (tg + 1u) * nx) xb_add(&bar[XB_TOPGEN], 1u);
            else XB_SPIN(xb_ld(&bar[XB_TOPGEN]) == tg, bar);
            __builtin_amdgcn_fence(__ATOMIC_ACQUIRE, "agent");
            xb_add(&bar[XB_XGEN(b.x)], 1u);
            asm volatile("s_waitcnt vmcnt(0)" ::: "memory");
        } else {
            XB_SPIN(xb_ld(&bar[XB_XGEN(b.x)]) == gen, bar);
            __builtin_amdgcn_fence(__ATOMIC_ACQUIRE, "agent");
            asm volatile("s_waitcnt vmcnt(0)" ::: "memory");
        }
    }
    __syncthreads();
}

struct Frame {
    LAS unsigned char* lds; volatile LAS unsigned* MISC; gu32* ctl;
    int tid, lane, wave, vcu, G;
};
__device__ __forceinline__ float wave_sum(float v) {
#pragma unroll
    for (int o = 1; o < 64; o <<= 1) v += __shfl_xor(v, o);
    return v;
}

__device__ __forceinline__ void p0_transpose_item(const float* W, int K, int N, bf16_t* WT, const float* kscale, const float* nscale, LAS float* scr, int item, int lane) {
    const int nblk = N / 32, kb = item / nblk, nb = item % nblk, k0 = 64 * kb, n0 = 32 * nb;
    const float ns = nscale ? nscale[n0 + (lane & 31)] : 1.f;
#pragma unroll 8
    for (int i = 0; i < 32; ++i) { const int kk = 2 * i + (lane >> 5); const float ks = kscale ? kscale[k0 + kk] : 1.f; scr[kk * 33 + (lane & 31)] = W[(size_t)(k0 + kk) * N + n0 + (lane & 31)] * ks * ns; }
    LDS_WAIT(); asm volatile("" ::: "memory");
    const int c = lane & 7;
#pragma unroll
    for (int j = 0; j < 4; ++j) { const int n = (lane >> 3) + 8 * j; const LAS float* s = scr + (8 * c) * 33 + n;
        v4u o; o.x = pk2(s[0 * 33], s[1 * 33]); o.y = pk2(s[2 * 33], s[3 * 33]); o.z = pk2(s[4 * 33], s[5 * 33]); o.w = pk2(s[6 * 33], s[7 * 33]);
        *(GAS v4u*)(WT + (size_t)(n0 + n) * K + k0 + 8 * c) = o; }
    LDS_WAIT(); asm volatile("" ::: "memory");
}
__device__ __forceinline__ void row_bf16_rs(int lane, const float* xrow, bf16_t* orow, float* rs) {
    const GAS f32x4* xr = (const GAS f32x4*)xrow + lane;
    f32x4 v[4]; float s = 0.f;
#pragma unroll
    for (int j = 0; j < 4; ++j) { v[j] = xr[64 * j]; s += (v[j].x * v[j].x + v[j].y * v[j].y) + (v[j].z * v[j].z + v[j].w * v[j].w); }
    s = wave_sum(s);
    if (lane == 0) *rs = 1.f / sqrtf(s * (1.f / DM) + EPS);
    GAS unsigned long long* o8 = (GAS unsigned long long*)orow + lane;
#pragma unroll
    for (int j = 0; j < 4; ++j) o8[64 * j] = (unsigned long long)pk2(v[j].x, v[j].y) | ((unsigned long long)pk2(v[j].z, v[j].w) << 32);
}

struct Args { const void* in[16]; float* out; unsigned char* ws; double invf[8]; int ph_lo, ph_hi, li, pad; };

__global__ void __launch_bounds__(NTHR, 2) mega_fwd(Args args) {
    extern __shared__ __attribute__((aligned(16))) unsigned char lds[];
    Frame F;
    F.lds = (LAS unsigned char*)lds;
    F.MISC = (volatile LAS unsigned*)(F.lds + MISC_OFF);
    F.tid = threadIdx.x; F.lane = F.tid & 63; F.wave = __builtin_amdgcn_readfirstlane(F.tid >> 6);
    F.G = gridDim.x; { const int bx = blockIdx.x; F.vcu = (F.G % 8 == 0) ? (bx % 8) * (F.G / 8) + bx / 8 : bx; }
    unsigned char* ws = args.ws;
    F.ctl = (gu32*)(ws + WS_CTL);
    const float* x = (const float*)args.in[0]; const int* positions = (const int*)args.in[1]; const float* attn_norm = (const float*)args.in[2];
    const float* w_in = (const float*)args.in[3]; const float* b_gate = (const float*)args.in[4]; const float* w_pool = (const float*)args.in[5];
    const float* pool_scale = (const float*)args.in[6]; const float* q_norm = (const float*)args.in[7]; const float* k_norm = (const float*)args.in[8];
    const float* sinks = (const float*)args.in[9]; const float* w_out = (const float*)args.in[10]; const float* ffn_norm = (const float*)args.in[11];
    const float* w_up = (const float*)args.in[12]; const float* conv_w = (const float*)args.in[13]; const float* conv_b = (const float*)args.in[14];
    const float* w_down = (const float*)args.in[15];
    float* out = args.out;
    float* R1 = (float*)(ws + WS_R1); float* R2 = (float*)(ws + WS_R2); float* TAB = (float*)(ws + WS_TAB);
    bf16_t* Win_t = (bf16_t*)(ws + WS_WIN); bf16_t* Wp_t = (bf16_t*)(ws + WS_WP); bf16_t* Wo_t = (bf16_t*)(ws + WS_WO); bf16_t* Wu_t = (bf16_t*)(ws + WS_WU); bf16_t* Wd_t = (bf16_t*)(ws + WS_WD);
    bf16_t* XB = (bf16_t*)(ws + WS_XB); bf16_t* Z = (bf16_t*)(ws + WS_Z); bf16_t* UP = (bf16_t*)(ws + WS_UP); bf16_t* HACT = (bf16_t*)(ws + WS_HACT);
    bf16_t* BO = (bf16_t*)(ws + WS_B); bf16_t* AP = (bf16_t*)(ws + WS_AP);

    for (int u = F.tid; u < (LDS_BYTES - LDSCTL_OFF) / 4; u += NTHR) ((LAS unsigned*)(F.lds + LDSCTL_OFF))[u] = 0u;
    __syncthreads();
    XcdBarrier bar; bar.bar = (unsigned*)(F.ctl + CW_BAR); bar.x = 0; bar.st = nullptr;
    if (MK_N_LAUNCHES == 1) bar = xcd_barrier_post((unsigned*)(F.ctl + CW_BAR), F.MISC + 8);
#define GRID_BAR() do { if (MK_N_LAUNCHES == 1) xcd_barrier(bar); } while (0)
    const int lo = args.ph_lo, hi = args.ph_hi;
#define IN(k) (lo <= (k) && (k) < hi)
#define BOTH(k) (IN(k) && IN((k) + 1))
    const int gt = F.vcu * NTHR + F.tid, GT = F.G * NTHR;
    const int gw = F.vcu * NWAVES + F.wave, NGW = F.G * NWAVES;

    if (IN(0)) {
        LAS float* scr = (LAS float*)(F.lds + F.wave * 16384);
        constexpr int I_IN = (DM / 64) * (NIN / 32), I_P = (256 / 64) * (256 / 32), I_O = (DM / 64) * (DM / 32), I_U = (DM / 64) * (NUP / 32), I_D = (DFF / 64) * (DM / 32);
        constexpr int NITEMS = I_IN + 4 * I_P + I_O + I_U + I_D;
        for (int it = gw; it < NITEMS; it += NGW) {
            int r = it;
            if (r < I_IN) { p0_transpose_item(w_in, DM, NIN, Win_t, attn_norm, nullptr, scr, r, F.lane); continue; } r -= I_IN;
            if (r < 4 * I_P) { const int g = r / I_P; p0_transpose_item(w_pool + (size_t)g * 65536, 256, 256, Wp_t + (size_t)g * 65536, nullptr, pool_scale + 256 * g, scr, r % I_P, F.lane); continue; } r -= 4 * I_P;
            if (r < I_O) { p0_transpose_item(w_out, DM, DM, Wo_t, nullptr, nullptr, scr, r, F.lane); continue; } r -= I_O;
            if (r < I_U) { p0_transpose_item(w_up, DM, NUP, Wu_t, ffn_norm, nullptr, scr, r, F.lane); continue; } r -= I_U;
            p0_transpose_item(w_down, DFF, DM, Wd_t, nullptr, nullptr, scr, r, F.lane);
        }
        for (int m = gw; m < M; m += NGW) row_bf16_rs(F.lane, x + (size_t)m * DM, XB + (size_t)m * DM, R1 + m);
        for (int idx = gt; idx < M * 8; idx += GT) { const int m = idx >> 3, j = idx & 7;
            double rev = (double)positions[m] * args.invf[j]; rev -= floor(rev); const float fr = (float)rev;
            TAB[(size_t)m * 16 + j] = __builtin_amdgcn_cosf(fr); TAB[(size_t)m * 16 + 8 + j] = __builtin_amdgcn_sinf(fr); }
        if (BOTH(0)) GRID_BAR();
    }
    if (IN(1)) {
        pg8::Gemm g{DM, DM, DM, (size_t)128 * DM * 2, (size_t)128 * DM * 2};
        pg8::TileOrder S; S.init(M / 256, NIN / 256, F.G, (int)blockIdx.x, XB, Win_t, (size_t)256 * DM * 2, (size_t)256 * DM * 2, 0);
        pg8::EpiStore E{Z, NIN, R1};
        pg8::gemm_phase<pg8::EpiStore, pg8::TileOrder, true>(F.lds, g, S, E);
        if (BOTH(1)) GRID_BAR();
    }
    if (IN(2)) {
        for (int it = gt >> 3; it < M * 18; it += GT >> 3) {
            const int m = it / 18, h = it - m * 18, sub = F.tid & 7;
            bf16_t* p = Z + (size_t)m * NIN + ZQ + 64 * h + 8 * sub;
            float v[8]; unpack8(*(const v4u*)p, v);
            float ss = 0.f;
#pragma unroll
            for (int j = 0; j < 8; ++j) ss += v[j] * v[j];
            ss += __shfl_xor(ss, 1); ss += __shfl_xor(ss, 2); ss += __shfl_xor(ss, 4);
            const float rr = 1.f / sqrtf(ss * (1.f / 64.f) + EPS);
            const float* nw = (h < 16 ? q_norm : k_norm) + 8 * sub;
#pragma unroll
            for (int j = 0; j < 8; ++j) v[j] = v[j] * rr * nw[j];
            float o[8];
#pragma unroll
            for (int j = 0; j < 8; ++j) { const float pr = __shfl_xor(v[j], 1); const float c = TAB[(size_t)m * 16 + j], s = TAB[(size_t)m * 16 + 8 + j];
                o[j] = sub == 0 ? v[j] * c - pr * s : (sub == 1 ? v[j] * c + pr * s : v[j]); }
            const float sc = h < 16 ? 0.125f * LOG2E : 1.f;
#pragma unroll
            for (int j = 0; j < 8; ++j) o[j] *= sc;
            *(v4u*)p = pack8(o);
        }
        bf16_t* P = XB;
        for (int idx = gt; idx < M * 128; idx += GT) { const int m = idx >> 7, ch = idx & 127, g = ch >> 5, w = 2 << g, t = m & (SEQ - 1), cnt = (t + 1 < w) ? t + 1 : w;
            float a[8], u0[8];
#pragma unroll
            for (int j = 0; j < 8; ++j) a[j] = 0.f;
            for (int k = 0; k < cnt; ++k) { float f[8]; unpack8(*(const v4u*)(Z + (size_t)(m - k) * NIN + 8 * ch), f);
#pragma unroll
                for (int j = 0; j < 8; ++j) { a[j] += f[j]; if (k == 0) u0[j] = f[j]; } }
            const float ic = 1.f / (float)cnt;
#pragma unroll
            for (int j = 0; j < 8; ++j) a[j] = a[j] * ic - u0[j];
            *(v4u*)(P + (size_t)m * DM + 8 * ch) = pack8(a); }
        if (BOTH(2)) GRID_BAR();
    }
    if (IN(3)) {
        constexpr int KP = 72;
        LAS bf16_t* Ks = (LAS bf16_t*)F.lds; LAS bf16_t* Vs = Ks + 256 * KP;
        for (int unit = F.vcu; unit < NBATCH * 32 * 2; unit += F.G) {
            const int kvh = unit & 1, nblk = (unit >> 1) & 31, b = unit >> 6;
            const long row0 = (long)b * SEQ + (long)nblk * 128;
            __syncthreads();
            for (int c = F.tid; c < 2048; c += NTHR) { const int r = c >> 3, ch = c & 7; const long grow = row0 - 128 + r; v4u kv = {0u, 0u, 0u, 0u}, vv = {0u, 0u, 0u, 0u};
                if (grow >= (long)b * SEQ) { kv = *(const v4u*)(Z + (size_t)grow * NIN + ZK + 64 * kvh + 8 * ch); vv = *(const v4u*)(Z + (size_t)grow * NIN + ZV + 64 * kvh + 8 * ch); }
                *(LAS v4u*)(Ks + r * KP + 8 * ch) = kv; *(LAS v4u*)(Vs + r * KP + 8 * ch) = vv; }
            __syncthreads();
            const int i = F.tid & 127, gs = F.tid >> 7;
            for (int gg = 0; gg < 2; ++gg) {
                const int head = kvh * 8 + gs + 4 * gg;
                float q[64], o[64];
                const bf16_t* qp = Z + (size_t)(row0 + i) * NIN + ZQ + 64 * head;
#pragma unroll
                for (int c = 0; c < 8; ++c) { float f[8]; unpack8(*(const v4u*)(qp + 8 * c), f);
#pragma unroll
                    for (int j = 0; j < 8; ++j) q[8 * c + j] = f[j]; }
#pragma unroll
                for (int d = 0; d < 64; ++d) o[d] = 0.f;
                float mrun = sinks[head] * LOG2E, l = 1.f;
                const int s0 = (nblk == 0) ? 127 - i : 0;
                for (int s = s0; s < 128; ++s) { const int j = i + 1 + s;
                    float dot = 0.f;
#pragma unroll
                    for (int c = 0; c < 8; ++c) { float f[8]; unpack8(*(const LAS v4u*)(Ks + j * KP + 8 * c), f);
#pragma unroll
                        for (int e = 0; e < 8; ++e) dot += q[8 * c + e] * f[e]; }
                    const float mn = fmaxf(mrun, dot), corr = __builtin_amdgcn_exp2f(mrun - mn), p = __builtin_amdgcn_exp2f(dot - mn);
                    l = l * corr + p; mrun = mn;
#pragma unroll
                    for (int c = 0; c < 8; ++c) { float f[8]; unpack8(*(const LAS v4u*)(Vs + j * KP + 8 * c), f);
#pragma unroll
                        for (int e = 0; e < 8; ++e) o[8 * c + e] = o[8 * c + e] * corr + p * f[e]; }
                }
                const float inv = 1.f / l;
                bf16_t* op = BO + (size_t)(row0 + i) * DM + 64 * head;
#pragma unroll
                for (int c = 0; c < 8; ++c) { float f[8];
#pragma unroll
                    for (int e = 0; e < 8; ++e) f[e] = o[8 * c + e] * inv;
                    *(v4u*)(op + 8 * c) = pack8(f); }
            }
        }
        __syncthreads();
        if (BOTH(3)) GRID_BAR();
    }
    if (IN(4)) {
        pg8::Gemm g{DM, 256, 256, (size_t)128 * DM * 2, (size_t)128 * 256 * 2};
        pg8::TileOrder S; S.init(M / 256, 4, F.G, (int)blockIdx.x, XB, Wp_t, (size_t)256 * DM * 2, (size_t)256 * 256 * 2, (size_t)256 * 2);
        pg8::EpiStore E{AP, DM, nullptr};
        pg8::gemm_phase<pg8::EpiStore, pg8::TileOrder, true>(F.lds, g, S, E);
        if (BOTH(4)) GRID_BAR();
    }
    if (IN(5)) {
        bf16_t* MIX = XB;
        for (int idx = gt; idx < M * 128; idx += GT) { const int m = idx >> 7, ch = idx & 127;
            float gp[8], ga[8], a[8], b[8], o[8];
            unpack8(*(const v4u*)(Z + (size_t)m * NIN + ZG + 8 * ch), gp); unpack8(*(const v4u*)(Z + (size_t)m * NIN + ZG + DM + 8 * ch), ga);
            unpack8(*(const v4u*)(AP + (size_t)m * DM + 8 * ch), a); unpack8(*(const v4u*)(BO + (size_t)m * DM + 8 * ch), b);
#pragma unroll
            for (int j = 0; j < 8; ++j) o[j] = sigmoidf_(gp[j] + b_gate[8 * ch + j]) * a[j] + sigmoidf_(ga[j] + b_gate[DM + 8 * ch + j]) * b[j];
            *(v4u*)(MIX + (size_t)m * DM + 8 * ch) = pack8(o); }
        if (BOTH(5)) GRID_BAR();
    }
    if (IN(6)) {
        pg8::Gemm g{DM, DM, DM, (size_t)128 * DM * 2, (size_t)128 * DM * 2};
        pg8::TileOrder S; S.init(M / 256, DM / 256, F.G, (int)blockIdx.x, XB, Wo_t, (size_t)256 * DM * 2, (size_t)256 * DM * 2, 0);
        pg8::EpiRes E{x, out, DM};
        pg8::gemm_phase<pg8::EpiRes, pg8::TileOrder, true>(F.lds, g, S, E);
        if (BOTH(6)) GRID_BAR();
    }
    if (IN(7)) {
        for (int m = gw; m < M; m += NGW) row_bf16_rs(F.lane, out + (size_t)m * DM, XB + (size_t)m * DM, R2 + m);
        if (BOTH(7)) GRID_BAR();
    }
    for (int hh = 0; hh < 2; ++hh) {
        if (IN(8 + 2 * hh)) {
            const size_t r0 = (size_t)hh * (M / 2);
            pg8::Gemm g{DM, DM, DM, (size_t)128 * DM * 2, (size_t)128 * DM * 2};
            pg8::TileOrder S; S.init(M / 512, NUP / 256, F.G, (int)blockIdx.x, XB + r0 * DM, Wu_t, (size_t)256 * DM * 2, (size_t)256 * DM * 2, 0);
            pg8::EpiStore E{UP, NUP, R2 + r0};
            pg8::gemm_phase<pg8::EpiStore, pg8::TileOrder, true>(F.lds, g, S, E);
            if (BOTH(8 + 2 * hh)) GRID_BAR();
        }
        if (IN(9 + 2 * hh)) {
            const int r0 = hh * (M / 2);
            for (int idx = gt; idx < (M / 2) * (DFF / 8); idx += GT) { const int tl = idx / (DFF / 8), ch = idx - tl * (DFF / 8), m = r0 + tl, s = m & (SEQ - 1);
                float yg[8], yv[8];
#pragma unroll
                for (int j = 0; j < 8; ++j) { yg[j] = conv_b[8 * ch + j]; yv[j] = conv_b[DFF + 8 * ch + j]; }
#pragma unroll
                for (int k = 0; k < 3; ++k) { if (s >= k) { float fg[8], fv[8];
                    unpack8(*(const v4u*)(UP + (size_t)(tl - k) * NUP + 8 * ch), fg); unpack8(*(const v4u*)(UP + (size_t)(tl - k) * NUP + DFF + 8 * ch), fv);
#pragma unroll
                    for (int j = 0; j < 8; ++j) { yg[j] += conv_w[(size_t)(2 - k) * NUP + 8 * ch + j] * fg[j]; yv[j] += conv_w[(size_t)(2 - k) * NUP + DFF + 8 * ch + j] * fv[j]; } } }
                float o[8];
#pragma unroll
                for (int j = 0; j < 8; ++j) o[j] = yg[j] * sigmoidf_(yg[j]) * yv[j];
                *(v4u*)(HACT + (size_t)m * DFF + 8 * ch) = pack8(o); }
            if (BOTH(9 + 2 * hh)) GRID_BAR();
        }
    }
    if (IN(12)) {
        pg8::Gemm g{DFF, DFF, DFF, (size_t)128 * DFF * 2, (size_t)128 * DFF * 2};
        pg8::TileOrder S; S.init(M / 256, DM / 256, F.G, (int)blockIdx.x, HACT, Wd_t, (size_t)256 * DFF * 2, (size_t)256 * DFF * 2, 0);
        pg8::EpiRes E{out, out, DM};
        pg8::gemm_phase<pg8::EpiRes, pg8::TileOrder, true>(F.lds, g, S, E);
    }
#undef IN
#undef BOTH
}

extern "C" void kernel_launch(void* const* d_in, const int* in_sizes, int n_in, void* d_out, int out_size, void* d_ws, size_t ws_size, hipStream_t stream) {
    static int grid = 0;
    if (grid == 0) {
        if (n_in != 16 || in_sizes[0] != M * DM || out_size != M * DM || ws_size < WS_END) { fprintf(stderr, "kernel_launch: unexpected shapes (n_in %d, in0 %d, out %d, ws %zu); nothing launched\n", n_in, n_in > 0 ? in_sizes[0] : -1, out_size, ws_size); grid = -1; return; }
        int dev = 0, cus = 0, per_cu = 0;
        if (hipGetDevice(&dev) != hipSuccess || hipDeviceGetAttribute(&cus, hipDeviceAttributeMultiprocessorCount, dev) != hipSuccess) { grid = -1; return; }
        if (hipFuncSetAttribute((const void*)mega_fwd, hipFuncAttributeMaxDynamicSharedMemorySize, LDS_BYTES) != hipSuccess) { fprintf(stderr, "kernel_launch: hipFuncSetAttribute failed\n"); grid = -1; return; }
        if (hipOccupancyMaxActiveBlocksPerMultiprocessor(&per_cu, (const void*)mega_fwd, NTHR, LDS_BYTES) != hipSuccess || per_cu < 1) { fprintf(stderr, "kernel_launch: occupancy query reports %d blocks per CU\n", per_cu); (void)hipGetLastError(); grid = -1; return; }
        grid = cus;
    }
    if (grid < 0) return;
    if (hipMemsetAsync((char*)d_ws + WS_CTL, 0, CTL_ZERO_BYTES, stream) != hipSuccess) return;
    Args a{};
    for (int i = 0; i < 16; ++i) a.in[i] = d_in[i];
    a.out = (float*)d_out; a.ws = (unsigned char*)d_ws;
    for (int j = 0; j < 8; ++j) a.invf[j] = std::pow(500000.0, -(double)j / 8.0) / 6.283185307179586476925;
    if (MK_N_LAUNCHES == 1) { a.ph_lo = 0; a.ph_hi = N_PHASES; a.li = 0; hipLaunchKernelGGL(mega_fwd, dim3(grid), dim3(NTHR), LDS_BYTES, stream, a); }
    else for (int p = 0; p < N_PHASES; ++p) { a.ph_lo = p; a.ph_hi = p + 1; a.li = p; hipLaunchKernelGGL(mega_fwd, dim3(grid), dim3(NTHR), LDS_BYTES, stream, a); }
}
```

```cpp
#include <hip/hip_runtime.h>
#include <cstdio>
#include <cstdint>
#include <cmath>

#ifndef MK_N_LAUNCHES
#define MK_N_LAUNCHES 1
#endif

constexpr int DM = 1024, NBATCH = 8, SEQ = 4096, M = NBATCH * SEQ;
constexpr int NIN = 4352, DFF = 2816, NUP = 2 * DFF;
constexpr int ZQ = 1024, ZK = 2048, ZV = 2176, ZG = 2304;
constexpr float EPS = 1e-6f, LOG2E = 1.4426950408889634f;

#define GAS __attribute__((address_space(1)))
#define LAS __attribute__((address_space(3)))
typedef unsigned short bf16_t;
typedef unsigned v4u __attribute__((ext_vector_type(4)));
typedef float f32x4 __attribute__((ext_vector_type(4)));
typedef short bf16x8 __attribute__((ext_vector_type(8)));
typedef GAS unsigned gu32;
#define RLX_AGENT __ATOMIC_RELAXED, __HIP_MEMORY_SCOPE_AGENT
#define LDS_WAIT() asm volatile("s_waitcnt lgkmcnt(0)" ::: "memory")
#define VM_WAIT() asm volatile("s_waitcnt vmcnt(0)" ::: "memory")

__device__ __forceinline__ unsigned f2bf(float f) { unsigned u = __builtin_bit_cast(unsigned, f); return (u + 0x7fffu + ((u >> 16) & 1u)) >> 16; }
typedef float f32x2_t __attribute__((ext_vector_type(2))); typedef __bf16 bf16x2_t __attribute__((ext_vector_type(2)));
__device__ __forceinline__ unsigned pk2(float lo, float hi) { f32x2_t v = {lo, hi}; bf16x2_t b = __builtin_convertvector(v, bf16x2_t); return __builtin_bit_cast(unsigned, b); }
__device__ __forceinline__ float bflo(unsigned w) { return __uint_as_float(w << 16); }
__device__ __forceinline__ float bfhi(unsigned w) { return __uint_as_float(w & 0xffff0000u); }
__device__ __forceinline__ void unpack8(const v4u w, float (&f)[8]) { f[0] = bflo(w.x); f[1] = bfhi(w.x); f[2] = bflo(w.y); f[3] = bfhi(w.y); f[4] = bflo(w.z); f[5] = bfhi(w.z); f[6] = bflo(w.w); f[7] = bfhi(w.w); }
__device__ __forceinline__ v4u pack8(const float (&f)[8]) { v4u w; w.x = pk2(f[0], f[1]); w.y = pk2(f[2], f[3]); w.z = pk2(f[4], f[5]); w.w = pk2(f[6], f[7]); return w; }
__device__ __forceinline__ float sigmoidf_(float x) { return __builtin_amdgcn_rcpf(1.f + __builtin_amdgcn_exp2f(-x * LOG2E)); }

namespace pg8 {
constexpr int BM = 256, BK = 64, HALF = 128, HTB = HALF * BK * 2, STAGE_BYTES = 8 * HTB, NXCD = 8, WGM = 8;
__host__ __device__ __forceinline__ int lds_byte(int r, int c) { const int st = (r >> 4) * 2 + (c >> 5), rr = r & 15, cc = c & 31, ob = rr * 64 + cc * 2; return st * 1024 + (ob ^ (((ob >> 9) & 1) << 5)); }
__host__ __device__ __forceinline__ void stage_rc(int b, int& R, int& C) { const int st = b / 1024, sb = b % 1024, swz = sb ^ (((sb >> 9) & 1) << 5); R = (st >> 1) * 16 + swz / 64; C = (st & 1) * 32 + (swz % 64) / 2; }
__host__ __device__ __forceinline__ int perm32(int rho) { const int n = rho >> 4, i = rho & 15; return 8 * (i >> 2) + 4 * n + (i & 3); }

struct Unit { const char* a; const char* b; int pm, pn; };
struct Gemm { int lda, ldb, K; size_t hstepA, hstepB; };

struct TileOrder {
    int nM, nN, nwg, G, c; const char* A; const char* B; size_t sA, sB, sApn;
    __device__ void init(int nM_, int nN_, int G_, int c_, const void* A_, const void* B_, size_t sA_, size_t sB_, size_t sApn_) { nM = nM_; nN = nN_; nwg = nM * nN; G = G_; c = c_; A = (const char*)A_; B = (const char*)B_; sA = sA_; sB = sB_; sApn = sApn_; }
    __device__ bool next(int i, Unit& u) const {
        const long L = (long)i * G + c; if (L >= nwg) return false;
        int wgid = (int)L; { const int q = nwg / NXCD, r = nwg % NXCD, xcd = wgid % NXCD, off = wgid / NXCD; wgid = (xcd < r ? xcd * (q + 1) : r * (q + 1) + (xcd - r) * q) + off; }
        const int nig = WGM * nN, gid = wgid / nig, fm = gid * WGM, gsz = (nM - fm) < WGM ? (nM - fm) : WGM;
        u.pm = fm + ((wgid % nig) % gsz); u.pn = (wgid % nig) / gsz;
        u.a = A + (size_t)u.pm * sA + (size_t)u.pn * sApn; u.b = B + (size_t)u.pn * sB; return true;
    }
};

template <int BMODE> __device__ __forceinline__ int mapB(int R) { return BMODE == 1 ? ((R & ~31) + perm32(R & 31)) : R; }

template <class Epi, class Sched, bool ALIGN_EPI>
__device__ __forceinline__ void gemm_phase(LAS unsigned char* lds, const Gemm g, const Sched& S, const Epi& E) {
    const int tid = threadIdx.x, wid = __builtin_amdgcn_readfirstlane(tid >> 6), lane = tid & 63, wr = wid >> 2, wc = wid & 3, fr = lane & 15, fq = lane >> 4;
    const int nt = g.K / BK;
    unsigned voffA[2], voffB[2];
#pragma unroll
    for (int i = 0; i < 2; ++i) { int R, C; stage_rc(tid * 16 + i * 8192, R, C); const int Rb = mapB<Epi::BMODE>(R);
        voffA[i] = (unsigned)(R * g.lda + C) * 2u; voffB[i] = (unsigned)(Rb * g.ldb + C) * 2u; }
    const size_t kstep = (size_t)(BK * 2);
    const size_t hstepA = g.hstepA, hstepB = g.hstepB;
    const unsigned ldsw = (unsigned)wid * 1024u;
    const int aoff = lds_byte(wr * 64 + fr, fq * 8), boff = lds_byte(wc * 32 + fr, fq * 8);
#define PG8_SA(b, h) (((b) * 2 + (h)) * HTB)
#define PG8_SB(b, h) ((4 + (b) * 2 + (h)) * HTB)
#define PG8_STAGE(bufoff, gbase, voff) do { _Pragma("unroll") for (int _i = 0; _i < 2; ++_i) \
        __builtin_amdgcn_global_load_lds((const unsigned*)((const char*)(gbase) + (voff)[_i]), (LAS unsigned*)(lds + (bufoff) + ldsw + _i * 8192), 16, 0, 0); } while (0)
#define PG8_LDA(dst, b, h) do { _Pragma("unroll") for (int m = 0; m < 4; ++m) _Pragma("unroll") for (int k = 0; k < 2; ++k) dst[m][k] = *(const LAS bf16x8*)(lds + PG8_SA(b, h) + aoff + m * 2048 + k * 1024); } while (0)
#define PG8_LDB(dst, b, h) do { _Pragma("unroll") for (int n = 0; n < 2; ++n) _Pragma("unroll") for (int k = 0; k < 2; ++k) dst[n][k] = *(const LAS bf16x8*)(lds + PG8_SB(b, h) + boff + n * 2048 + k * 1024); } while (0)
#define PG8_MMA(ai, bj, At, Bt) do { __builtin_amdgcn_s_setprio(1); _Pragma("unroll") for (int m = 0; m < 4; ++m) _Pragma("unroll") for (int n = 0; n < 2; ++n) _Pragma("unroll") for (int k = 0; k < 2; ++k) \
        acc[ai][bj][m][n] = __builtin_amdgcn_mfma_f32_16x16x32_bf16(Bt[n][k], At[m][k], acc[ai][bj][m][n], 0, 0, 0); __builtin_amdgcn_s_setprio(0); } while (0)
#define PG8_WAIT_V(n) asm volatile("s_waitcnt vmcnt(" #n ")" ::: "memory")
#define PG8_WAIT_L(n) asm volatile("s_waitcnt lgkmcnt(" #n ")" ::: "memory")
#define PG8_BAR __builtin_amdgcn_s_barrier()
#define PG8_SCHED __builtin_amdgcn_sched_barrier(0)
    Unit cur, nxt; int ui = 0;
    if (!S.next(0, cur)) return;
    f32x4 acc[2][2][4][2];
#pragma unroll
    for (int a = 0; a < 2; ++a)
#pragma unroll
        for (int b = 0; b < 2; ++b)
#pragma unroll
            for (int m = 0; m < 4; ++m)
#pragma unroll
                for (int n = 0; n < 2; ++n) acc[a][b][m][n] = (f32x4){0.f, 0.f, 0.f, 0.f};
    bf16x8 At[4][2], B0[2][2], B1[2][2];
    const char* cA = cur.a; const char* cB = cur.b;
    PG8_STAGE(PG8_SB(0, 0), cB, voffB); PG8_STAGE(PG8_SB(0, 1), cB + hstepB, voffB); PG8_STAGE(PG8_SA(0, 0), cA, voffA); PG8_STAGE(PG8_SA(0, 1), cA + hstepA, voffA);
    if (wr == 1) PG8_BAR;
    PG8_WAIT_V(2); PG8_BAR;
    PG8_STAGE(PG8_SB(1, 0), cB + kstep, voffB); PG8_STAGE(PG8_SA(1, 0), cA + kstep, voffA); PG8_STAGE(PG8_SB(1, 1), cB + hstepB + kstep, voffB);
    PG8_WAIT_V(6); PG8_BAR;
    for (;;) {
        const bool has_next = S.next(ui + 1, nxt);
        const char* nA = has_next ? nxt.a : cA; const char* nB = has_next ? nxt.b : cB;
        for (int t = 0; t < nt; t += 2) {
            const bool last = (t == nt - 2);
            const char* a1 = cA + (size_t)(t + 1) * kstep;
            const char* a2 = last ? nA : cA + (size_t)(t + 2) * kstep; const char* b2 = last ? nB : cB + (size_t)(t + 2) * kstep;
            const char* a3 = a2 + kstep; const char* b3 = b2 + kstep;
            PG8_LDB(B0, 0, 0); PG8_LDB(B1, 0, 1); PG8_SCHED; PG8_LDA(At, 0, 0); PG8_STAGE(PG8_SA(1, 1), a1 + hstepA, voffA);
            PG8_WAIT_V(8); PG8_WAIT_L(0); PG8_BAR; PG8_MMA(0, 0, At, B0); PG8_MMA(0, 1, At, B1); PG8_BAR; PG8_SCHED;
            PG8_LDA(At, 0, 1); PG8_STAGE(PG8_SB(0, 0), b2, voffB); PG8_STAGE(PG8_SB(0, 1), b2 + hstepB, voffB); PG8_STAGE(PG8_SA(0, 0), a2, voffA);
            PG8_WAIT_V(8); PG8_WAIT_L(0); PG8_BAR; PG8_MMA(1, 0, At, B0); PG8_MMA(1, 1, At, B1); PG8_BAR; PG8_SCHED;
            PG8_LDB(B0, 1, 0); PG8_LDB(B1, 1, 1); PG8_SCHED; PG8_LDA(At, 1, 0); PG8_STAGE(PG8_SA(0, 1), a2 + hstepA, voffA);
            PG8_WAIT_V(8); PG8_WAIT_L(0); PG8_BAR; PG8_MMA(0, 0, At, B0); PG8_MMA(0, 1, At, B1); PG8_BAR; PG8_SCHED;
            PG8_LDA(At, 1, 1); PG8_STAGE(PG8_SB(1, 0), b3, voffB); PG8_STAGE(PG8_SB(1, 1), b3 + hstepB, voffB); PG8_STAGE(PG8_SA(1, 0), a3, voffA);
            PG8_WAIT_V(8); PG8_WAIT_L(0); PG8_BAR; PG8_MMA(1, 0, At, B0); PG8_MMA(1, 1, At, B1); PG8_BAR; PG8_SCHED;
        }
        if constexpr (ALIGN_EPI) { if (wr == 0) PG8_BAR; }
        E(acc, cur, wr, wc, fr, fq);
        if (!has_next) break;
#pragma unroll
        for (int a = 0; a < 2; ++a)
#pragma unroll
            for (int b = 0; b < 2; ++b)
#pragma unroll
                for (int m = 0; m < 4; ++m)
#pragma unroll
                    for (int n = 0; n < 2; ++n) acc[a][b][m][n] = (f32x4){0.f, 0.f, 0.f, 0.f};
        cur = nxt; cA = nA; cB = nB; ++ui;
        if constexpr (ALIGN_EPI) { if (wr == 1) PG8_BAR; }
    }
    PG8_WAIT_V(0);
    if constexpr (!ALIGN_EPI) { if (wr == 0) PG8_BAR; }
    PG8_BAR;
#undef PG8_SA
#undef PG8_SB
#undef PG8_STAGE
#undef PG8_LDA
#undef PG8_LDB
#undef PG8_MMA
#undef PG8_WAIT_V
#undef PG8_WAIT_L
#undef PG8_BAR
#undef PG8_SCHED
}

struct EpiStore {
    static constexpr int BMODE = 1;
    bf16_t* O; int ldc; const float* rs;
    __device__ __forceinline__ void operator()(const f32x4 (&acc)[2][2][4][2], const Unit& u, int wr, int wc, int fr, int fq) const {
        const int row0 = u.pm * BM + wr * 64 + fr, col0 = u.pn * BM + wc * 32 + 8 * fq;
#pragma unroll
        for (int ai = 0; ai < 2; ++ai)
#pragma unroll
            for (int m = 0; m < 4; ++m) { const int row = row0 + ai * HALF + m * 16; const float s = rs ? rs[row] : 1.f; bf16_t* rowp = O + (size_t)row * ldc + col0;
#pragma unroll
                for (int bj = 0; bj < 2; ++bj) { const f32x4 v0 = acc[ai][bj][m][0] * s, v1 = acc[ai][bj][m][1] * s;
                    v4u w; w.x = pk2(v0[0], v0[1]); w.y = pk2(v0[2], v0[3]); w.z = pk2(v1[0], v1[1]); w.w = pk2(v1[2], v1[3]);
                    *(v4u*)(rowp + bj * HALF) = w; } }
    }
};
struct EpiRes {
    static constexpr int BMODE = 0;
    const float* base; float* out; int ldc;
    __device__ __forceinline__ void operator()(const f32x4 (&acc)[2][2][4][2], const Unit& u, int wr, int wc, int fr, int fq) const {
        const int row0 = u.pm * BM + wr * 64 + fr, col0 = u.pn * BM + wc * 32 + 4 * fq;
#pragma unroll
        for (int ai = 0; ai < 2; ++ai)
#pragma unroll
            for (int m = 0; m < 4; ++m) { const size_t off = (size_t)(row0 + ai * HALF + m * 16) * ldc + col0;
#pragma unroll
                for (int bj = 0; bj < 2; ++bj)
#pragma unroll
                    for (int n = 0; n < 2; ++n) { const f32x4 b = *(const f32x4*)(base + off + bj * HALF + n * 16); *(f32x4*)(out + off + bj * HALF + n * 16) = b + acc[ai][bj][m][n]; } }
    }
};
}

constexpr int NWAVES = 8, NTHR = NWAVES * 64;
constexpr int N_PHASES = 13;
constexpr size_t MiB = 1u << 20;
constexpr size_t WS_CTL = 0, CTL_ZERO_BYTES = 1 * MiB;
constexpr size_t WS_R1 = 1 * MiB, WS_R2 = WS_R1 + 256 * 1024;
constexpr size_t WS_TAB = 2 * MiB;
constexpr size_t WS_WIN = 4 * MiB, WS_WP = 13 * MiB, WS_WO = 14 * MiB, WS_WU = 16 * MiB, WS_WD = 28 * MiB;
constexpr size_t WS_XB = 34 * MiB;
constexpr size_t WS_Z = 98 * MiB;
constexpr size_t WS_UP = WS_Z, WS_HACT = WS_Z + 176 * MiB;
constexpr size_t WS_B = 370 * MiB;
constexpr size_t WS_AP = 434 * MiB;
constexpr size_t WS_END = 498 * MiB;
static_assert(WS_WIN + (size_t)NIN * DM * 2 <= WS_WP && WS_WU + (size_t)NUP * DM * 2 <= WS_WD && WS_WD + (size_t)DM * DFF * 2 <= WS_XB, "weights map");
static_assert(WS_Z + (size_t)M * NIN * 2 <= WS_B && WS_HACT + (size_t)M * DFF * 2 <= WS_END && (size_t)(M / 2) * NUP * 2 <= 176 * MiB, "activation map");
constexpr int CW_BAR = 4096;
constexpr int RING_BYTES = 131072, LDSCTL_OFF = RING_BYTES, MISC_OFF = LDSCTL_OFF + 320, LDS_BYTES = 147456;

#define XB_TMO      128
#define XB_XCNT(j)  (256  + 64 * (j))
#define XB_XSUB(j)  (1280 + 64 * (j))
#define XB_XGEN(j)  (2304 + 64 * (j))
#define XB_TOP      3328
#define XB_TOPGEN   3392
#define XCD_BAR_WORDS 3456
#define XB_SPIN_CAP (1u << 18)
__device__ __forceinline__ unsigned xb_ld(unsigned* p)              { return __hip_atomic_load(p, __ATOMIC_RELAXED, __HIP_MEMORY_SCOPE_AGENT); }
__device__ __forceinline__ unsigned xb_add(unsigned* p, unsigned v) { return __hip_atomic_fetch_add(p, v, __ATOMIC_RELAXED, __HIP_MEMORY_SCOPE_AGENT); }
__device__ __forceinline__ unsigned xb_xcc_id() { return (unsigned)__builtin_amdgcn_s_getreg((3 << 11) | 20) & 0xFu; }
#define XB_SPIN(cond, bar) do { unsigned _sp = 0; while (cond) { __builtin_amdgcn_s_sleep(1); \
    if ((++_sp & 255u) == 0u) { if (xb_ld(&(bar)[XB_TMO])) break; if (_sp > XB_SPIN_CAP) { atomicAdd(&(bar)[XB_TMO], 1u); break; } } } } while (0)
struct XcdBarrier { unsigned* bar; unsigned x; volatile LAS unsigned* st; };
__device__ __forceinline__ XcdBarrier xcd_barrier_post(unsigned* bar, volatile LAS unsigned* st) {
    XcdBarrier b; b.bar = bar; b.x = xb_xcc_id(); b.st = st;
    if (threadIdx.x == 0) (void)xb_add(&bar[XB_XCNT(b.x)], 1u);
    return b;
}
__device__ __forceinline__ void xcd_barrier_complete(unsigned* bar, unsigned x, unsigned& nloc, unsigned& nx) {
    const unsigned G = gridDim.x * gridDim.y * gridDim.z;
    unsigned sum, cnt, mine, sp = 0u;
    for (;;) {
        sum = 0u; cnt = 0u; mine = 0u;
#pragma unroll
        for (unsigned j = 0; j < 16; ++j) { const unsigned c = xb_ld(&bar[XB_XCNT(j)]); sum += c; cnt += (c > 0u) ? 1u : 0u; mine = (j == x) ? c : mine; }
        if (sum == G) break;
        __builtin_amdgcn_s_sleep(1);
        if ((++sp & 255u) == 0u) { if (xb_ld(&bar[XB_TMO])) break; if (sp > XB_SPIN_CAP) { atomicAdd(&bar[XB_TMO], 1u); break; } }
    }
    nloc = mine > 0u ? mine : 1u; nx = cnt > 0u ? cnt : 1u;
}
__device__ __forceinline__ void xcd_barrier(const XcdBarrier& b) {
    asm volatile("s_waitcnt vmcnt(0)" ::: "memory");
    __syncthreads();
    if (threadIdx.x == 0) {
        unsigned* bar = b.bar;
        __builtin_amdgcn_s_waitcnt(0);
        unsigned nloc = b.st[0], nx = b.st[1];
        if (nloc == 0u) { xcd_barrier_complete(bar, b.x, nloc, nx); b.st[0] = nloc; b.st[1] = nx; }
        const unsigned old = xb_add(&bar[XB_XSUB(b.x)], 1u);
        const unsigned gen = old / nloc;
        if (old + 1u == (gen + 1u) * nloc) {
            __builtin_amdgcn_fence(__ATOMIC_RELEASE, "agent");
            asm volatile("s_waitcnt vmcnt(0)" ::: "memory");
            const unsigned og = xb_add(&bar[XB_TOP], 1u);
            const unsigned tg = og / nx;
            if (og + 1u == (tg + 1u) * nx) xb_add(&bar[XB_TOPGEN], 1u);
            else XB_SPIN(xb_ld(&bar[XB_TOPGEN]) == tg, bar);
            __builtin_amdgcn_fence(__ATOMIC_ACQUIRE, "agent");
            xb_add(&bar[XB_XGEN(b.x)], 1u);
            asm volatile("s_waitcnt vmcnt(0)" ::: "memory");
        } else {
            XB_SPIN(xb_ld(&bar[XB_XGEN(b.x)]) == gen, bar);
            __builtin_amdgcn_fence(__ATOMIC_ACQUIRE, "agent");
            asm volatile("s_waitcnt vmcnt(0)" ::: "memory");
        }
    }
    __syncthreads();
}

struct Frame {
    LAS unsigned char* lds; volatile LAS unsigned* MISC; gu32* ctl;
    int tid, lane, wave, vcu, G;
};
__device__ __forceinline__ float wave_sum(float v) {
#pragma unroll
    for (int o = 1; o < 64; o <<= 1) v += __shfl_xor(v, o);
    return v;
}

__device__ __forceinline__ void p0_transpose_item(const float* W, int K, int N, bf16_t* WT, const float* kscale, const float* nscale, LAS float* scr, int item, int lane) {
    const int nblk = N / 32, kb = item / nblk, nb = item % nblk, k0 = 64 * kb, n0 = 32 * nb;
    const float ns = nscale ? nscale[n0 + (lane & 31)] : 1.f;
#pragma unroll 8
    for (int i = 0; i < 32; ++i) { const int kk = 2 * i + (lane >> 5); const float ks = kscale ? kscale[k0 + kk] : 1.f; scr[kk * 33 + (lane & 31)] = W[(size_t)(k0 + kk) * N + n0 + (lane & 31)] * ks * ns; }
    LDS_WAIT(); asm volatile("" ::: "memory");
    const int c = lane & 7;
#pragma unroll
    for (int j = 0; j < 4; ++j) { const int n = (lane >> 3) + 8 * j; const LAS float* s = scr + (8 * c) * 33 + n;
        v4u o; o.x = pk2(s[0 * 33], s[1 * 33]); o.y = pk2(s[2 * 33], s[3 * 33]); o.z = pk2(s[4 * 33], s[5 * 33]); o.w = pk2(s[6 * 33], s[7 * 33]);
        *(GAS v4u*)(WT + (size_t)(n0 + n) * K + k0 + 8 * c) = o; }
    LDS_WAIT(); asm volatile("" ::: "memory");
}
__device__ __forceinline__ void row_bf16_rs(int lane, const float* xrow, bf16_t* orow, float* rs) {
    const GAS f32x4* xr = (const GAS f32x4*)xrow + lane;
    f32x4 v[4]; float s = 0.f;
#pragma unroll
    for (int j = 0; j < 4; ++j) { v[j] = xr[64 * j]; s += (v[j].x * v[j].x + v[j].y * v[j].y) + (v[j].z * v[j].z + v[j].w * v[j].w); }
    s = wave_sum(s);
    if (lane == 0) *rs = 1.f / sqrtf(s * (1.f / DM) + EPS);
    GAS unsigned long long* o8 = (GAS unsigned long long*)orow + lane;
#pragma unroll
    for (int j = 0; j < 4; ++j) o8[64 * j] = (unsigned long long)pk2(v[j].x, v[j].y) | ((unsigned long long)pk2(v[j].z, v[j].w) << 32);
}

struct Args { const void* in[16]; float* out; unsigned char* ws; double invf[8]; int ph_lo, ph_hi, li, pad; };

__global__ void __launch_bounds__(NTHR, 2) mega_fwd(Args args) {
    extern __shared__ __attribute__((aligned(16))) unsigned char lds[];
    Frame F;
    F.lds = (LAS unsigned char*)lds;
    F.MISC = (volatile LAS unsigned*)(F.lds + MISC_OFF);
    F.tid = threadIdx.x; F.lane = F.tid & 63; F.wave = __builtin_amdgcn_readfirstlane(F.tid >> 6);
    F.G = gridDim.x; { const int bx = blockIdx.x; F.vcu = (F.G % 8 == 0) ? (bx % 8) * (F.G / 8) + bx / 8 : bx; }
    unsigned char* ws = args.ws;
    F.ctl = (gu32*)(ws + WS_CTL);
    const float* x = (const float*)args.in[0]; const int* positions = (const int*)args.in[1]; const float* attn_norm = (const float*)args.in[2];
    const float* w_in = (const float*)args.in[3]; const float* b_gate = (const float*)args.in[4]; const float* w_pool = (const float*)args.in[5];
    const float* pool_scale = (const float*)args.in[6]; const float* q_norm = (const float*)args.in[7]; const float* k_norm = (const float*)args.in[8];
    const float* sinks = (const float*)args.in[9]; const float* w_out = (const float*)args.in[10]; const float* ffn_norm = (const float*)args.in[11];
    const float* w_up = (const float*)args.in[12]; const float* conv_w = (const float*)args.in[13]; const float* conv_b = (const float*)args.in[14];
    const float* w_down = (const float*)args.in[15];
    float* out = args.out;
    float* R1 = (float*)(ws + WS_R1); float* R2 = (float*)(ws + WS_R2); float* TAB = (float*)(ws + WS_TAB);
    bf16_t* Win_t = (bf16_t*)(ws + WS_WIN); bf16_t* Wp_t = (bf16_t*)(ws + WS_WP); bf16_t* Wo_t = (bf16_t*)(ws + WS_WO); bf16_t* Wu_t = (bf16_t*)(ws + WS_WU); bf16_t* Wd_t = (bf16_t*)(ws + WS_WD);
    bf16_t* XB = (bf16_t*)(ws + WS_XB); bf16_t* Z = (bf16_t*)(ws + WS_Z); bf16_t* UP = (bf16_t*)(ws + WS_UP); bf16_t* HACT = (bf16_t*)(ws + WS_HACT);
    bf16_t* BO = (bf16_t*)(ws + WS_B); bf16_t* AP = (bf16_t*)(ws + WS_AP);

    for (int u = F.tid; u < (LDS_BYTES - LDSCTL_OFF) / 4; u += NTHR) ((LAS unsigned*)(F.lds + LDSCTL_OFF))[u] = 0u;
    __syncthreads();
    XcdBarrier bar; bar.bar = (unsigned*)(F.ctl + CW_BAR); bar.x = 0; bar.st = nullptr;
    if (MK_N_LAUNCHES == 1) bar = xcd_barrier_post((unsigned*)(F.ctl + CW_BAR), F.MISC + 8);
#define GRID_BAR() do { if (MK_N_LAUNCHES == 1) xcd_barrier(bar); } while (0)
    const int lo = args.ph_lo, hi = args.ph_hi;
#define IN(k) (lo <= (k) && (k) < hi)
#define BOTH(k) (IN(k) && IN((k) + 1))
    const int gt = F.vcu * NTHR + F.tid, GT = F.G * NTHR;
    const int gw = F.vcu * NWAVES + F.wave, NGW = F.G * NWAVES;

    if (IN(0)) {
        LAS float* scr = (LAS float*)(F.lds + F.wave * 16384);
        constexpr int I_IN = (DM / 64) * (NIN / 32), I_P = (256 / 64) * (256 / 32), I_O = (DM / 64) * (DM / 32), I_U = (DM / 64) * (NUP / 32), I_D = (DFF / 64) * (DM / 32);
        constexpr int NITEMS = I_IN + 4 * I_P + I_O + I_U + I_D;
        for (int it = gw; it < NITEMS; it += NGW) {
            int r = it;
            if (r < I_IN) { p0_transpose_item(w_in, DM, NIN, Win_t, attn_norm, nullptr, scr, r, F.lane); continue; } r -= I_IN;
            if (r < 4 * I_P) { const int g = r / I_P; p0_transpose_item(w_pool + (size_t)g * 65536, 256, 256, Wp_t + (size_t)g * 65536, nullptr, pool_scale + 256 * g, scr, r % I_P, F.lane); continue; } r -= 4 * I_P;
            if (r < I_O) { p0_transpose_item(w_out, DM, DM, Wo_t, nullptr, nullptr, scr, r, F.lane); continue; } r -= I_O;
            if (r < I_U) { p0_transpose_item(w_up, DM, NUP, Wu_t, ffn_norm, nullptr, scr, r, F.lane); continue; } r -= I_U;
            p0_transpose_item(w_down, DFF, DM, Wd_t, nullptr, nullptr, scr, r, F.lane);
        }
        for (int m = gw; m < M; m += NGW) row_bf16_rs(F.lane, x + (size_t)m * DM, XB + (size_t)m * DM, R1 + m);
        for (int idx = gt; idx < M * 8; idx += GT) { const int m = idx >> 3, j = idx & 7;
            double rev = (double)positions[m] * args.invf[j]; rev -= floor(rev); const float fr = (float)rev;
            TAB[(size_t)m * 16 + j] = __builtin_amdgcn_cosf(fr); TAB[(size_t)m * 16 + 8 + j] = __builtin_amdgcn_sinf(fr); }
        if (BOTH(0)) GRID_BAR();
    }
    if (IN(1)) {
        pg8::Gemm g{DM, DM, DM, (size_t)128 * DM * 2, (size_t)128 * DM * 2};
        pg8::TileOrder S; S.init(M / 256, NIN / 256, F.G, (int)blockIdx.x, XB, Win_t, (size_t)256 * DM * 2, (size_t)256 * DM * 2, 0);
        pg8::EpiStore E{Z, NIN, R1};
        pg8::gemm_phase<pg8::EpiStore, pg8::TileOrder, true>(F.lds, g, S, E);
        if (BOTH(1)) GRID_BAR();
    }
    if (IN(2)) {
        for (int it = gt >> 3; it < M * 18; it += GT >> 3) {
            const int m = it / 18, h = it - m * 18, sub = F.tid & 7;
            bf16_t* p = Z + (size_t)m * NIN + ZQ + 64 * h + 8 * sub;
            float v[8]; unpack8(*(const v4u*)p, v);
            float ss = 0.f;
#pragma unroll
            for (int j = 0; j < 8; ++j) ss += v[j] * v[j];
            ss += __shfl_xor(ss, 1); ss += __shfl_xor(ss, 2); ss += __shfl_xor(ss, 4);
            const float rr = 1.f / sqrtf(ss * (1.f / 64.f) + EPS);
            const float* nw = (h < 16 ? q_norm : k_norm) + 8 * sub;
#pragma unroll
            for (int j = 0; j < 8; ++j) v[j] = v[j] * rr * nw[j];
            float o[8];
#pragma unroll
            for (int j = 0; j < 8; ++j) { const float pr = __shfl_xor(v[j], 1); const float c = TAB[(size_t)m * 16 + j], s = TAB[(size_t)m * 16 + 8 + j];
                o[j] = sub == 0 ? v[j] * c - pr * s : (sub == 1 ? v[j] * c + pr * s : v[j]); }
            const float sc = h < 16 ? 0.125f * LOG2E : 1.f;
#pragma unroll
            for (int j = 0; j < 8; ++j) o[j] *= sc;
            *(v4u*)p = pack8(o);
        }
        bf16_t* P = XB;
        for (int idx = gt; idx < M * 128; idx += GT) { const int m = idx >> 7, ch = idx & 127, g = ch >> 5, w = 2 << g, t = m & (SEQ - 1), cnt = (t + 1 < w) ? t + 1 : w;
            float a[8], u0[8];
#pragma unroll
            for (int j = 0; j < 8; ++j) a[j] = 0.f;
            for (int k = 0; k < cnt; ++k) { float f[8]; unpack8(*(const v4u*)(Z + (size_t)(m - k) * NIN + 8 * ch), f);
#pragma unroll
                for (int j = 0; j < 8; ++j) { a[j] += f[j]; if (k == 0) u0[j] = f[j]; } }
            const float ic = 1.f / (float)cnt;
#pragma unroll
            for (int j = 0; j < 8; ++j) a[j] = a[j] * ic - u0[j];
            *(v4u*)(P + (size_t)m * DM + 8 * ch) = pack8(a); }
        if (BOTH(2)) GRID_BAR();
    }
    if (IN(3)) {
        constexpr int KP = 72;
        LAS bf16_t* Ks = (LAS bf16_t*)F.lds; LAS bf16_t* Vs = Ks + 256 * KP;
        for (int unit = F.vcu; unit < NBATCH * 32 * 2; unit += F.G) {
            const int kvh = unit & 1, nblk = (unit >> 1) & 31, b = unit >> 6;
            const long row0 = (long)b * SEQ + (long)nblk * 128;
            __syncthreads();
            for (int c = F.tid; c < 2048; c += NTHR) { const int r = c >> 3, ch = c & 7; const long grow = row0 - 128 + r; v4u kv = {0u, 0u, 0u, 0u}, vv = {0u, 0u, 0u, 0u};
                if (grow >= (long)b * SEQ) { kv = *(const v4u*)(Z + (size_t)grow * NIN + ZK + 64 * kvh + 8 * ch); vv = *(const v4u*)(Z + (size_t)grow * NIN + ZV + 64 * kvh + 8 * ch); }
                *(LAS v4u*)(Ks + r * KP + 8 * ch) = kv; *(LAS v4u*)(Vs + r * KP + 8 * ch) = vv; }
            __syncthreads();
            const int i = F.tid & 127, gs = F.tid >> 7;
            for (int gg = 0; gg < 2; ++gg) {
                const int head = kvh * 8 + gs + 4 * gg;
                float q[64], o[64];
                const bf16_t* qp = Z + (size_t)(row0 + i) * NIN + ZQ + 64 * head;
#pragma unroll
                for (int c = 0; c < 8; ++c) { float f[8]; unpack8(*(const v4u*)(qp + 8 * c), f);
#pragma unroll
                    for (int j = 0; j < 8; ++j) q[8 * c + j] = f[j]; }
#pragma unroll
                for (int d = 0; d < 64; ++d) o[d] = 0.f;
                float mrun = sinks[head] * LOG2E, l = 1.f;
                const int s0 = (nblk == 0) ? 127 - i : 0;
                for (int s = s0; s < 128; ++s) { const int j = i + 1 + s;
                    float dot = 0.f;
#pragma unroll
                    for (int c = 0; c < 8; ++c) { float f[8]; unpack8(*(const LAS v4u*)(Ks + j * KP + 8 * c), f);
#pragma unroll
                        for (int e = 0; e < 8; ++e) dot += q[8 * c + e] * f[e]; }
                    const float mn = fmaxf(mrun, dot), corr = __builtin_amdgcn_exp2f(mrun - mn), p = __builtin_amdgcn_exp2f(dot - mn);
                    l = l * corr + p; mrun = mn;
#pragma unroll
                    for (int c = 0; c < 8; ++c) { float f[8]; unpack8(*(const LAS v4u*)(Vs + j * KP + 8 * c), f);
#pragma unroll
                        for (int e = 0; e < 8; ++e) o[8 * c + e] = o[8 * c + e] * corr + p * f[e]; }
                }
                const float inv = 1.f / l;
                bf16_t* op = BO + (size_t)(row0 + i) * DM + 64 * head;
#pragma unroll
                for (int c = 0; c < 8; ++c) { float f[8];
#pragma unroll
                    for (int e = 0; e < 8; ++e) f[e] = o[8 * c + e] * inv;
                    *(v4u*)(op + 8 * c) = pack8(f); }
            }
        }
        __syncthreads();
        if (BOTH(3)) GRID_BAR();
    }
    if (IN(4)) {
        pg8::Gemm g{DM, 256, 256, (size_t)128 * DM * 2, (size_t)128 * 256 * 2};
        pg8::TileOrder S; S.init(M / 256, 4, F.G, (int)blockIdx.x, XB, Wp_t, (size_t)256 * DM * 2, (size_t)256 * 256 * 2, (size_t)256 * 2);
        pg8::EpiStore E{AP, DM, nullptr};
        pg8::gemm_phase<pg8::EpiStore, pg8::TileOrder, true>(F.lds, g, S, E);
        if (BOTH(4)) GRID_BAR();
    }
    if (IN(5)) {
        bf16_t* MIX = XB;
        for (int idx = gt; idx < M * 128; idx += GT) { const int m = idx >> 7, ch = idx & 127;
            float gp[8], ga[8], a[8], b[8], o[8];
            unpack8(*(const v4u*)(Z + (size_t)m * NIN + ZG + 8 * ch), gp); unpack8(*(const v4u*)(Z + (size_t)m * NIN + ZG + DM + 8 * ch), ga);
            unpack8(*(const v4u*)(AP + (size_t)m * DM + 8 * ch), a); unpack8(*(const v4u*)(BO + (size_t)m * DM + 8 * ch), b);
#pragma unroll
            for (int j = 0; j < 8; ++j) o[j] = sigmoidf_(gp[j] + b_gate[8 * ch + j]) * a[j] + sigmoidf_(ga[j] + b_gate[DM + 8 * ch + j]) * b[j];
            *(v4u*)(MIX + (size_t)m * DM + 8 * ch) = pack8(o); }
        if (BOTH(5)) GRID_BAR();
    }
    if (IN(6)) {
        pg8::Gemm g{DM, DM, DM, (size_t)128 * DM * 2, (size_t)128 * DM * 2};
        pg8::TileOrder S; S.init(M / 256, DM / 256, F.G, (int)blockIdx.x, XB, Wo_t, (size_t)256 * DM * 2, (size_t)256 * DM * 2, 0);
        pg8::EpiRes E{x, out, DM};
        pg8::gemm_phase<pg8::EpiRes, pg8::TileOrder, true>(F.lds, g, S, E);
        if (BOTH(6)) GRID_BAR();
    }
    if (IN(7)) {
        for (int m = gw; m < M; m += NGW) row_bf16_rs(F.lane, out + (size_t)m * DM, XB + (size_t)m * DM, R2 + m);
        if (BOTH(7)) GRID_BAR();
    }
    for (int hh = 0; hh < 2; ++hh) {
        if (IN(8 + 2 * hh)) {
            const size_t r0 = (size_t)hh * (M / 2);
            pg8::Gemm g{DM, DM, DM, (size_t)128 * DM * 2, (size_t)128 * DM * 2};
            pg8::TileOrder S; S.init(M / 512, NUP / 256, F.G, (int)blockIdx.x, XB + r0 * DM, Wu_t, (size_t)256 * DM * 2, (size_t)256 * DM * 2, 0);
            pg8::EpiStore E{UP, NUP, R2 + r0};
            pg8::gemm_phase<pg8::EpiStore, pg8::TileOrder, true>(F.lds, g, S, E);
            if (BOTH(8 + 2 * hh)) GRID_BAR();
        }
        if (IN(9 + 2 * hh)) {
            const int r0 = hh * (M / 2);
            for (int idx = gt; idx < (M / 2) * (DFF / 8); idx += GT) { const int tl = idx / (DFF / 8), ch = idx - tl * (DFF / 8), m = r0 + tl, s = m & (SEQ - 1);
                float yg[8], yv[8];
#pragma unroll
                for (int j = 0; j < 8; ++j) { yg[j] = conv_b[8 * ch + j]; yv[j] = conv_b[DFF + 8 * ch + j]; }
#pragma unroll
                for (int k = 0; k < 3; ++k) { if (s >= k) { float fg[8], fv[8];
                    unpack8(*(const v4u*)(UP + (size_t)(tl - k) * NUP + 8 * ch), fg); unpack8(*(const v4u*)(UP + (size_t)(tl - k) * NUP + DFF + 8 * ch), fv);
#pragma unroll
                    for (int j = 0; j < 8; ++j) { yg[j] += conv_w[(size_t)(2 - k) * NUP + 8 * ch + j] * fg[j]; yv[j] += conv_w[(size_t)(2 - k) * NUP + DFF + 8 * ch + j] * fv[j]; } } }
                float o[8];
#pragma unroll
                for (int j = 0; j < 8; ++j) o[j] = yg[j] * sigmoidf_(yg[j]) * yv[j];
                *(v4u*)(HACT + (size_t)m * DFF + 8 * ch) = pack8(o); }
            if (BOTH(9 + 2 * hh)) GRID_BAR();
        }
    }
    if (IN(12)) {
        pg8::Gemm g{DFF, DFF, DFF, (size_t)128 * DFF * 2, (size_t)128 * DFF * 2};
        pg8::TileOrder S; S.init(M / 256, DM / 256, F.G, (int)blockIdx.x, HACT, Wd_t, (size_t)256 * DFF * 2, (size_t)256 * DFF * 2, 0);
        pg8::EpiRes E{out, out, DM};
        pg8::gemm_phase<pg8::EpiRes, pg8::TileOrder, true>(F.lds, g, S, E);
    }
#undef IN
#undef BOTH
}

extern "C" void kernel_launch(void* const* d_in, const int* in_sizes, int n_in, void* d_out, int out_size, void* d_ws, size_t ws_size, hipStream_t stream) {
    static int grid = 0;
    if (grid == 0) {
        if (n_in != 16 || in_sizes[0] != M * DM || out_size != M * DM || ws_size < WS_END) { fprintf(stderr, "kernel_launch: unexpected shapes (n_in %d, in0 %d, out %d, ws %zu); nothing launched\n", n_in, n_in > 0 ? in_sizes[0] : -1, out_size, ws_size); grid = -1; return; }
        int dev = 0, cus = 0, per_cu = 0;
        if (hipGetDevice(&dev) != hipSuccess || hipDeviceGetAttribute(&cus, hipDeviceAttributeMultiprocessorCount, dev) != hipSuccess) { grid = -1; return; }
        if (hipFuncSetAttribute((const void*)mega_fwd, hipFuncAttributeMaxDynamicSharedMemorySize, LDS_BYTES) != hipSuccess) { fprintf(stderr, "kernel_launch: hipFuncSetAttribute failed\n"); grid = -1; return; }
        if (hipOccupancyMaxActiveBlocksPerMultiprocessor(&per_cu, (const void*)mega_fwd, NTHR, LDS_BYTES) != hipSuccess || per_cu < 1) { fprintf(stderr, "kernel_launch: occupancy query reports %d blocks per CU\n", per_cu); (void)hipGetLastError(); grid = -1; return; }
        grid = cus;
    }
    if (grid < 0) return;
    if (hipMemsetAsync((char*)d_ws + WS_CTL, 0, CTL_ZERO_BYTES, stream) != hipSuccess) return;
    Args a{};
    for (int i = 0; i < 16; ++i) a.in[i] = d_in[i];
    a.out = (float*)d_out; a.ws = (unsigned char*)d_ws;
    for (int j = 0; j < 8; ++j) a.invf[j] = std::pow(500000.0, -(double)j / 8.0) / 6.283185307179586476925;
    if (MK_N_LAUNCHES == 1) { a.ph_lo = 0; a.ph_hi = N_PHASES; a.li = 0; hipLaunchKernelGGL(mega_fwd, dim3(grid), dim3(NTHR), LDS_BYTES, stream, a); }
    else for (int p = 0; p < N_PHASES; ++p) { a.ph_lo = p; a.ph_hi = p + 1; a.li = p; hipLaunchKernelGGL(mega_fwd, dim3(grid), dim3(NTHR), LDS_BYTES, stream, a); }
}
```

```cpp
#include <hip/hip_runtime.h>
#include <cstdio>
#include <cstdint>
#include <cmath>

#ifndef MK_N_LAUNCHES
#define MK_N_LAUNCHES 1
#endif

constexpr int DM = 1024, NBATCH = 8, SEQ = 4096, M = NBATCH * SEQ;
constexpr int NIN = 4352, DFF = 2816, NUP = 2 * DFF;
constexpr int ZQ = 1024, ZK = 2048, ZV = 2176, ZG = 2304;
constexpr float EPS = 1e-6f, LOG2E = 1.4426950408889634f;

#define GAS __attribute__((address_space(1)))
#define LAS __attribute__((address_space(3)))
typedef unsigned short bf16_t;
typedef unsigned v4u __attribute__((ext_vector_type(4)));
typedef float f32x4 __attribute__((ext_vector_type(4)));
typedef short bf16x8 __attribute__((ext_vector_type(8)));
typedef GAS unsigned gu32;
#define RLX_AGENT __ATOMIC_RELAXED, __HIP_MEMORY_SCOPE_AGENT
#define LDS_WAIT() asm volatile("s_waitcnt lgkmcnt(0)" ::: "memory")
#define VM_WAIT() asm volatile("s_waitcnt vmcnt(0)" ::: "memory")

__device__ __forceinline__ unsigned f2bf(float f) { unsigned u = __builtin_bit_cast(unsigned, f); return (u + 0x7fffu + ((u >> 16) & 1u)) >> 16; }
typedef float f32x2_t __attribute__((ext_vector_type(2))); typedef __bf16 bf16x2_t __attribute__((ext_vector_type(2)));
__device__ __forceinline__ unsigned pk2(float lo, float hi) { f32x2_t v = {lo, hi}; bf16x2_t b = __builtin_convertvector(v, bf16x2_t); return __builtin_bit_cast(unsigned, b); }
__device__ __forceinline__ float bflo(unsigned w) { return __uint_as_float(w << 16); }
__device__ __forceinline__ float bfhi(unsigned w) { return __uint_as_float(w & 0xffff0000u); }
__device__ __forceinline__ void unpack8(const v4u w, float (&f)[8]) { f[0] = bflo(w.x); f[1] = bfhi(w.x); f[2] = bflo(w.y); f[3] = bfhi(w.y); f[4] = bflo(w.z); f[5] = bfhi(w.z); f[6] = bflo(w.w); f[7] = bfhi(w.w); }
__device__ __forceinline__ v4u pack8(const float (&f)[8]) { v4u w; w.x = pk2(f[0], f[1]); w.y = pk2(f[2], f[3]); w.z = pk2(f[4], f[5]); w.w = pk2(f[6], f[7]); return w; }
__device__ __forceinline__ float sigmoidf_(float x) { return __builtin_amdgcn_rcpf(1.f + __builtin_amdgcn_exp2f(-x * LOG2E)); }

namespace pg8 {
constexpr int BM = 256, BK = 64, HALF = 128, HTB = HALF * BK * 2, STAGE_BYTES = 8 * HTB, NXCD = 8, WGM = 8;
__host__ __device__ __forceinline__ int lds_byte(int r, int c) { const int st = (r >> 4) * 2 + (c >> 5), rr = r & 15, cc = c & 31, ob = rr * 64 + cc * 2; return st * 1024 + (ob ^ (((ob >> 9) & 1) << 5)); }
__host__ __device__ __forceinline__ void stage_rc(int b, int& R, int& C) { const int st = b / 1024, sb = b % 1024, swz = sb ^ (((sb >> 9) & 1) << 5); R = (st >> 1) * 16 + swz / 64; C = (st & 1) * 32 + (swz % 64) / 2; }
__host__ __device__ __forceinline__ int perm32(int rho) { const int n = rho >> 4, i = rho & 15; return 8 * (i >> 2) + 4 * n + (i & 3); }

struct Unit { const char* a; const char* b; int pm, pn; };
struct Gemm { int lda, ldb, K; size_t hstepA, hstepB; };

struct TileOrder {
    int nM, nN, nwg, G, c; const char* A; const char* B; size_t sA, sB, sApn;
    __device__ void init(int nM_, int nN_, int G_, int c_, const void* A_, const void* B_, size_t sA_, size_t sB_, size_t sApn_) { nM = nM_; nN = nN_; nwg = nM * nN; G = G_; c = c_; A = (const char*)A_; B = (const char*)B_; sA = sA_; sB = sB_; sApn = sApn_; }
    __device__ bool next(int i, Unit& u) const {
        const long L = (long)i * G + c; if (L >= nwg) return false;
        int wgid = (int)L; { const int q = nwg / NXCD, r = nwg % NXCD, xcd = wgid % NXCD, off = wgid / NXCD; wgid = (xcd < r ? xcd * (q + 1) : r * (q + 1) + (xcd - r) * q) + off; }
        const int nig = WGM * nN, gid = wgid / nig, fm = gid * WGM, gsz = (nM - fm) < WGM ? (nM - fm) : WGM;
        u.pm = fm + ((wgid % nig) % gsz); u.pn = (wgid % nig) / gsz;
        u.a = A + (size_t)u.pm * sA + (size_t)u.pn * sApn; u.b = B + (size_t)u.pn * sB; return true;
    }
};

template <int BMODE> __device__ __forceinline__ int mapB(int R) { return BMODE == 1 ? ((R & ~31) + perm32(R & 31)) : R; }

template <class Epi, class Sched, bool ALIGN_EPI>
__device__ __forceinline__ void gemm_phase(LAS unsigned char* lds, const Gemm g, const Sched& S, const Epi& E) {
    const int tid = threadIdx.x, wid = __builtin_amdgcn_readfirstlane(tid >> 6), lane = tid & 63, wr = wid >> 2, wc = wid & 3, fr = lane & 15, fq = lane >> 4;
    const int nt = g.K / BK;
    unsigned voffA[2], voffB[2];
#pragma unroll
    for (int i = 0; i < 2; ++i) { int R, C; stage_rc(tid * 16 + i * 8192, R, C); const int Rb = mapB<Epi::BMODE>(R);
        voffA[i] = (unsigned)(R * g.lda + C) * 2u; voffB[i] = (unsigned)(Rb * g.ldb + C) * 2u; }
    const size_t kstep = (size_t)(BK * 2);
    const size_t hstepA = g.hstepA, hstepB = g.hstepB;
    const unsigned ldsw = (unsigned)wid * 1024u;
    const int aoff = lds_byte(wr * 64 + fr, fq * 8), boff = lds_byte(wc * 32 + fr, fq * 8);
#define PG8_SA(b, h) (((b) * 2 + (h)) * HTB)
#define PG8_SB(b, h) ((4 + (b) * 2 + (h)) * HTB)
#define PG8_STAGE(bufoff, gbase, voff) do { _Pragma("unroll") for (int _i = 0; _i < 2; ++_i) \
        __builtin_amdgcn_global_load_lds((const unsigned*)((const char*)(gbase) + (voff)[_i]), (LAS unsigned*)(lds + (bufoff) + ldsw + _i * 8192), 16, 0, 0); } while (0)
#define PG8_LDA(dst, b, h) do { _Pragma("unroll") for (int m = 0; m < 4; ++m) _Pragma("unroll") for (int k = 0; k < 2; ++k) dst[m][k] = *(const LAS bf16x8*)(lds + PG8_SA(b, h) + aoff + m * 2048 + k * 1024); } while (0)
#define PG8_LDB(dst, b, h) do { _Pragma("unroll") for (int n = 0; n < 2; ++n) _Pragma("unroll") for (int k = 0; k < 2; ++k) dst[n][k] = *(const LAS bf16x8*)(lds + PG8_SB(b, h) + boff + n * 2048 + k * 1024); } while (0)
#define PG8_MMA(ai, bj, At, Bt) do { __builtin_amdgcn_s_setprio(1); _Pragma("unroll") for (int m = 0; m < 4; ++m) _Pragma("unroll") for (int n = 0; n < 2; ++n) _Pragma("unroll") for (int k = 0; k < 2; ++k) \
        acc[ai][bj][m][n] = __builtin_amdgcn_mfma_f32_16x16x32_bf16(Bt[n][k], At[m][k], acc[ai][bj][m][n], 0, 0, 0); __builtin_amdgcn_s_setprio(0); } while (0)
#define PG8_WAIT_V(n) asm volatile("s_waitcnt vmcnt(" #n ")" ::: "memory")
#define PG8_WAIT_L(n) asm volatile("s_waitcnt lgkmcnt(" #n ")" ::: "memory")
#define PG8_BAR __builtin_amdgcn_s_barrier()
#define PG8_SCHED __builtin_amdgcn_sched_barrier(0)
    Unit cur, nxt; int ui = 0;
    if (!S.next(0, cur)) return;
    f32x4 acc[2][2][4][2];
#pragma unroll
    for (int a = 0; a < 2; ++a)
#pragma unroll
        for (int b = 0; b < 2; ++b)
#pragma unroll
            for (int m = 0; m < 4; ++m)
#pragma unroll
                for (int n = 0; n < 2; ++n) acc[a][b][m][n] = (f32x4){0.f, 0.f, 0.f, 0.f};
    bf16x8 At[4][2], B0[2][2], B1[2][2];
    const char* cA = cur.a; const char* cB = cur.b;
    PG8_STAGE(PG8_SB(0, 0), cB, voffB); PG8_STAGE(PG8_SB(0, 1), cB + hstepB, voffB); PG8_STAGE(PG8_SA(0, 0), cA, voffA); PG8_STAGE(PG8_SA(0, 1), cA + hstepA, voffA);
    if (wr == 1) PG8_BAR;
    PG8_WAIT_V(2); PG8_BAR;
    PG8_STAGE(PG8_SB(1, 0), cB + kstep, voffB); PG8_STAGE(PG8_SA(1, 0), cA + kstep, voffA); PG8_STAGE(PG8_SB(1, 1), cB + hstepB + kstep, voffB);
    PG8_WAIT_V(6); PG8_BAR;
    for (;;) {
        const bool has_next = S.next(ui + 1, nxt);
        const char* nA = has_next ? nxt.a : cA; const char* nB = has_next ? nxt.b : cB;
        for (int t = 0; t < nt; t += 2) {
            const bool last = (t == nt - 2);
            const char* a1 = cA + (size_t)(t + 1) * kstep;
            const char* a2 = last ? nA : cA + (size_t)(t + 2) * kstep; const char* b2 = last ? nB : cB + (size_t)(t + 2) * kstep;
            const char* a3 = a2 + kstep; const char* b3 = b2 + kstep;
            PG8_LDB(B0, 0, 0); PG8_LDB(B1, 0, 1); PG8_SCHED; PG8_LDA(At, 0, 0); PG8_STAGE(PG8_SA(1, 1), a1 + hstepA, voffA);
            PG8_WAIT_V(8); PG8_WAIT_L(0); PG8_BAR; PG8_MMA(0, 0, At, B0); PG8_MMA(0, 1, At, B1); PG8_BAR; PG8_SCHED;
            PG8_LDA(At, 0, 1); PG8_STAGE(PG8_SB(0, 0), b2, voffB); PG8_STAGE(PG8_SB(0, 1), b2 + hstepB, voffB); PG8_STAGE(PG8_SA(0, 0), a2, voffA);
            PG8_WAIT_V(8); PG8_WAIT_L(0); PG8_BAR; PG8_MMA(1, 0, At, B0); PG8_MMA(1, 1, At, B1); PG8_BAR; PG8_SCHED;
            PG8_LDB(B0, 1, 0); PG8_LDB(B1, 1, 1); PG8_SCHED; PG8_LDA(At, 1, 0); PG8_STAGE(PG8_SA(0, 1), a2 + hstepA, voffA);
            PG8_WAIT_V(8); PG8_WAIT_L(0); PG8_BAR; PG8_MMA(0, 0, At, B0); PG8_MMA(0, 1, At, B1); PG8_BAR; PG8_SCHED;
            PG8_LDA(At, 1, 1); PG8_STAGE(PG8_SB(1, 0), b3, voffB); PG8_STAGE(PG8_SB(1, 1), b3 + hstepB, voffB); PG8_STAGE(PG8_SA(1, 0), a3, voffA);
            PG8_WAIT_V(8); PG8_WAIT_L(0); PG8_BAR; PG8_MMA(1, 0, At, B0); PG8_MMA(1, 1, At, B1); PG8_BAR; PG8_SCHED;
        }
        if constexpr (ALIGN_EPI) { if (wr == 0) PG8_BAR; }
        E(acc, cur, wr, wc, fr, fq);
        if (!has_next) break;
#pragma unroll
        for (int a = 0; a < 2; ++a)
#pragma unroll
            for (int b = 0; b < 2; ++b)
#pragma unroll
                for (int m = 0; m < 4; ++m)
#pragma unroll
                    for (int n = 0; n < 2; ++n) acc[a][b][m][n] = (f32x4){0.f, 0.f, 0.f, 0.f};
        cur = nxt; cA = nA; cB = nB; ++ui;
        if constexpr (ALIGN_EPI) { if (wr == 1) PG8_BAR; }
    }
    PG8_WAIT_V(0);
    if constexpr (!ALIGN_EPI) { if (wr == 0) PG8_BAR; }
    PG8_BAR;
#undef PG8_SA
#undef PG8_SB
#undef PG8_STAGE
#undef PG8_LDA
#undef PG8_LDB
#undef PG8_MMA
#undef PG8_WAIT_V
#undef PG8_WAIT_L
#undef PG8_BAR
#undef PG8_SCHED
}

struct EpiStore {
    static constexpr int BMODE = 1;
    bf16_t* O; int ldc; const float* rs; const float* ssq;
    __device__ __forceinline__ void operator()(const f32x4 (&acc)[2][2][4][2], const Unit& u, int wr, int wc, int fr, int fq) const {
        const int row0 = u.pm * BM + wr * 64 + fr, col0 = u.pn * BM + wc * 32 + 8 * fq;
#pragma unroll
        for (int ai = 0; ai < 2; ++ai)
#pragma unroll
            for (int m = 0; m < 4; ++m) { const int row = row0 + ai * HALF + m * 16; float s = rs ? rs[row] : 1.f;
                if (ssq) { const f32x4 p = *(const f32x4*)(ssq + (size_t)row * 16 + 4 * fq); float t = (p.x + p.y) + (p.z + p.w); t += __shfl_xor(t, 16); t += __shfl_xor(t, 32); s = 1.f / sqrtf(t * (1.f / 1024.f) + EPS); }
                bf16_t* rowp = O + (size_t)row * ldc + col0;
#pragma unroll
                for (int bj = 0; bj < 2; ++bj) { const f32x4 v0 = acc[ai][bj][m][0] * s, v1 = acc[ai][bj][m][1] * s;
                    v4u w; w.x = pk2(v0[0], v0[1]); w.y = pk2(v0[2], v0[3]); w.z = pk2(v1[0], v1[1]); w.w = pk2(v1[2], v1[3]);
                    *(v4u*)(rowp + bj * HALF) = w; } }
    }
};
struct EpiRes {
    static constexpr int BMODE = 0;
    const float* base; float* out; int ldc;
    __device__ __forceinline__ void operator()(const f32x4 (&acc)[2][2][4][2], const Unit& u, int wr, int wc, int fr, int fq) const {
        const int row0 = u.pm * BM + wr * 64 + fr, col0 = u.pn * BM + wc * 32 + 4 * fq;
#pragma unroll
        for (int ai = 0; ai < 2; ++ai)
#pragma unroll
            for (int m = 0; m < 4; ++m) { const size_t off = (size_t)(row0 + ai * HALF + m * 16) * ldc + col0;
#pragma unroll
                for (int bj = 0; bj < 2; ++bj)
#pragma unroll
                    for (int n = 0; n < 2; ++n) { const f32x4 b = *(const f32x4*)(base + off + bj * HALF + n * 16); *(f32x4*)(out + off + bj * HALF + n * 16) = b + acc[ai][bj][m][n]; } }
    }
};
struct EpiMix {
    static constexpr int BMODE = 1;
    const bf16_t* Zg; int ldz; const float* bg; const bf16_t* BO; bf16_t* MIX;
    __device__ __forceinline__ void operator()(const f32x4 (&acc)[2][2][4][2], const Unit& u, int wr, int wc, int fr, int fq) const {
        const int row0 = u.pm * BM + wr * 64 + fr, col0 = u.pn * BM + wc * 32 + 8 * fq;
#pragma unroll
        for (int ai = 0; ai < 2; ++ai)
#pragma unroll
            for (int m = 0; m < 4; ++m) { const size_t row = (size_t)(row0 + ai * HALF + m * 16);
#pragma unroll
                for (int bj = 0; bj < 2; ++bj) { const int c = col0 + bj * HALF;
                    float gp[8], ga[8], bo[8], o[8];
                    unpack8(*(const v4u*)(Zg + row * ldz + c), gp); unpack8(*(const v4u*)(Zg + row * ldz + DM + c), ga); unpack8(*(const v4u*)(BO + row * DM + c), bo);
                    const f32x4 bp0 = *(const f32x4*)(bg + c), bp1 = *(const f32x4*)(bg + c + 4), ba0 = *(const f32x4*)(bg + DM + c), ba1 = *(const f32x4*)(bg + DM + c + 4);
                    const f32x4 a0 = acc[ai][bj][m][0], a1 = acc[ai][bj][m][1];
#pragma unroll
                    for (int j = 0; j < 4; ++j) { o[j] = sigmoidf_(gp[j] + bp0[j]) * a0[j] + sigmoidf_(ga[j] + ba0[j]) * bo[j]; o[4 + j] = sigmoidf_(gp[4 + j] + bp1[j]) * a1[j] + sigmoidf_(ga[4 + j] + ba1[j]) * bo[4 + j]; }
                    *(v4u*)(MIX + row * DM + c) = pack8(o); asm volatile("" ::: "memory"); } }
    }
};
struct EpiOut1 {
    static constexpr int BMODE = 1;
    const float* x; float* out; bf16_t* X1B; float* SSQ;
    __device__ __forceinline__ void operator()(const f32x4 (&acc)[2][2][4][2], const Unit& u, int wr, int wc, int fr, int fq) const {
        const int row0 = u.pm * BM + wr * 64 + fr, col0 = u.pn * BM + wc * 32 + 8 * fq;
#pragma unroll
        for (int ai = 0; ai < 2; ++ai)
#pragma unroll
            for (int m = 0; m < 4; ++m) { const size_t row = (size_t)(row0 + ai * HALF + m * 16); float ss = 0.f;
#pragma unroll
                for (int bj = 0; bj < 2; ++bj) { const size_t off = row * DM + col0 + bj * HALF;
                    const f32x4 v0 = *(const f32x4*)(x + off) + acc[ai][bj][m][0], v1 = *(const f32x4*)(x + off + 4) + acc[ai][bj][m][1];
                    *(f32x4*)(out + off) = v0; *(f32x4*)(out + off + 4) = v1;
                    ss += (v0[0] * v0[0] + v0[1] * v0[1]) + (v0[2] * v0[2] + v0[3] * v0[3]) + (v1[0] * v1[0] + v1[1] * v1[1]) + (v1[2] * v1[2] + v1[3] * v1[3]);
                    v4u w; w.x = pk2(v0[0], v0[1]); w.y = pk2(v0[2], v0[3]); w.z = pk2(v1[0], v1[1]); w.w = pk2(v1[2], v1[3]);
                    *(v4u*)(X1B + off) = w; }
                ss += __shfl_xor(ss, 16); ss += __shfl_xor(ss, 32);
                if (fq == 0) SSQ[row * 16 + u.pn * 4 + wc] = ss; asm volatile("" ::: "memory"); }
    }
};
}

constexpr int NWAVES = 8, NTHR = NWAVES * 64;
constexpr int N_PHASES = 13;
constexpr size_t MiB = 1u << 20;
constexpr size_t WS_CTL = 0, CTL_ZERO_BYTES = 1 * MiB;
constexpr size_t WS_R1 = 1 * MiB;
constexpr size_t WS_SSQ = 498 * MiB;
constexpr size_t WS_TAB = 2 * MiB;
constexpr size_t WS_WIN = 4 * MiB, WS_WP = 13 * MiB, WS_WO = 14 * MiB, WS_WU = 16 * MiB, WS_WD = 28 * MiB;
constexpr size_t WS_XB = 34 * MiB;
constexpr size_t WS_Z = 98 * MiB;
constexpr size_t WS_UP = WS_Z, WS_HACT = WS_Z + 176 * MiB;
constexpr size_t WS_B = 370 * MiB;
constexpr size_t WS_AP = 434 * MiB;
constexpr size_t WS_END = 500 * MiB;
static_assert(WS_WIN + (size_t)NIN * DM * 2 <= WS_WP && WS_WU + (size_t)NUP * DM * 2 <= WS_WD && WS_WD + (size_t)DM * DFF * 2 <= WS_XB, "weights map");
static_assert(WS_Z + (size_t)M * NIN * 2 <= WS_B && WS_HACT + (size_t)M * DFF * 2 <= WS_SSQ && WS_AP + (size_t)M * DM * 2 <= WS_SSQ && (size_t)(M / 2) * NUP * 2 <= 176 * MiB, "activation map");
constexpr int CW_BAR = 4096;
constexpr int RING_BYTES = 131072, LDSCTL_OFF = RING_BYTES, MISC_OFF = LDSCTL_OFF + 320, LDS_BYTES = 147456;

#define XB_TMO      128
#define XB_XCNT(j)  (256  + 64 * (j))
#define XB_XSUB(j)  (1280 + 64 * (j))
#define XB_XGEN(j)  (2304 + 64 * (j))
#define XB_TOP      3328
#define XB_TOPGEN   3392
#define XCD_BAR_WORDS 3456
#define XB_SPIN_CAP (1u << 18)
__device__ __forceinline__ unsigned xb_ld(unsigned* p)              { return __hip_atomic_load(p, __ATOMIC_RELAXED, __HIP_MEMORY_SCOPE_AGENT); }
__device__ __forceinline__ unsigned xb_add(unsigned* p, unsigned v) { return __hip_atomic_fetch_add(p, v, __ATOMIC_RELAXED, __HIP_MEMORY_SCOPE_AGENT); }
__device__ __forceinline__ unsigned xb_xcc_id() { return (unsigned)__builtin_amdgcn_s_getreg((3 << 11) | 20) & 0xFu; }
#define XB_SPIN(cond, bar) do { unsigned _sp = 0; while (cond) { __builtin_amdgcn_s_sleep(1); \
    if ((++_sp & 255u) == 0u) { if (xb_ld(&(bar)[XB_TMO])) break; if (_sp > XB_SPIN_CAP) { atomicAdd(&(bar)[XB_TMO], 1u); break; } } } } while (0)
struct XcdBarrier { unsigned* bar; unsigned x; volatile LAS unsigned* st; };
__device__ __forceinline__ XcdBarrier xcd_barrier_post(unsigned* bar, volatile LAS unsigned* st) {
    XcdBarrier b; b.bar = bar; b.x = xb_xcc_id(); b.st = st;
    if (threadIdx.x == 0) (void)xb_add(&bar[XB_XCNT(b.x)], 1u);
    return b;
}
__device__ __forceinline__ void xcd_barrier_complete(unsigned* bar, unsigned x, unsigned& nloc, unsigned& nx) {
    const unsigned G = gridDim.x * gridDim.y * gridDim.z;
    unsigned sum, cnt, mine, sp = 0u;
    for (;;) {
        sum = 0u; cnt = 0u; mine = 0u;
#pragma unroll
        for (unsigned j = 0; j < 16; ++j) { const unsigned c = xb_ld(&bar[XB_XCNT(j)]); sum += c; cnt += (c > 0u) ? 1u : 0u; mine = (j == x) ? c : mine; }
        if (sum == G) break;
        __builtin_amdgcn_s_sleep(1);
        if ((++sp & 255u) == 0u) { if (xb_ld(&bar[XB_TMO])) break; if (sp > XB_SPIN_CAP) { atomicAdd(&bar[XB_TMO], 1u); break; } }
    }
    nloc = mine > 0u ? mine : 1u; nx = cnt > 0u ? cnt : 1u;
}
__device__ __forceinline__ void xcd_barrier(const XcdBarrier& b) {
    asm volatile("s_waitcnt vmcnt(0)" ::: "memory");
    __syncthreads();
    if (threadIdx.x == 0) {
        unsigned* bar = b.bar;
        __builtin_amdgcn_s_waitcnt(0);
        unsigned nloc = b.st[0], nx = b.st[1];
        if (nloc == 0u) { xcd_barrier_complete(bar, b.x, nloc, nx); b.st[0] = nloc; b.st[1] = nx; }
        const unsigned old = xb_add(&bar[XB_XSUB(b.x)], 1u);
        const unsigned gen = old / nloc;
        if (old + 1u == (gen + 1u) * nloc) {
            __builtin_amdgcn_fence(__ATOMIC_RELEASE, "agent");
            asm volatile("s_waitcnt vmcnt(0)" ::: "memory");
            const unsigned og = xb_add(&bar[XB_TOP], 1u);
            const unsigned tg = og / nx;
            if (og + 1u == (tg + 1u) * nx) xb_add(&bar[XB_TOPGEN], 1u);
            else XB_SPIN(xb_ld(&bar[XB_TOPGEN]) == tg, bar);
            __builtin_amdgcn_fence(__ATOMIC_ACQUIRE, "agent");
            xb_add(&bar[XB_XGEN(b.x)], 1u);
            asm volatile("s_waitcnt vmcnt(0)" ::: "memory");
        } else {
            XB_SPIN(xb_ld(&bar[XB_XGEN(b.x)]) == gen, bar);
            __builtin_amdgcn_fence(__ATOMIC_ACQUIRE, "agent");
            asm volatile("s_waitcnt vmcnt(0)" ::: "memory");
        }
    }
    __syncthreads();
}

struct Frame {
    LAS unsigned char* lds; volatile LAS unsigned* MISC; gu32* ctl;
    int tid, lane, wave, vcu, G;
};
__device__ __forceinline__ float wave_sum(float v) {
#pragma unroll
    for (int o = 1; o < 64; o <<= 1) v += __shfl_xor(v, o);
    return v;
}

__device__ __forceinline__ void p0_transpose_item(const float* W, int K, int N, bf16_t* WT, const float* kscale, const float* nscale, LAS float* scr, int item, int lane) {
    const int nblk = N / 32, kb = item / nblk, nb = item % nblk, k0 = 64 * kb, n0 = 32 * nb;
    const float ns = nscale ? nscale[n0 + (lane & 31)] : 1.f;
#pragma unroll 8
    for (int i = 0; i < 32; ++i) { const int kk = 2 * i + (lane >> 5); const float ks = kscale ? kscale[k0 + kk] : 1.f; scr[kk * 33 + (lane & 31)] = W[(size_t)(k0 + kk) * N + n0 + (lane & 31)] * ks * ns; }
    LDS_WAIT(); asm volatile("" ::: "memory");
    const int c = lane & 7;
#pragma unroll
    for (int j = 0; j < 4; ++j) { const int n = (lane >> 3) + 8 * j; const LAS float* s = scr + (8 * c) * 33 + n;
        v4u o; o.x = pk2(s[0 * 33], s[1 * 33]); o.y = pk2(s[2 * 33], s[3 * 33]); o.z = pk2(s[4 * 33], s[5 * 33]); o.w = pk2(s[6 * 33], s[7 * 33]);
        *(GAS v4u*)(WT + (size_t)(n0 + n) * K + k0 + 8 * c) = o; }
    LDS_WAIT(); asm volatile("" ::: "memory");
}
__device__ __forceinline__ void row_bf16_rs(int lane, const float* xrow, bf16_t* orow, float* rs) {
    const GAS f32x4* xr = (const GAS f32x4*)xrow + lane;
    f32x4 v[4]; float s = 0.f;
#pragma unroll
    for (int j = 0; j < 4; ++j) { v[j] = xr[64 * j]; s += (v[j].x * v[j].x + v[j].y * v[j].y) + (v[j].z * v[j].z + v[j].w * v[j].w); }
    s = wave_sum(s);
    if (lane == 0) *rs = 1.f / sqrtf(s * (1.f / DM) + EPS);
    GAS unsigned long long* o8 = (GAS unsigned long long*)orow + lane;
#pragma unroll
    for (int j = 0; j < 4; ++j) o8[64 * j] = (unsigned long long)pk2(v[j].x, v[j].y) | ((unsigned long long)pk2(v[j].z, v[j].w) << 32);
}

typedef float f32x16 __attribute__((ext_vector_type(16)));
typedef short s16x4 __attribute__((ext_vector_type(4)));
constexpr int AT_KP = 72, AT_VP = 260;
constexpr int AT_K_OFF = 0, AT_V_OFF = 256 * AT_KP * 2, AT_W_OFF = 71680, AT_W_BYTES = 4608;
static_assert(AT_V_OFF + 64 * AT_VP * 2 <= AT_W_OFF && AT_W_OFF + 8 * AT_W_BYTES <= RING_BYTES, "attention LDS map");
__device__ __forceinline__ int crow16(int r, int hi) { return (r & 3) + 8 * (r >> 2) + 4 * hi; }
__device__ __forceinline__ void attn_phase(Frame& F, const bf16_t* Q, int ldq, const bf16_t* K, int ldk, const bf16_t* V, int ldv, const float* sinks, bf16_t* BO) {
    LAS bf16_t* Ks = (LAS bf16_t*)(F.lds + AT_K_OFF); LAS bf16_t* Vt = (LAS bf16_t*)(F.lds + AT_V_OFF);
    LAS bf16_t* stg = (LAS bf16_t*)(F.lds + AT_W_OFF + F.wave * AT_W_BYTES); LAS float* wsf = (LAS float*)(F.lds + AT_W_OFF + F.wave * AT_W_BYTES + 4096);
    const int lane = F.lane, r32 = lane & 31, hi = lane >> 5;
    const float NEG = -INFINITY;
    for (int unit = F.vcu; unit < NBATCH * 32 * 2; unit += F.G) {
        const int kvh = unit & 1, nblk = (unit >> 1) & 31, b = unit >> 6;
        const long row0 = (long)b * SEQ + (long)nblk * 128;
        __syncthreads();
#pragma unroll
        for (int i = 0; i < 4; ++i) { const int c = F.tid + i * NTHR, r = c >> 3, ch = c & 7; const long grow = row0 - 128 + r; v4u kv = {0u, 0u, 0u, 0u}, vv = {0u, 0u, 0u, 0u};
            if (grow >= (long)b * SEQ) { kv = *(const v4u*)(K + (size_t)grow * ldk + 64 * kvh + 8 * ch); vv = *(const v4u*)(V + (size_t)grow * ldv + 64 * kvh + 8 * ch); }
            *(LAS v4u*)(Ks + r * AT_KP + 8 * ch) = kv;
            LAS bf16_t* vp = Vt + (8 * ch) * AT_VP + r;
            vp[0 * AT_VP] = (bf16_t)(vv.x & 0xffffu); vp[1 * AT_VP] = (bf16_t)(vv.x >> 16); vp[2 * AT_VP] = (bf16_t)(vv.y & 0xffffu); vp[3 * AT_VP] = (bf16_t)(vv.y >> 16);
            vp[4 * AT_VP] = (bf16_t)(vv.z & 0xffffu); vp[5 * AT_VP] = (bf16_t)(vv.z >> 16); vp[6 * AT_VP] = (bf16_t)(vv.w & 0xffffu); vp[7 * AT_VP] = (bf16_t)(vv.w >> 16); }
        __syncthreads();
        const int head = kvh * 8 + F.wave;
        const float sinkv = sinks[head] * LOG2E;
#pragma unroll 1
        for (int c = 0; c < 4; ++c) {
            const bf16_t* qp = Q + (size_t)(row0 + 32 * c + r32) * ldq + 64 * head + 8 * hi;
            bf16x8 qf[4];
#pragma unroll
            for (int s = 0; s < 4; ++s) qf[s] = *(const bf16x8*)(qp + 16 * s);
            f32x16 S[5];
#pragma unroll
            for (int t = 0; t < 5; ++t) {
#pragma unroll
                for (int r = 0; r < 16; ++r) S[t][r] = 0.f;
                const LAS bf16_t* kp = Ks + ((c + t) * 32 + r32) * AT_KP + 8 * hi;
#pragma unroll
                for (int s = 0; s < 4; ++s) { const bf16x8 kf = *(const LAS bf16x8*)(kp + 16 * s); S[t] = __builtin_amdgcn_mfma_f32_32x32x16_bf16(kf, qf[s], S[t], 0, 0, 0); }
            }
#pragma unroll
            for (int r = 0; r < 16; ++r) { const int jj = crow16(r, hi); if (!(jj > r32)) S[0][r] = NEG; if (!(jj <= r32)) S[4][r] = NEG; }
#pragma unroll
            for (int t = 0; t < 5; ++t) { if (nblk == 0 && c + t < 4) {
#pragma unroll
                for (int r = 0; r < 16; ++r) S[t][r] = NEG; } }
            float mx = NEG;
#pragma unroll
            for (int t = 0; t < 5; ++t)
#pragma unroll
                for (int r = 0; r < 16; ++r) mx = fmaxf(mx, S[t][r]);
            mx = fmaxf(mx, __shfl_xor(mx, 32)); mx = fmaxf(mx, sinkv);
            float l = 0.f;
#pragma unroll
            for (int t = 0; t < 5; ++t)
#pragma unroll
                for (int r = 0; r < 16; ++r) { const float p = __builtin_amdgcn_exp2f(S[t][r] - mx); S[t][r] = p; l += p; }
            l += __shfl_xor(l, 32); l += __builtin_amdgcn_exp2f(sinkv - mx);
            f32x16 O[2];
#pragma unroll
            for (int r = 0; r < 16; ++r) { O[0][r] = 0.f; O[1][r] = 0.f; }
#pragma unroll
            for (int t = 0; t < 5; ++t)
#pragma unroll
                for (int s = 0; s < 2; ++s) {
                    v4u pw; pw.x = pk2(S[t][8 * s + 0], S[t][8 * s + 1]); pw.y = pk2(S[t][8 * s + 2], S[t][8 * s + 3]); pw.z = pk2(S[t][8 * s + 4], S[t][8 * s + 5]); pw.w = pk2(S[t][8 * s + 6], S[t][8 * s + 7]);
                    const bf16x8 xs = __builtin_bit_cast(bf16x8, pw);
#pragma unroll
                    for (int d0 = 0; d0 < 2; ++d0) { const LAS bf16_t* vp = Vt + (32 * d0 + r32) * AT_VP + (c + t) * 32 + 16 * s + 4 * hi;
                        const s16x4 lo = *(const LAS s16x4*)vp, hh = *(const LAS s16x4*)(vp + 8);
                        const bf16x8 vf = __builtin_shufflevector(lo, hh, 0, 1, 2, 3, 4, 5, 6, 7);
                        O[d0] = __builtin_amdgcn_mfma_f32_32x32x16_bf16(xs, vf, O[d0], 0, 0, 0); }
                }
            asm volatile("s_waitcnt lgkmcnt(0)" ::: "memory");
            if (hi == 0) wsf[r32] = 1.f / l;
            asm volatile("s_waitcnt lgkmcnt(0)" ::: "memory");
#pragma unroll
            for (int r = 0; r < 16; ++r) { const int qi = crow16(r, hi); const float inv = wsf[qi];
                stg[qi * 64 + r32] = (bf16_t)f2bf(O[0][r] * inv); stg[qi * 64 + 32 + r32] = (bf16_t)f2bf(O[1][r] * inv); }
            asm volatile("s_waitcnt lgkmcnt(0)" ::: "memory");
#pragma unroll
            for (int i = 0; i < 4; ++i) { const int row = i * 8 + (lane >> 3), ch = lane & 7; const v4u v = *(const LAS v4u*)(stg + row * 64 + ch * 8);
                *(v4u*)(BO + (size_t)(row0 + 32 * c + row) * DM + 64 * head + 8 * ch) = v; }
            asm volatile("s_waitcnt lgkmcnt(0)" ::: "memory");
        }
    }
    __syncthreads();
}

struct Args { const void* in[16]; float* out; unsigned char* ws; double invf[8]; int ph_lo, ph_hi, li, pad; };

__global__ void __launch_bounds__(NTHR, 2) mega_fwd(Args args) {
    extern __shared__ __attribute__((aligned(16))) unsigned char lds[];
    Frame F;
    F.lds = (LAS unsigned char*)lds;
    F.MISC = (volatile LAS unsigned*)(F.lds + MISC_OFF);
    F.tid = threadIdx.x; F.lane = F.tid & 63; F.wave = __builtin_amdgcn_readfirstlane(F.tid >> 6);
    F.G = gridDim.x; { const int bx = blockIdx.x; F.vcu = (F.G % 8 == 0) ? (bx % 8) * (F.G / 8) + bx / 8 : bx; }
    unsigned char* ws = args.ws;
    F.ctl = (gu32*)(ws + WS_CTL);
    const float* x = (const float*)args.in[0]; const int* positions = (const int*)args.in[1]; const float* attn_norm = (const float*)args.in[2];
    const float* w_in = (const float*)args.in[3]; const float* b_gate = (const float*)args.in[4]; const float* w_pool = (const float*)args.in[5];
    const float* pool_scale = (const float*)args.in[6]; const float* q_norm = (const float*)args.in[7]; const float* k_norm = (const float*)args.in[8];
    const float* sinks = (const float*)args.in[9]; const float* w_out = (const float*)args.in[10]; const float* ffn_norm = (const float*)args.in[11];
    const float* w_up = (const float*)args.in[12]; const float* conv_w = (const float*)args.in[13]; const float* conv_b = (const float*)args.in[14];
    const float* w_down = (const float*)args.in[15];
    float* out = args.out;
    float* R1 = (float*)(ws + WS_R1); float* SSQ = (float*)(ws + WS_SSQ); float* TAB = (float*)(ws + WS_TAB);
    bf16_t* Win_t = (bf16_t*)(ws + WS_WIN); bf16_t* Wp_t = (bf16_t*)(ws + WS_WP); bf16_t* Wo_t = (bf16_t*)(ws + WS_WO); bf16_t* Wu_t = (bf16_t*)(ws + WS_WU); bf16_t* Wd_t = (bf16_t*)(ws + WS_WD);
    bf16_t* XB = (bf16_t*)(ws + WS_XB); bf16_t* Z = (bf16_t*)(ws + WS_Z); bf16_t* UP = (bf16_t*)(ws + WS_UP); bf16_t* HACT = (bf16_t*)(ws + WS_HACT);
    bf16_t* BO = (bf16_t*)(ws + WS_B); bf16_t* AP = (bf16_t*)(ws + WS_AP);

    for (int u = F.tid; u < (LDS_BYTES - LDSCTL_OFF) / 4; u += NTHR) ((LAS unsigned*)(F.lds + LDSCTL_OFF))[u] = 0u;
    __syncthreads();
    XcdBarrier bar; bar.bar = (unsigned*)(F.ctl + CW_BAR); bar.x = 0; bar.st = nullptr;
    if (MK_N_LAUNCHES == 1) bar = xcd_barrier_post((unsigned*)(F.ctl + CW_BAR), F.MISC + 8);
#define GRID_BAR() do { if (MK_N_LAUNCHES == 1) xcd_barrier(bar); } while (0)
    const int lo = args.ph_lo, hi = args.ph_hi;
#define IN(k) (lo <= (k) && (k) < hi)
#define BOTH(k) (IN(k) && IN((k) + 1))
    const int gt = F.vcu * NTHR + F.tid, GT = F.G * NTHR;
    const int gw = F.vcu * NWAVES + F.wave, NGW = F.G * NWAVES;

    if (IN(0)) {
        LAS float* scr = (LAS float*)(F.lds + F.wave * 16384);
        constexpr int I_IN = (DM / 64) * (NIN / 32), I_P = (256 / 64) * (256 / 32), I_O = (DM / 64) * (DM / 32), I_U = (DM / 64) * (NUP / 32), I_D = (DFF / 64) * (DM / 32);
        constexpr int NITEMS = I_IN + 4 * I_P + I_O + I_U + I_D;
        for (int it = gw; it < NITEMS; it += NGW) {
            int r = it;
            if (r < I_IN) { p0_transpose_item(w_in, DM, NIN, Win_t, attn_norm, nullptr, scr, r, F.lane); continue; } r -= I_IN;
            if (r < 4 * I_P) { const int g = r / I_P; p0_transpose_item(w_pool + (size_t)g * 65536, 256, 256, Wp_t + (size_t)g * 65536, nullptr, pool_scale + 256 * g, scr, r % I_P, F.lane); continue; } r -= 4 * I_P;
            if (r < I_O) { p0_transpose_item(w_out, DM, DM, Wo_t, nullptr, nullptr, scr, r, F.lane); continue; } r -= I_O;
            if (r < I_U) { p0_transpose_item(w_up, DM, NUP, Wu_t, ffn_norm, nullptr, scr, r, F.lane); continue; } r -= I_U;
            p0_transpose_item(w_down, DFF, DM, Wd_t, nullptr, nullptr, scr, r, F.lane);
        }
        for (int m = gw; m < M; m += NGW) row_bf16_rs(F.lane, x + (size_t)m * DM, XB + (size_t)m * DM, R1 + m);
        for (int idx = gt; idx < M * 8; idx += GT) { const int m = idx >> 3, j = idx & 7;
            double rev = (double)positions[m] * args.invf[j]; rev -= floor(rev); const float fr = (float)rev;
            TAB[(size_t)m * 16 + j] = __builtin_amdgcn_cosf(fr); TAB[(size_t)m * 16 + 8 + j] = __builtin_amdgcn_sinf(fr); }
        if (BOTH(0)) GRID_BAR();
    }
    if (IN(1)) {
        pg8::Gemm g{DM, DM, DM, (size_t)128 * DM * 2, (size_t)128 * DM * 2};
        pg8::TileOrder S; S.init(M / 256, NIN / 256, F.G, (int)blockIdx.x, XB, Win_t, (size_t)256 * DM * 2, (size_t)256 * DM * 2, 0);
        pg8::EpiStore E{Z, NIN, R1, nullptr};
        pg8::gemm_phase<pg8::EpiStore, pg8::TileOrder, true>(F.lds, g, S, E);
        if (BOTH(1)) GRID_BAR();
    }
    if (IN(2)) {
        for (int it = gt >> 3; it < M * 18; it += GT >> 3) {
            const int m = it / 18, h = it - m * 18, sub = F.tid & 7;
            bf16_t* p = Z + (size_t)m * NIN + ZQ + 64 * h + 8 * sub;
            float v[8]; unpack8(*(const v4u*)p, v);
            float ss = 0.f;
#pragma unroll
            for (int j = 0; j < 8; ++j) ss += v[j] * v[j];
            ss += __shfl_xor(ss, 1); ss += __shfl_xor(ss, 2); ss += __shfl_xor(ss, 4);
            const float rr = 1.f / sqrtf(ss * (1.f / 64.f) + EPS);
            const float* nw = (h < 16 ? q_norm : k_norm) + 8 * sub;
#pragma unroll
            for (int j = 0; j < 8; ++j) v[j] = v[j] * rr * nw[j];
            float o[8];
#pragma unroll
            for (int j = 0; j < 8; ++j) { const float pr = __shfl_xor(v[j], 1); const float c = TAB[(size_t)m * 16 + j], s = TAB[(size_t)m * 16 + 8 + j];
                o[j] = sub == 0 ? v[j] * c - pr * s : (sub == 1 ? v[j] * c + pr * s : v[j]); }
            const float sc = h < 16 ? 0.125f * LOG2E : 1.f;
#pragma unroll
            for (int j = 0; j < 8; ++j) o[j] *= sc;
            *(v4u*)p = pack8(o);
        }
        bf16_t* P = XB;
        for (int idx = gt; idx < M * 128; idx += GT) { const int m = idx >> 7, ch = idx & 127, g = ch >> 5, w = 2 << g, t = m & (SEQ - 1), cnt = (t + 1 < w) ? t + 1 : w;
            float a[8], u0[8];
#pragma unroll
            for (int j = 0; j < 8; ++j) a[j] = 0.f;
            for (int k = 0; k < cnt; ++k) { float f[8]; unpack8(*(const v4u*)(Z + (size_t)(m - k) * NIN + 8 * ch), f);
#pragma unroll
                for (int j = 0; j < 8; ++j) { a[j] += f[j]; if (k == 0) u0[j] = f[j]; } }
            const float ic = 1.f / (float)cnt;
#pragma unroll
            for (int j = 0; j < 8; ++j) a[j] = a[j] * ic - u0[j];
            *(v4u*)(P + (size_t)m * DM + 8 * ch) = pack8(a); }
        if (BOTH(2)) GRID_BAR();
    }
    if (IN(3)) {
        attn_phase(F, Z + ZQ, NIN, Z + ZK, NIN, Z + ZV, NIN, sinks, BO);
        if (BOTH(3)) GRID_BAR();
    }
    if (IN(4)) {
        pg8::Gemm g{DM, 256, 256, (size_t)128 * DM * 2, (size_t)128 * 256 * 2};
        pg8::TileOrder S; S.init(M / 256, 4, F.G, (int)blockIdx.x, XB, Wp_t, (size_t)256 * DM * 2, (size_t)256 * 256 * 2, (size_t)256 * 2);
        pg8::EpiMix E{Z + ZG, NIN, b_gate, BO, AP};
        pg8::gemm_phase<pg8::EpiMix, pg8::TileOrder, true>(F.lds, g, S, E);
        if (BOTH(4)) GRID_BAR();
    }
    if (IN(6)) {
        pg8::Gemm g{DM, DM, DM, (size_t)128 * DM * 2, (size_t)128 * DM * 2};
        pg8::TileOrder S; S.init(M / 256, DM / 256, F.G, (int)blockIdx.x, AP, Wo_t, (size_t)256 * DM * 2, (size_t)256 * DM * 2, 0);
        pg8::EpiOut1 E{x, out, XB, SSQ};
        pg8::gemm_phase<pg8::EpiOut1, pg8::TileOrder, true>(F.lds, g, S, E);
        if (BOTH(6)) GRID_BAR();
    }
    for (int hh = 0; hh < 2; ++hh) {
        if (IN(8 + 2 * hh)) {
            const size_t r0 = (size_t)hh * (M / 2);
            pg8::Gemm g{DM, DM, DM, (size_t)128 * DM * 2, (size_t)128 * DM * 2};
            pg8::TileOrder S; S.init(M / 512, NUP / 256, F.G, (int)blockIdx.x, XB + r0 * DM, Wu_t, (size_t)256 * DM * 2, (size_t)256 * DM * 2, 0);
            pg8::EpiStore E{UP, NUP, nullptr, SSQ + r0 * 16};
            pg8::gemm_phase<pg8::EpiStore, pg8::TileOrder, true>(F.lds, g, S, E);
            if (BOTH(8 + 2 * hh)) GRID_BAR();
        }
        if (IN(9 + 2 * hh)) {
            const int r0 = hh * (M / 2);
            for (int idx = gt; idx < (M / 2) * (DFF / 8); idx += GT) { const int tl = idx / (DFF / 8), ch = idx - tl * (DFF / 8), m = r0 + tl, s = m & (SEQ - 1);
                float yg[8], yv[8];
#pragma unroll
                for (int j = 0; j < 8; ++j) { yg[j] = conv_b[8 * ch + j]; yv[j] = conv_b[DFF + 8 * ch + j]; }
#pragma unroll
                for (int k = 0; k < 3; ++k) { if (s >= k) { float fg[8], fv[8];
                    unpack8(*(const v4u*)(UP + (size_t)(tl - k) * NUP + 8 * ch), fg); unpack8(*(const v4u*)(UP + (size_t)(tl - k) * NUP + DFF + 8 * ch), fv);
#pragma unroll
                    for (int j = 0; j < 8; ++j) { yg[j] += conv_w[(size_t)(2 - k) * NUP + 8 * ch + j] * fg[j]; yv[j] += conv_w[(size_t)(2 - k) * NUP + DFF + 8 * ch + j] * fv[j]; } } }
                float o[8];
#pragma unroll
                for (int j = 0; j < 8; ++j) o[j] = yg[j] * sigmoidf_(yg[j]) * yv[j];
                *(v4u*)(HACT + (size_t)m * DFF + 8 * ch) = pack8(o); }
            if (BOTH(9 + 2 * hh)) GRID_BAR();
        }
    }
    if (IN(12)) {
        pg8::Gemm g{DFF, DFF, DFF, (size_t)128 * DFF * 2, (size_t)128 * DFF * 2};
        pg8::TileOrder S; S.init(M / 256, DM / 256, F.G, (int)blockIdx.x, HACT, Wd_t, (size_t)256 * DFF * 2, (size_t)256 * DFF * 2, 0);
        pg8::EpiRes E{out, out, DM};
        pg8::gemm_phase<pg8::EpiRes, pg8::TileOrder, true>(F.lds, g, S, E);
    }
#undef IN
#undef BOTH
}

extern "C" void kernel_launch(void* const* d_in, const int* in_sizes, int n_in, void* d_out, int out_size, void* d_ws, size_t ws_size, hipStream_t stream) {
    static int grid = 0;
    if (grid == 0) {
        if (n_in != 16 || in_sizes[0] != M * DM || out_size != M * DM || ws_size < WS_END) { fprintf(stderr, "kernel_launch: unexpected shapes (n_in %d, in0 %d, out %d, ws %zu); nothing launched\n", n_in, n_in > 0 ? in_sizes[0] : -1, out_size, ws_size); grid = -1; return; }
        int dev = 0, cus = 0, per_cu = 0;
        if (hipGetDevice(&dev) != hipSuccess || hipDeviceGetAttribute(&cus, hipDeviceAttributeMultiprocessorCount, dev) != hipSuccess) { grid = -1; return; }
        if (hipFuncSetAttribute((const void*)mega_fwd, hipFuncAttributeMaxDynamicSharedMemorySize, LDS_BYTES) != hipSuccess) { fprintf(stderr, "kernel_launch: hipFuncSetAttribute failed\n"); grid = -1; return; }
        if (hipOccupancyMaxActiveBlocksPerMultiprocessor(&per_cu, (const void*)mega_fwd, NTHR, LDS_BYTES) != hipSuccess || per_cu < 1) { fprintf(stderr, "kernel_launch: occupancy query reports %d blocks per CU\n", per_cu); (void)hipGetLastError(); grid = -1; return; }
        grid = cus;
    }
    if (grid < 0) return;
    if (hipMemsetAsync((char*)d_ws + WS_CTL, 0, CTL_ZERO_BYTES, stream) != hipSuccess) return;
    Args a{};
    for (int i = 0; i < 16; ++i) a.in[i] = d_in[i];
    a.out = (float*)d_out; a.ws = (unsigned char*)d_ws;
    for (int j = 0; j < 8; ++j) a.invf[j] = std::pow(500000.0, -(double)j / 8.0) / 6.283185307179586476925;
    if (MK_N_LAUNCHES == 1) { a.ph_lo = 0; a.ph_hi = N_PHASES; a.li = 0; hipLaunchKernelGGL(mega_fwd, dim3(grid), dim3(NTHR), LDS_BYTES, stream, a); }
    else for (int p = 0; p < N_PHASES; ++p) { a.ph_lo = p; a.ph_hi = p + 1; a.li = p; hipLaunchKernelGGL(mega_fwd, dim3(grid), dim3(NTHR), LDS_BYTES, stream, a); }
}
```

```cpp
#include <hip/hip_runtime.h>
#include <cstdio>
#include <cstdint>
#include <cmath>

#ifndef MK_N_LAUNCHES
#define MK_N_LAUNCHES 1
#endif

constexpr int DM = 1024, NBATCH = 8, SEQ = 4096, M = NBATCH * SEQ;
constexpr int NIN = 4352, DFF = 2816, NUP = 2 * DFF;
constexpr int ZQ = 1024, ZK = 2048, ZV = 2176, ZG = 2304;
constexpr float EPS = 1e-6f, LOG2E = 1.4426950408889634f;

#define GAS __attribute__((address_space(1)))
#define LAS __attribute__((address_space(3)))
typedef unsigned short bf16_t;
typedef unsigned v4u __attribute__((ext_vector_type(4)));
typedef float f32x4 __attribute__((ext_vector_type(4)));
typedef short bf16x8 __attribute__((ext_vector_type(8)));
typedef GAS unsigned gu32;
#define RLX_AGENT __ATOMIC_RELAXED, __HIP_MEMORY_SCOPE_AGENT
#define LDS_WAIT() asm volatile("s_waitcnt lgkmcnt(0)" ::: "memory")
#define VM_WAIT() asm volatile("s_waitcnt vmcnt(0)" ::: "memory")

__device__ __forceinline__ unsigned f2bf(float f) { unsigned u = __builtin_bit_cast(unsigned, f); return (u + 0x7fffu + ((u >> 16) & 1u)) >> 16; }
typedef float f32x2_t __attribute__((ext_vector_type(2))); typedef __bf16 bf16x2_t __attribute__((ext_vector_type(2)));
__device__ __forceinline__ unsigned pk2(float lo, float hi) { f32x2_t v = {lo, hi}; bf16x2_t b = __builtin_convertvector(v, bf16x2_t); return __builtin_bit_cast(unsigned, b); }
__device__ __forceinline__ float bflo(unsigned w) { return __uint_as_float(w << 16); }
__device__ __forceinline__ float bfhi(unsigned w) { return __uint_as_float(w & 0xffff0000u); }
__device__ __forceinline__ void unpack8(const v4u w, float (&f)[8]) { f[0] = bflo(w.x); f[1] = bfhi(w.x); f[2] = bflo(w.y); f[3] = bfhi(w.y); f[4] = bflo(w.z); f[5] = bfhi(w.z); f[6] = bflo(w.w); f[7] = bfhi(w.w); }
__device__ __forceinline__ v4u pack8(const float (&f)[8]) { v4u w; w.x = pk2(f[0], f[1]); w.y = pk2(f[2], f[3]); w.z = pk2(f[4], f[5]); w.w = pk2(f[6], f[7]); return w; }
__device__ __forceinline__ float sigmoidf_(float x) { return __builtin_amdgcn_rcpf(1.f + __builtin_amdgcn_exp2f(-x * LOG2E)); }

namespace pg8 {
constexpr int BM = 256, BK = 64, HALF = 128, HTB = HALF * BK * 2, STAGE_BYTES = 8 * HTB, NXCD = 8, WGM = 8;
__host__ __device__ __forceinline__ int lds_byte(int r, int c) { const int st = (r >> 4) * 2 + (c >> 5), rr = r & 15, cc = c & 31, ob = rr * 64 + cc * 2; return st * 1024 + (ob ^ (((ob >> 9) & 1) << 5)); }
__host__ __device__ __forceinline__ void stage_rc(int b, int& R, int& C) { const int st = b / 1024, sb = b % 1024, swz = sb ^ (((sb >> 9) & 1) << 5); R = (st >> 1) * 16 + swz / 64; C = (st & 1) * 32 + (swz % 64) / 2; }
__host__ __device__ __forceinline__ int perm32(int rho) { const int n = rho >> 4, i = rho & 15; return 8 * (i >> 2) + 4 * n + (i & 3); }

struct Unit { const char* a; const char* b; int pm, pn; };
struct Gemm { int lda, ldb, K; size_t hstepA, hstepB; };

struct TileOrder {
    int nM, nN, nwg, G, c; const char* A; const char* B; size_t sA, sB, sApn;
    __device__ void init(int nM_, int nN_, int G_, int c_, const void* A_, const void* B_, size_t sA_, size_t sB_, size_t sApn_) { nM = nM_; nN = nN_; nwg = nM * nN; G = G_; c = c_; A = (const char*)A_; B = (const char*)B_; sA = sA_; sB = sB_; sApn = sApn_; }
    __device__ bool next(int i, Unit& u) const {
        const long L = (long)i * G + c; if (L >= nwg) return false;
        int wgid = (int)L; { const int q = nwg / NXCD, r = nwg % NXCD, xcd = wgid % NXCD, off = wgid / NXCD; wgid = (xcd < r ? xcd * (q + 1) : r * (q + 1) + (xcd - r) * q) + off; }
        const int nig = WGM * nN, gid = wgid / nig, fm = gid * WGM, gsz = (nM - fm) < WGM ? (nM - fm) : WGM;
        u.pm = fm + ((wgid % nig) % gsz); u.pn = (wgid % nig) / gsz;
        u.a = A + (size_t)u.pm * sA + (size_t)u.pn * sApn; u.b = B + (size_t)u.pn * sB; return true;
    }
};

template <int BMODE> __device__ __forceinline__ int mapB(int R) { return BMODE == 1 ? ((R & ~31) + perm32(R & 31)) : R; }
template <int AMODE> __device__ __forceinline__ int mapA(int R) { return AMODE == 1 ? (128 * (R >> 6) + 8 * (R & 15) + ((R >> 4) & 3)) : R; }

template <class Epi, class Sched, bool ALIGN_EPI>
__device__ __forceinline__ void gemm_phase(LAS unsigned char* lds, const Gemm g, const Sched& S, const Epi& E) {
    const int tid = threadIdx.x, wid = __builtin_amdgcn_readfirstlane(tid >> 6), lane = tid & 63, wr = wid >> 2, wc = wid & 3, fr = lane & 15, fq = lane >> 4;
    const int nt = g.K / BK;
    unsigned voffA[2], voffB[2];
#pragma unroll
    for (int i = 0; i < 2; ++i) { int R, C; stage_rc(tid * 16 + i * 8192, R, C); const int Rb = mapB<Epi::BMODE>(R);
        voffA[i] = (unsigned)(mapA<Epi::AMODE>(R) * g.lda + C) * 2u; voffB[i] = (unsigned)(Rb * g.ldb + C) * 2u; }
    const size_t kstep = (size_t)(BK * 2);
    const size_t hstepA = g.hstepA, hstepB = g.hstepB;
    const unsigned ldsw = (unsigned)wid * 1024u;
    const int aoff = lds_byte(wr * 64 + fr, fq * 8), boff = lds_byte(wc * 32 + fr, fq * 8);
#define PG8_SA(b, h) (((b) * 2 + (h)) * HTB)
#define PG8_SB(b, h) ((4 + (b) * 2 + (h)) * HTB)
#define PG8_STAGE(bufoff, gbase, voff) do { _Pragma("unroll") for (int _i = 0; _i < 2; ++_i) \
        __builtin_amdgcn_global_load_lds((const unsigned*)((const char*)(gbase) + (voff)[_i]), (LAS unsigned*)(lds + (bufoff) + ldsw + _i * 8192), 16, 0, 0); } while (0)
#define PG8_LDA(dst, b, h) do { _Pragma("unroll") for (int m = 0; m < 4; ++m) _Pragma("unroll") for (int k = 0; k < 2; ++k) dst[m][k] = *(const LAS bf16x8*)(lds + PG8_SA(b, h) + aoff + m * 2048 + k * 1024); } while (0)
#define PG8_LDB(dst, b, h) do { _Pragma("unroll") for (int n = 0; n < 2; ++n) _Pragma("unroll") for (int k = 0; k < 2; ++k) dst[n][k] = *(const LAS bf16x8*)(lds + PG8_SB(b, h) + boff + n * 2048 + k * 1024); } while (0)
#define PG8_MMA(ai, bj, At, Bt) do { __builtin_amdgcn_s_setprio(1); _Pragma("unroll") for (int m = 0; m < 4; ++m) _Pragma("unroll") for (int n = 0; n < 2; ++n) _Pragma("unroll") for (int k = 0; k < 2; ++k) \
        acc[ai][bj][m][n] = __builtin_amdgcn_mfma_f32_16x16x32_bf16(Bt[n][k], At[m][k], acc[ai][bj][m][n], 0, 0, 0); __builtin_amdgcn_s_setprio(0); } while (0)
#define PG8_WAIT_V(n) asm volatile("s_waitcnt vmcnt(" #n ")" ::: "memory")
#define PG8_WAIT_L(n) asm volatile("s_waitcnt lgkmcnt(" #n ")" ::: "memory")
#define PG8_BAR __builtin_amdgcn_s_barrier()
#define PG8_SCHED __builtin_amdgcn_sched_barrier(0)
    Unit cur, nxt; int ui = 0;
    if (!S.next(0, cur)) return;
    f32x4 acc[2][2][4][2];
#pragma unroll
    for (int a = 0; a < 2; ++a)
#pragma unroll
        for (int b = 0; b < 2; ++b)
#pragma unroll
            for (int m = 0; m < 4; ++m)
#pragma unroll
                for (int n = 0; n < 2; ++n) acc[a][b][m][n] = (f32x4){0.f, 0.f, 0.f, 0.f};
    bf16x8 At[4][2], B0[2][2], B1[2][2];
    const char* cA = cur.a; const char* cB = cur.b;
    PG8_STAGE(PG8_SB(0, 0), cB, voffB); PG8_STAGE(PG8_SB(0, 1), cB + hstepB, voffB); PG8_STAGE(PG8_SA(0, 0), cA, voffA); PG8_STAGE(PG8_SA(0, 1), cA + hstepA, voffA);
    if (wr == 1) PG8_BAR;
    PG8_WAIT_V(2); PG8_BAR;
    PG8_STAGE(PG8_SB(1, 0), cB + kstep, voffB); PG8_STAGE(PG8_SA(1, 0), cA + kstep, voffA); PG8_STAGE(PG8_SB(1, 1), cB + hstepB + kstep, voffB);
    PG8_WAIT_V(6); PG8_BAR;
    for (;;) {
        const bool has_next = S.next(ui + 1, nxt);
        const char* nA = has_next ? nxt.a : cA; const char* nB = has_next ? nxt.b : cB;
        for (int t = 0; t < nt; t += 2) {
            const bool last = (t == nt - 2);
            const char* a1 = cA + (size_t)(t + 1) * kstep;
            const char* a2 = last ? nA : cA + (size_t)(t + 2) * kstep; const char* b2 = last ? nB : cB + (size_t)(t + 2) * kstep;
            const char* a3 = a2 + kstep; const char* b3 = b2 + kstep;
            PG8_LDB(B0, 0, 0); PG8_LDB(B1, 0, 1); PG8_SCHED; PG8_LDA(At, 0, 0); PG8_STAGE(PG8_SA(1, 1), a1 + hstepA, voffA);
            PG8_WAIT_V(8); PG8_WAIT_L(0); PG8_BAR; PG8_MMA(0, 0, At, B0); PG8_MMA(0, 1, At, B1); PG8_BAR; PG8_SCHED;
            PG8_LDA(At, 0, 1); PG8_STAGE(PG8_SB(0, 0), b2, voffB); PG8_STAGE(PG8_SB(0, 1), b2 + hstepB, voffB); PG8_STAGE(PG8_SA(0, 0), a2, voffA);
            PG8_WAIT_V(8); PG8_WAIT_L(0); PG8_BAR; PG8_MMA(1, 0, At, B0); PG8_MMA(1, 1, At, B1); PG8_BAR; PG8_SCHED;
            PG8_LDB(B0, 1, 0); PG8_LDB(B1, 1, 1); PG8_SCHED; PG8_LDA(At, 1, 0); PG8_STAGE(PG8_SA(0, 1), a2 + hstepA, voffA);
            PG8_WAIT_V(8); PG8_WAIT_L(0); PG8_BAR; PG8_MMA(0, 0, At, B0); PG8_MMA(0, 1, At, B1); PG8_BAR; PG8_SCHED;
            PG8_LDA(At, 1, 1); PG8_STAGE(PG8_SB(1, 0), b3, voffB); PG8_STAGE(PG8_SB(1, 1), b3 + hstepB, voffB); PG8_STAGE(PG8_SA(1, 0), a3, voffA);
            PG8_WAIT_V(8); PG8_WAIT_L(0); PG8_BAR; PG8_MMA(1, 0, At, B0); PG8_MMA(1, 1, At, B1); PG8_BAR; PG8_SCHED;
        }
        if constexpr (ALIGN_EPI) { if (wr == 0) PG8_BAR; }
        E(acc, cur, wr, wc, fr, fq);
        if (!has_next) break;
#pragma unroll
        for (int a = 0; a < 2; ++a)
#pragma unroll
            for (int b = 0; b < 2; ++b)
#pragma unroll
                for (int m = 0; m < 4; ++m)
#pragma unroll
                    for (int n = 0; n < 2; ++n) acc[a][b][m][n] = (f32x4){0.f, 0.f, 0.f, 0.f};
        cur = nxt; cA = nA; cB = nB; ++ui;
        if constexpr (ALIGN_EPI) { if (wr == 1) PG8_BAR; }
    }
    PG8_WAIT_V(0);
    if constexpr (!ALIGN_EPI) { if (wr == 0) PG8_BAR; }
    PG8_BAR;
#undef PG8_SA
#undef PG8_SB
#undef PG8_STAGE
#undef PG8_LDA
#undef PG8_LDB
#undef PG8_MMA
#undef PG8_WAIT_V
#undef PG8_WAIT_L
#undef PG8_BAR
#undef PG8_SCHED
}

struct EpiStore {
    static constexpr int BMODE = 1, AMODE = 0;
    bf16_t* O; int ldc; const float* rs; const float* ssq;
    __device__ __forceinline__ void operator()(const f32x4 (&acc)[2][2][4][2], const Unit& u, int wr, int wc, int fr, int fq) const {
        const int row0 = u.pm * BM + wr * 64 + fr, col0 = u.pn * BM + wc * 32 + 8 * fq;
#pragma unroll
        for (int ai = 0; ai < 2; ++ai)
#pragma unroll
            for (int m = 0; m < 4; ++m) { const int row = row0 + ai * HALF + m * 16; float s = rs ? rs[row] : 1.f;
                if (ssq) { const f32x4 p = *(const f32x4*)(ssq + (size_t)row * 16 + 4 * fq); float t = (p.x + p.y) + (p.z + p.w); t += __shfl_xor(t, 16); t += __shfl_xor(t, 32); s = 1.f / sqrtf(t * (1.f / 1024.f) + EPS); }
                bf16_t* rowp = O + (size_t)row * ldc + col0;
#pragma unroll
                for (int bj = 0; bj < 2; ++bj) { const f32x4 v0 = acc[ai][bj][m][0] * s, v1 = acc[ai][bj][m][1] * s;
                    v4u w; w.x = pk2(v0[0], v0[1]); w.y = pk2(v0[2], v0[3]); w.z = pk2(v1[0], v1[1]); w.w = pk2(v1[2], v1[3]);
                    *(v4u*)(rowp + bj * HALF) = w; } }
    }
};
struct EpiRes {
    static constexpr int BMODE = 0, AMODE = 0;
    const float* base; float* out; int ldc;
    __device__ __forceinline__ void operator()(const f32x4 (&acc)[2][2][4][2], const Unit& u, int wr, int wc, int fr, int fq) const {
        const int row0 = u.pm * BM + wr * 64 + fr, col0 = u.pn * BM + wc * 32 + 4 * fq;
#pragma unroll
        for (int ai = 0; ai < 2; ++ai)
#pragma unroll
            for (int m = 0; m < 4; ++m) { const size_t off = (size_t)(row0 + ai * HALF + m * 16) * ldc + col0;
#pragma unroll
                for (int bj = 0; bj < 2; ++bj)
#pragma unroll
                    for (int n = 0; n < 2; ++n) { const f32x4 b = *(const f32x4*)(base + off + bj * HALF + n * 16); *(f32x4*)(out + off + bj * HALF + n * 16) = b + acc[ai][bj][m][n]; } }
    }
};
struct EpiMix {
    static constexpr int BMODE = 1, AMODE = 0;
    const bf16_t* Zg; int ldz; const float* bg; const bf16_t* BO; bf16_t* MIX;
    __device__ __forceinline__ void operator()(const f32x4 (&acc)[2][2][4][2], const Unit& u, int wr, int wc, int fr, int fq) const {
        const int row0 = u.pm * BM + wr * 64 + fr, col0 = u.pn * BM + wc * 32 + 8 * fq;
#pragma unroll
        for (int ai = 0; ai < 2; ++ai)
#pragma unroll
            for (int m = 0; m < 4; ++m) { const size_t row = (size_t)(row0 + ai * HALF + m * 16);
#pragma unroll
                for (int bj = 0; bj < 2; ++bj) { const int c = col0 + bj * HALF;
                    float gp[8], ga[8], bo[8], o[8];
                    unpack8(*(const v4u*)(Zg + row * ldz + c), gp); unpack8(*(const v4u*)(Zg + row * ldz + DM + c), ga); unpack8(*(const v4u*)(BO + row * DM + c), bo);
                    const f32x4 bp0 = *(const f32x4*)(bg + c), bp1 = *(const f32x4*)(bg + c + 4), ba0 = *(const f32x4*)(bg + DM + c), ba1 = *(const f32x4*)(bg + DM + c + 4);
                    const f32x4 a0 = acc[ai][bj][m][0], a1 = acc[ai][bj][m][1];
#pragma unroll
                    for (int j = 0; j < 4; ++j) { o[j] = sigmoidf_(gp[j] + bp0[j]) * a0[j] + sigmoidf_(ga[j] + ba0[j]) * bo[j]; o[4 + j] = sigmoidf_(gp[4 + j] + bp1[j]) * a1[j] + sigmoidf_(ga[4 + j] + ba1[j]) * bo[4 + j]; }
                    *(v4u*)(MIX + row * DM + c) = pack8(o); asm volatile("" ::: "memory"); } }
    }
};
struct EpiOut1 {
    static constexpr int BMODE = 1, AMODE = 0;
    const float* x; float* out; bf16_t* X1B; float* SSQ;
    __device__ __forceinline__ void operator()(const f32x4 (&acc)[2][2][4][2], const Unit& u, int wr, int wc, int fr, int fq) const {
        const int row0 = u.pm * BM + wr * 64 + fr, col0 = u.pn * BM + wc * 32 + 8 * fq;
#pragma unroll
        for (int ai = 0; ai < 2; ++ai)
#pragma unroll
            for (int m = 0; m < 4; ++m) { const size_t row = (size_t)(row0 + ai * HALF + m * 16); float ss = 0.f;
#pragma unroll
                for (int bj = 0; bj < 2; ++bj) { const size_t off = row * DM + col0 + bj * HALF;
                    const f32x4 v0 = *(const f32x4*)(x + off) + acc[ai][bj][m][0], v1 = *(const f32x4*)(x + off + 4) + acc[ai][bj][m][1];
                    *(f32x4*)(out + off) = v0; *(f32x4*)(out + off + 4) = v1;
                    ss += (v0[0] * v0[0] + v0[1] * v0[1]) + (v0[2] * v0[2] + v0[3] * v0[3]) + (v1[0] * v1[0] + v1[1] * v1[1]) + (v1[2] * v1[2] + v1[3] * v1[3]);
                    v4u w; w.x = pk2(v0[0], v0[1]); w.y = pk2(v0[2], v0[3]); w.z = pk2(v1[0], v1[1]); w.w = pk2(v1[2], v1[3]);
                    *(v4u*)(X1B + off) = w; }
                ss += __shfl_xor(ss, 16); ss += __shfl_xor(ss, 32);
                if (fq == 0) SSQ[row * 16 + u.pn * 4 + wc] = ss; asm volatile("" ::: "memory"); }
    }
};
__device__ __forceinline__ float dpp_shr1(float v) { return __int_as_float(__builtin_amdgcn_update_dpp(0, __float_as_int(v), 0x111, 0xf, 0xf, true)); }
__device__ __forceinline__ f32x4 dpp_shr1(f32x4 v) { f32x4 r; r[0] = dpp_shr1(v[0]); r[1] = dpp_shr1(v[1]); r[2] = dpp_shr1(v[2]); r[3] = dpp_shr1(v[3]); return r; }
struct EpiConv {
    static constexpr int BMODE = 1, AMODE = 1;
    const float* ssq; const float* cw; const float* cb; bf16_t* HACT; float* Y01; float* HALO;
    __device__ __forceinline__ void operator()(f32x4 (&acc)[2][2][4][2], const Unit& u, int wr, int wc, int fr, int fq) const {
#define AE(e, bj, n) acc[(e) >> 2][bj][(e) & 3][n]
        const int trow0 = u.pm * BM + 128 * wr + 8 * fr, q = u.pm * 2 + wr, colg = u.pn * 128 + wc * 32 + 8 * fq;
#pragma unroll
        for (int e = 0; e < 8; ++e) { const f32x4 p = *(const f32x4*)(ssq + (size_t)(trow0 + e) * 16 + 4 * fq); float t = (p.x + p.y) + (p.z + p.w); t += __shfl_xor(t, 16); t += __shfl_xor(t, 32);
            const float r2 = 1.f / sqrtf(t * (1.f / 1024.f) + EPS);
#pragma unroll
            for (int bj = 0; bj < 2; ++bj) { AE(e, bj, 0) *= r2; AE(e, bj, 1) *= r2; }
            asm volatile("" : "+v"(AE(e, 0, 0)), "+v"(AE(e, 0, 1)), "+v"(AE(e, 1, 0)), "+v"(AE(e, 1, 1))); }
        asm volatile("" ::: "memory");
        if (fr == 15) {
#pragma unroll
            for (int e = 6; e < 8; ++e)
#pragma unroll
                for (int bj = 0; bj < 2; ++bj) { float* hp = HALO + ((size_t)(q * 2 + (e - 6)) * NUP + bj * DFF + colg); *(f32x4*)hp = AE(e, bj, 0); *(f32x4*)(hp + 4) = AE(e, bj, 1); } }
#pragma unroll
        for (int bj = 0; bj < 2; ++bj)
#pragma unroll
            for (int n = 0; n < 2; ++n) { const int c = bj * DFF + colg + 4 * n;
                const f32x4 w0 = *(const f32x4*)(cw + c), w1 = *(const f32x4*)(cw + NUP + c), w2 = *(const f32x4*)(cw + 2 * NUP + c), bb = *(const f32x4*)(cb + c);
                const f32x4 p6 = dpp_shr1(AE(6, bj, n)), p7 = dpp_shr1(AE(7, bj, n));
#pragma unroll
                for (int e = 7; e >= 2; --e) AE(e, bj, n) = w2 * AE(e, bj, n) + (w1 * AE(e - 1, bj, n) + (w0 * AE(e - 2, bj, n) + bb));
                AE(1, bj, n) = w2 * AE(1, bj, n) + (w1 * AE(0, bj, n) + (w0 * p7 + bb));
                AE(0, bj, n) = w2 * AE(0, bj, n) + (w1 * p7 + (w0 * p6 + bb));
                asm volatile("" : "+v"(AE(0, bj, n)), "+v"(AE(1, bj, n)), "+v"(AE(2, bj, n)), "+v"(AE(3, bj, n)), "+v"(AE(4, bj, n)), "+v"(AE(5, bj, n)), "+v"(AE(6, bj, n)), "+v"(AE(7, bj, n)) :: "memory"); }
        if (fr == 0) {
#pragma unroll
            for (int e = 0; e < 2; ++e)
#pragma unroll
                for (int bj = 0; bj < 2; ++bj) { float* yp = Y01 + ((size_t)(q * 2 + e) * NUP + bj * DFF + colg); *(f32x4*)yp = AE(e, bj, 0); *(f32x4*)(yp + 4) = AE(e, bj, 1); } }
#pragma unroll
        for (int e = 0; e < 8; ++e) { const f32x4 g0 = AE(e, 0, 0), g1 = AE(e, 0, 1), v0 = AE(e, 1, 0), v1 = AE(e, 1, 1); float o[8];
#pragma unroll
            for (int j = 0; j < 4; ++j) { o[j] = g0[j] * sigmoidf_(g0[j]) * v0[j]; o[4 + j] = g1[j] * sigmoidf_(g1[j]) * v1[j]; }
            *(v4u*)(HACT + (size_t)(trow0 + e) * DFF + colg) = pack8(o); asm volatile("" ::: "memory"); }
#undef AE
    }
};
}

constexpr int NWAVES = 8, NTHR = NWAVES * 64;
constexpr int N_PHASES = 13;
constexpr size_t MiB = 1u << 20;
constexpr size_t WS_CTL = 0, CTL_ZERO_BYTES = 1 * MiB;
constexpr size_t WS_R1 = 1 * MiB;
constexpr size_t WS_SSQ = 498 * MiB;
constexpr size_t WS_TAB = 2 * MiB;
constexpr size_t WS_WIN = 4 * MiB, WS_WP = 13 * MiB, WS_WO = 14 * MiB, WS_WU = 16 * MiB, WS_WD = 28 * MiB;
constexpr size_t WS_XB = 34 * MiB;
constexpr size_t WS_Z = 98 * MiB;
constexpr size_t WS_Y01 = WS_Z, WS_HALO = WS_Z + 16 * MiB, WS_HACT = WS_Z + 176 * MiB;
constexpr size_t WS_B = 370 * MiB;
constexpr size_t WS_AP = 434 * MiB;
constexpr size_t WS_END = 500 * MiB;
static_assert(WS_WIN + (size_t)NIN * DM * 2 <= WS_WP && WS_WU + (size_t)NUP * DM * 2 <= WS_WD && WS_WD + (size_t)DM * DFF * 2 <= WS_XB, "weights map");
static_assert(WS_Z + (size_t)M * NIN * 2 <= WS_B && WS_HACT + (size_t)M * DFF * 2 <= WS_SSQ && WS_AP + (size_t)M * DM * 2 <= WS_SSQ, "activation map");
constexpr int CW_BAR = 4096;
constexpr int RING_BYTES = 131072, LDSCTL_OFF = RING_BYTES, MISC_OFF = LDSCTL_OFF + 320, LDS_BYTES = 147456;

#define XB_TMO      128
#define XB_XCNT(j)  (256  + 64 * (j))
#define XB_XSUB(j)  (1280 + 64 * (j))
#define XB_XGEN(j)  (2304 + 64 * (j))
#define XB_TOP      3328
#define XB_TOPGEN   3392
#define XCD_BAR_WORDS 3456
#define XB_SPIN_CAP (1u << 18)
__device__ __forceinline__ unsigned xb_ld(unsigned* p)              { return __hip_atomic_load(p, __ATOMIC_RELAXED, __HIP_MEMORY_SCOPE_AGENT); }
__device__ __forceinline__ unsigned xb_add(unsigned* p, unsigned v) { return __hip_atomic_fetch_add(p, v, __ATOMIC_RELAXED, __HIP_MEMORY_SCOPE_AGENT); }
__device__ __forceinline__ unsigned xb_xcc_id() { return (unsigned)__builtin_amdgcn_s_getreg((3 << 11) | 20) & 0xFu; }
#define XB_SPIN(cond, bar) do { unsigned _sp = 0; while (cond) { __builtin_amdgcn_s_sleep(1); \
    if ((++_sp & 255u) == 0u) { if (xb_ld(&(bar)[XB_TMO])) break; if (_sp > XB_SPIN_CAP) { atomicAdd(&(bar)[XB_TMO], 1u); break; } } } } while (0)
struct XcdBarrier { unsigned* bar; unsigned x; volatile LAS unsigned* st; };
__device__ __forceinline__ XcdBarrier xcd_barrier_post(unsigned* bar, volatile LAS unsigned* st) {
    XcdBarrier b; b.bar = bar; b.x = xb_xcc_id(); b.st = st;
    if (threadIdx.x == 0) (void)xb_add(&bar[XB_XCNT(b.x)], 1u);
    return b;
}
__device__ __forceinline__ void xcd_barrier_complete(unsigned* bar, unsigned x, unsigned& nloc, unsigned& nx) {
    const unsigned G = gridDim.x * gridDim.y * gridDim.z;
    unsigned sum, cnt, mine, sp = 0u;
    for (;;) {
        sum = 0u; cnt = 0u; mine = 0u;
#pragma unroll
        for (unsigned j = 0; j < 16; ++j) { const unsigned c = xb_ld(&bar[XB_XCNT(j)]); sum += c; cnt += (c > 0u) ? 1u : 0u; mine = (j == x) ? c : mine; }
        if (sum == G) break;
        __builtin_amdgcn_s_sleep(1);
        if ((++sp & 255u) == 0u) { if (xb_ld(&bar[XB_TMO])) break; if (sp > XB_SPIN_CAP) { atomicAdd(&bar[XB_TMO], 1u); break; } }
    }
    nloc = mine > 0u ? mine : 1u; nx = cnt > 0u ? cnt : 1u;
}
__device__ __forceinline__ void xcd_barrier(const XcdBarrier& b) {
    asm volatile("s_waitcnt vmcnt(0)" ::: "memory");
    __syncthreads();
    if (threadIdx.x == 0) {
        unsigned* bar = b.bar;
        __builtin_amdgcn_s_waitcnt(0);
        unsigned nloc = b.st[0], nx = b.st[1];
        if (nloc == 0u) { xcd_barrier_complete(bar, b.x, nloc, nx); b.st[0] = nloc; b.st[1] = nx; }
        const unsigned old = xb_add(&bar[XB_XSUB(b.x)], 1u);
        const unsigned gen = old / nloc;
        if (old + 1u == (gen + 1u) * nloc) {
            __builtin_amdgcn_fence(__ATOMIC_RELEASE, "agent");
            asm volatile("s_waitcnt vmcnt(0)" ::: "memory");
            const unsigned og = xb_add(&bar[XB_TOP], 1u);
            const unsigned tg = og / nx;
            if (og + 1u == (tg + 1u) * nx) xb_add(&bar[XB_TOPGEN], 1u);
            else XB_SPIN(xb_ld(&bar[XB_TOPGEN]) == tg, bar);
            __builtin_amdgcn_fence(__ATOMIC_ACQUIRE, "agent");
            xb_add(&bar[XB_XGEN(b.x)], 1u);
            asm volatile("s_waitcnt vmcnt(0)" ::: "memory");
        } else {
            XB_SPIN(xb_ld(&bar[XB_XGEN(b.x)]) == gen, bar);
            __builtin_amdgcn_fence(__ATOMIC_ACQUIRE, "agent");
            asm volatile("s_waitcnt vmcnt(0)" ::: "memory");
        }
    }
    __syncthreads();
}

struct Frame {
    LAS unsigned char* lds; volatile LAS unsigned* MISC; gu32* ctl;
    int tid, lane, wave, vcu, G;
};
__device__ __forceinline__ float wave_sum(float v) {
#pragma unroll
    for (int o = 1; o < 64; o <<= 1) v += __shfl_xor(v, o);
    return v;
}

__device__ __forceinline__ void p0_transpose_item(const float* W, int K, int N, bf16_t* WT, const float* kscale, const float* nscale, LAS float* scr, int item, int lane) {
    const int nblk = N / 32, kb = item / nblk, nb = item % nblk, k0 = 64 * kb, n0 = 32 * nb;
    const float ns = nscale ? nscale[n0 + (lane & 31)] : 1.f;
#pragma unroll 8
    for (int i = 0; i < 32; ++i) { const int kk = 2 * i + (lane >> 5); const float ks = kscale ? kscale[k0 + kk] : 1.f; scr[kk * 33 + (lane & 31)] = W[(size_t)(k0 + kk) * N + n0 + (lane & 31)] * ks * ns; }
    LDS_WAIT(); asm volatile("" ::: "memory");
    const int c = lane & 7;
#pragma unroll
    for (int j = 0; j < 4; ++j) { const int n = (lane >> 3) + 8 * j; const LAS float* s = scr + (8 * c) * 33 + n;
        v4u o; o.x = pk2(s[0 * 33], s[1 * 33]); o.y = pk2(s[2 * 33], s[3 * 33]); o.z = pk2(s[4 * 33], s[5 * 33]); o.w = pk2(s[6 * 33], s[7 * 33]);
        *(GAS v4u*)(WT + (size_t)(n0 + n) * K + k0 + 8 * c) = o; }
    LDS_WAIT(); asm volatile("" ::: "memory");
}
__device__ __forceinline__ void row_bf16_rs(int lane, const float* xrow, bf16_t* orow, float* rs) {
    const GAS f32x4* xr = (const GAS f32x4*)xrow + lane;
    f32x4 v[4]; float s = 0.f;
#pragma unroll
    for (int j = 0; j < 4; ++j) { v[j] = xr[64 * j]; s += (v[j].x * v[j].x + v[j].y * v[j].y) + (v[j].z * v[j].z + v[j].w * v[j].w); }
    s = wave_sum(s);
    if (lane == 0) *rs = 1.f / sqrtf(s * (1.f / DM) + EPS);
    GAS unsigned long long* o8 = (GAS unsigned long long*)orow + lane;
#pragma unroll
    for (int j = 0; j < 4; ++j) o8[64 * j] = (unsigned long long)pk2(v[j].x, v[j].y) | ((unsigned long long)pk2(v[j].z, v[j].w) << 32);
}

typedef float f32x16 __attribute__((ext_vector_type(16)));
typedef short s16x4 __attribute__((ext_vector_type(4)));
constexpr int AT_KP = 72, AT_VP = 260;
constexpr int AT_K_OFF = 0, AT_V_OFF = 256 * AT_KP * 2, AT_W_OFF = 71680, AT_W_BYTES = 4608;
static_assert(AT_V_OFF + 64 * AT_VP * 2 <= AT_W_OFF && AT_W_OFF + 8 * AT_W_BYTES <= RING_BYTES, "attention LDS map");
__device__ __forceinline__ int crow16(int r, int hi) { return (r & 3) + 8 * (r >> 2) + 4 * hi; }
__device__ __forceinline__ void attn_phase(Frame& F, const bf16_t* Q, int ldq, const bf16_t* K, int ldk, const bf16_t* V, int ldv, const float* sinks, bf16_t* BO) {
    LAS bf16_t* Ks = (LAS bf16_t*)(F.lds + AT_K_OFF); LAS bf16_t* Vt = (LAS bf16_t*)(F.lds + AT_V_OFF);
    LAS bf16_t* stg = (LAS bf16_t*)(F.lds + AT_W_OFF + F.wave * AT_W_BYTES); LAS float* wsf = (LAS float*)(F.lds + AT_W_OFF + F.wave * AT_W_BYTES + 4096);
    const int lane = F.lane, r32 = lane & 31, hi = lane >> 5;
    const float NEG = -INFINITY;
    for (int unit = F.vcu; unit < NBATCH * 32 * 2; unit += F.G) {
        const int kvh = unit & 1, nblk = (unit >> 1) & 31, b = unit >> 6;
        const long row0 = (long)b * SEQ + (long)nblk * 128;
        __syncthreads();
#pragma unroll
        for (int i = 0; i < 4; ++i) { const int c = F.tid + i * NTHR, r = c >> 3, ch = c & 7; const long grow = row0 - 128 + r; v4u kv = {0u, 0u, 0u, 0u}, vv = {0u, 0u, 0u, 0u};
            if (grow >= (long)b * SEQ) { kv = *(const v4u*)(K + (size_t)grow * ldk + 64 * kvh + 8 * ch); vv = *(const v4u*)(V + (size_t)grow * ldv + 64 * kvh + 8 * ch); }
            *(LAS v4u*)(Ks + r * AT_KP + 8 * ch) = kv;
            LAS bf16_t* vp = Vt + (8 * ch) * AT_VP + r;
            vp[0 * AT_VP] = (bf16_t)(vv.x & 0xffffu); vp[1 * AT_VP] = (bf16_t)(vv.x >> 16); vp[2 * AT_VP] = (bf16_t)(vv.y & 0xffffu); vp[3 * AT_VP] = (bf16_t)(vv.y >> 16);
            vp[4 * AT_VP] = (bf16_t)(vv.z & 0xffffu); vp[5 * AT_VP] = (bf16_t)(vv.z >> 16); vp[6 * AT_VP] = (bf16_t)(vv.w & 0xffffu); vp[7 * AT_VP] = (bf16_t)(vv.w >> 16); }
        __syncthreads();
        const int head = kvh * 8 + F.wave;
        const float sinkv = sinks[head] * LOG2E;
#pragma unroll 1
        for (int c = 0; c < 4; ++c) {
            const bf16_t* qp = Q + (size_t)(row0 + 32 * c + r32) * ldq + 64 * head + 8 * hi;
            bf16x8 qf[4];
#pragma unroll
            for (int s = 0; s < 4; ++s) qf[s] = *(const bf16x8*)(qp + 16 * s);
            f32x16 S[5];
#pragma unroll
            for (int t = 0; t < 5; ++t) {
#pragma unroll
                for (int r = 0; r < 16; ++r) S[t][r] = 0.f;
                const LAS bf16_t* kp = Ks + ((c + t) * 32 + r32) * AT_KP + 8 * hi;
#pragma unroll
                for (int s = 0; s < 4; ++s) { const bf16x8 kf = *(const LAS bf16x8*)(kp + 16 * s); S[t] = __builtin_amdgcn_mfma_f32_32x32x16_bf16(kf, qf[s], S[t], 0, 0, 0); }
            }
#pragma unroll
            for (int r = 0; r < 16; ++r) { const int jj = crow16(r, hi); if (!(jj > r32)) S[0][r] = NEG; if (!(jj <= r32)) S[4][r] = NEG; }
#pragma unroll
            for (int t = 0; t < 5; ++t) { if (nblk == 0 && c + t < 4) {
#pragma unroll
                for (int r = 0; r < 16; ++r) S[t][r] = NEG; } }
            float mx = NEG;
#pragma unroll
            for (int t = 0; t < 5; ++t)
#pragma unroll
                for (int r = 0; r < 16; ++r) mx = fmaxf(mx, S[t][r]);
            mx = fmaxf(mx, __shfl_xor(mx, 32)); mx = fmaxf(mx, sinkv);
            float l = 0.f;
#pragma unroll
            for (int t = 0; t < 5; ++t)
#pragma unroll
                for (int r = 0; r < 16; ++r) { const float p = __builtin_amdgcn_exp2f(S[t][r] - mx); S[t][r] = p; l += p; }
            l += __shfl_xor(l, 32); l += __builtin_amdgcn_exp2f(sinkv - mx);
            f32x16 O[2];
#pragma unroll
            for (int r = 0; r < 16; ++r) { O[0][r] = 0.f; O[1][r] = 0.f; }
#pragma unroll
            for (int t = 0; t < 5; ++t)
#pragma unroll
                for (int s = 0; s < 2; ++s) {
                    v4u pw; pw.x = pk2(S[t][8 * s + 0], S[t][8 * s + 1]); pw.y = pk2(S[t][8 * s + 2], S[t][8 * s + 3]); pw.z = pk2(S[t][8 * s + 4], S[t][8 * s + 5]); pw.w = pk2(S[t][8 * s + 6], S[t][8 * s + 7]);
                    const bf16x8 xs = __builtin_bit_cast(bf16x8, pw);
#pragma unroll
                    for (int d0 = 0; d0 < 2; ++d0) { const LAS bf16_t* vp = Vt + (32 * d0 + r32) * AT_VP + (c + t) * 32 + 16 * s + 4 * hi;
                        const s16x4 lo = *(const LAS s16x4*)vp, hh = *(const LAS s16x4*)(vp + 8);
                        const bf16x8 vf = __builtin_shufflevector(lo, hh, 0, 1, 2, 3, 4, 5, 6, 7);
                        O[d0] = __builtin_amdgcn_mfma_f32_32x32x16_bf16(xs, vf, O[d0], 0, 0, 0); }
                }
            asm volatile("s_waitcnt lgkmcnt(0)" ::: "memory");
            if (hi == 0) wsf[r32] = 1.f / l;
            asm volatile("s_waitcnt lgkmcnt(0)" ::: "memory");
#pragma unroll
            for (int r = 0; r < 16; ++r) { const int qi = crow16(r, hi); const float inv = wsf[qi];
                stg[qi * 64 + r32] = (bf16_t)f2bf(O[0][r] * inv); stg[qi * 64 + 32 + r32] = (bf16_t)f2bf(O[1][r] * inv); }
            asm volatile("s_waitcnt lgkmcnt(0)" ::: "memory");
#pragma unroll
            for (int i = 0; i < 4; ++i) { const int row = i * 8 + (lane >> 3), ch = lane & 7; const v4u v = *(const LAS v4u*)(stg + row * 64 + ch * 8);
                *(v4u*)(BO + (size_t)(row0 + 32 * c + row) * DM + 64 * head + 8 * ch) = v; }
            asm volatile("s_waitcnt lgkmcnt(0)" ::: "memory");
        }
    }
    __syncthreads();
}

struct Args { const void* in[16]; float* out; unsigned char* ws; double invf[8]; int ph_lo, ph_hi, li, pad; };

__global__ void __launch_bounds__(NTHR, 2) mega_fwd(Args args) {
    extern __shared__ __attribute__((aligned(16))) unsigned char lds[];
    Frame F;
    F.lds = (LAS unsigned char*)lds;
    F.MISC = (volatile LAS unsigned*)(F.lds + MISC_OFF);
    F.tid = threadIdx.x; F.lane = F.tid & 63; F.wave = __builtin_amdgcn_readfirstlane(F.tid >> 6);
    F.G = gridDim.x; { const int bx = blockIdx.x; F.vcu = (F.G % 8 == 0) ? (bx % 8) * (F.G / 8) + bx / 8 : bx; }
    unsigned char* ws = args.ws;
    F.ctl = (gu32*)(ws + WS_CTL);
    const float* x = (const float*)args.in[0]; const int* positions = (const int*)args.in[1]; const float* attn_norm = (const float*)args.in[2];
    const float* w_in = (const float*)args.in[3]; const float* b_gate = (const float*)args.in[4]; const float* w_pool = (const float*)args.in[5];
    const float* pool_scale = (const float*)args.in[6]; const float* q_norm = (const float*)args.in[7]; const float* k_norm = (const float*)args.in[8];
    const float* sinks = (const float*)args.in[9]; const float* w_out = (const float*)args.in[10]; const float* ffn_norm = (const float*)args.in[11];
    const float* w_up = (const float*)args.in[12]; const float* conv_w = (const float*)args.in[13]; const float* conv_b = (const float*)args.in[14];
    const float* w_down = (const float*)args.in[15];
    float* out = args.out;
    float* R1 = (float*)(ws + WS_R1); float* SSQ = (float*)(ws + WS_SSQ); float* TAB = (float*)(ws + WS_TAB);
    bf16_t* Win_t = (bf16_t*)(ws + WS_WIN); bf16_t* Wp_t = (bf16_t*)(ws + WS_WP); bf16_t* Wo_t = (bf16_t*)(ws + WS_WO); bf16_t* Wu_t = (bf16_t*)(ws + WS_WU); bf16_t* Wd_t = (bf16_t*)(ws + WS_WD);
    bf16_t* XB = (bf16_t*)(ws + WS_XB); bf16_t* Z = (bf16_t*)(ws + WS_Z); float* Y01 = (float*)(ws + WS_Y01); float* HALO = (float*)(ws + WS_HALO); bf16_t* HACT = (bf16_t*)(ws + WS_HACT);
    bf16_t* BO = (bf16_t*)(ws + WS_B); bf16_t* AP = (bf16_t*)(ws + WS_AP);

    for (int u = F.tid; u < (LDS_BYTES - LDSCTL_OFF) / 4; u += NTHR) ((LAS unsigned*)(F.lds + LDSCTL_OFF))[u] = 0u;
    __syncthreads();
    XcdBarrier bar; bar.bar = (unsigned*)(F.ctl + CW_BAR); bar.x = 0; bar.st = nullptr;
    if (MK_N_LAUNCHES == 1) bar = xcd_barrier_post((unsigned*)(F.ctl + CW_BAR), F.MISC + 8);
#define GRID_BAR() do { if (MK_N_LAUNCHES == 1) xcd_barrier(bar); } while (0)
    const int lo = args.ph_lo, hi = args.ph_hi;
#define IN(k) (lo <= (k) && (k) < hi)
#define BOTH(k) (IN(k) && IN((k) + 1))
    const int gt = F.vcu * NTHR + F.tid, GT = F.G * NTHR;
    const int gw = F.vcu * NWAVES + F.wave, NGW = F.G * NWAVES;

    if (IN(0)) {
        LAS float* scr = (LAS float*)(F.lds + F.wave * 16384);
        constexpr int I_IN = (DM / 64) * (NIN / 32), I_P = (256 / 64) * (256 / 32), I_O = (DM / 64) * (DM / 32), I_U = (DM / 64) * (NUP / 32), I_D = (DFF / 64) * (DM / 32);
        constexpr int NITEMS = I_IN + 4 * I_P + I_O + I_U + I_D;
        for (int it = gw; it < NITEMS; it += NGW) {
            int r = it;
            if (r < I_IN) { p0_transpose_item(w_in, DM, NIN, Win_t, attn_norm, nullptr, scr, r, F.lane); continue; } r -= I_IN;
            if (r < 4 * I_P) { const int g = r / I_P; p0_transpose_item(w_pool + (size_t)g * 65536, 256, 256, Wp_t + (size_t)g * 65536, nullptr, pool_scale + 256 * g, scr, r % I_P, F.lane); continue; } r -= 4 * I_P;
            if (r < I_O) { p0_transpose_item(w_out, DM, DM, Wo_t, nullptr, nullptr, scr, r, F.lane); continue; } r -= I_O;
            if (r < I_U) { p0_transpose_item(w_up, DM, NUP, Wu_t, ffn_norm, nullptr, scr, r, F.lane); continue; } r -= I_U;
            p0_transpose_item(w_down, DFF, DM, Wd_t, nullptr, nullptr, scr, r, F.lane);
        }
        for (int m = gw; m < M; m += NGW) row_bf16_rs(F.lane, x + (size_t)m * DM, XB + (size_t)m * DM, R1 + m);
        for (int idx = gt; idx < M * 8; idx += GT) { const int m = idx >> 3, j = idx & 7;
            double rev = (double)positions[m] * args.invf[j]; rev -= floor(rev); const float fr = (float)rev;
            TAB[(size_t)m * 16 + j] = __builtin_amdgcn_cosf(fr); TAB[(size_t)m * 16 + 8 + j] = __builtin_amdgcn_sinf(fr); }
        if (BOTH(0)) GRID_BAR();
    }
    if (IN(1)) {
        pg8::Gemm g{DM, DM, DM, (size_t)128 * DM * 2, (size_t)128 * DM * 2};
        pg8::TileOrder S; S.init(M / 256, NIN / 256, F.G, (int)blockIdx.x, XB, Win_t, (size_t)256 * DM * 2, (size_t)256 * DM * 2, 0);
        pg8::EpiStore E{Z, NIN, R1, nullptr};
        pg8::gemm_phase<pg8::EpiStore, pg8::TileOrder, true>(F.lds, g, S, E);
        if (BOTH(1)) GRID_BAR();
    }
    if (IN(2)) {
        for (int it = gt >> 3; it < M * 18; it += GT >> 3) {
            const int m = it / 18, h = it - m * 18, sub = F.tid & 7;
            bf16_t* p = Z + (size_t)m * NIN + ZQ + 64 * h + 8 * sub;
            float v[8]; unpack8(*(const v4u*)p, v);
            float ss = 0.f;
#pragma unroll
            for (int j = 0; j < 8; ++j) ss += v[j] * v[j];
            ss += __shfl_xor(ss, 1); ss += __shfl_xor(ss, 2); ss += __shfl_xor(ss, 4);
            const float rr = 1.f / sqrtf(ss * (1.f / 64.f) + EPS);
            const float* nw = (h < 16 ? q_norm : k_norm) + 8 * sub;
#pragma unroll
            for (int j = 0; j < 8; ++j) v[j] = v[j] * rr * nw[j];
            float o[8];
#pragma unroll
            for (int j = 0; j < 8; ++j) { const float pr = __shfl_xor(v[j], 1); const float c = TAB[(size_t)m * 16 + j], s = TAB[(size_t)m * 16 + 8 + j];
                o[j] = sub == 0 ? v[j] * c - pr * s : (sub == 1 ? v[j] * c + pr * s : v[j]); }
            const float sc = h < 16 ? 0.125f * LOG2E : 1.f;
#pragma unroll
            for (int j = 0; j < 8; ++j) o[j] *= sc;
            *(v4u*)p = pack8(o);
        }
        bf16_t* P = XB;
        for (int idx = gt; idx < M * 128; idx += GT) { const int m = idx >> 7, ch = idx & 127, g = ch >> 5, w = 2 << g, t = m & (SEQ - 1), cnt = (t + 1 < w) ? t + 1 : w;
            float a[8], u0[8];
#pragma unroll
            for (int j = 0; j < 8; ++j) a[j] = 0.f;
            for (int k = 0; k < cnt; ++k) { float f[8]; unpack8(*(const v4u*)(Z + (size_t)(m - k) * NIN + 8 * ch), f);
#pragma unroll
                for (int j = 0; j < 8; ++j) { a[j] += f[j]; if (k == 0) u0[j] = f[j]; } }
            const float ic = 1.f / (float)cnt;
#pragma unroll
            for (int j = 0; j < 8; ++j) a[j] = a[j] * ic - u0[j];
            *(v4u*)(P + (size_t)m * DM + 8 * ch) = pack8(a); }
        if (BOTH(2)) GRID_BAR();
    }
    if (IN(3)) {
        attn_phase(F, Z + ZQ, NIN, Z + ZK, NIN, Z + ZV, NIN, sinks, BO);
        if (BOTH(3)) GRID_BAR();
    }
    if (IN(4)) {
        pg8::Gemm g{DM, 256, 256, (size_t)128 * DM * 2, (size_t)128 * 256 * 2};
        pg8::TileOrder S; S.init(M / 256, 4, F.G, (int)blockIdx.x, XB, Wp_t, (size_t)256 * DM * 2, (size_t)256 * 256 * 2, (size_t)256 * 2);
        pg8::EpiMix E{Z + ZG, NIN, b_gate, BO, AP};
        pg8::gemm_phase<pg8::EpiMix, pg8::TileOrder, true>(F.lds, g, S, E);
        if (BOTH(4)) GRID_BAR();
    }
    if (IN(6)) {
        pg8::Gemm g{DM, DM, DM, (size_t)128 * DM * 2, (size_t)128 * DM * 2};
        pg8::TileOrder S; S.init(M / 256, DM / 256, F.G, (int)blockIdx.x, AP, Wo_t, (size_t)256 * DM * 2, (size_t)256 * DM * 2, 0);
        pg8::EpiOut1 E{x, out, XB, SSQ};
        pg8::gemm_phase<pg8::EpiOut1, pg8::TileOrder, true>(F.lds, g, S, E);
        if (BOTH(6)) GRID_BAR();
    }
    if (IN(8)) {
        pg8::Gemm g{DM, DM, DM, (size_t)4 * DM * 2, (size_t)DFF * DM * 2};
        pg8::TileOrder S; S.init(M / 256, DFF / 128, F.G, (int)blockIdx.x, XB, Wu_t, (size_t)256 * DM * 2, (size_t)128 * DM * 2, 0);
        pg8::EpiConv E{SSQ, conv_w, conv_b, HACT, Y01, HALO};
        pg8::gemm_phase<pg8::EpiConv, pg8::TileOrder, true>(F.lds, g, S, E);
        if (BOTH(8)) GRID_BAR();
    }
    if (IN(9)) {
        for (int idx = gt; idx < 256 * (DFF / 8); idx += GT) { const int q = idx / (DFF / 8), c8 = idx - q * (DFF / 8);
            if ((q & 31) == 0) continue;
            float y0[16], y1[16];
#pragma unroll
            for (int h = 0; h < 2; ++h)
#pragma unroll
                for (int v = 0; v < 2; ++v) { const int c = h * DFF + 8 * c8 + 4 * v;
                    const f32x4 a0 = *(const f32x4*)(Y01 + (size_t)(q * 2 + 0) * NUP + c), a1 = *(const f32x4*)(Y01 + (size_t)(q * 2 + 1) * NUP + c);
                    const f32x4 h6 = *(const f32x4*)(HALO + (size_t)((q - 1) * 2 + 0) * NUP + c), h7 = *(const f32x4*)(HALO + (size_t)((q - 1) * 2 + 1) * NUP + c);
                    const f32x4 w0 = *(const f32x4*)(conv_w + c), w1 = *(const f32x4*)(conv_w + NUP + c);
                    const f32x4 r0 = a0 + w1 * h7 + w0 * h6, r1 = a1 + w0 * h7;
#pragma unroll
                    for (int j = 0; j < 4; ++j) { y0[8 * h + 4 * v + j] = r0[j]; y1[8 * h + 4 * v + j] = r1[j]; } }
            float o0[8], o1[8];
#pragma unroll
            for (int j = 0; j < 8; ++j) { o0[j] = y0[j] * sigmoidf_(y0[j]) * y0[8 + j]; o1[j] = y1[j] * sigmoidf_(y1[j]) * y1[8 + j]; }
            *(v4u*)(HACT + (size_t)(q * 128 + 0) * DFF + 8 * c8) = pack8(o0); *(v4u*)(HACT + (size_t)(q * 128 + 1) * DFF + 8 * c8) = pack8(o1); }
        if (BOTH(9)) GRID_BAR();
    }
    if (IN(12)) {
        pg8::Gemm g{DFF, DFF, DFF, (size_t)128 * DFF * 2, (size_t)128 * DFF * 2};
        pg8::TileOrder S; S.init(M / 256, DM / 256, F.G, (int)blockIdx.x, HACT, Wd_t, (size_t)256 * DFF * 2, (size_t)256 * DFF * 2, 0);
        pg8::EpiRes E{out, out, DM};
        pg8::gemm_phase<pg8::EpiRes, pg8::TileOrder, true>(F.lds, g, S, E);
    }
#undef IN
#undef BOTH
}

extern "C" void kernel_launch(void* const* d_in, const int* in_sizes, int n_in, void* d_out, int out_size, void* d_ws, size_t ws_size, hipStream_t stream) {
    static int grid = 0;
    if (grid == 0) {
        if (n_in != 16 || in_sizes[0] != M * DM || out_size != M * DM || ws_size < WS_END) { fprintf(stderr, "kernel_launch: unexpected shapes (n_in %d, in0 %d, out %d, ws %zu); nothing launched\n", n_in, n_in > 0 ? in_sizes[0] : -1, out_size, ws_size); grid = -1; return; }
        int dev = 0, cus = 0, per_cu = 0;
        if (hipGetDevice(&dev) != hipSuccess || hipDeviceGetAttribute(&cus, hipDeviceAttributeMultiprocessorCount, dev) != hipSuccess) { grid = -1; return; }
        if (hipFuncSetAttribute((const void*)mega_fwd, hipFuncAttributeMaxDynamicSharedMemorySize, LDS_BYTES) != hipSuccess) { fprintf(stderr, "kernel_launch: hipFuncSetAttribute failed\n"); grid = -1; return; }
        if (hipOccupancyMaxActiveBlocksPerMultiprocessor(&per_cu, (const void*)mega_fwd, NTHR, LDS_BYTES) != hipSuccess || per_cu < 1) { fprintf(stderr, "kernel_launch: occupancy query reports %d blocks per CU\n", per_cu); (void)hipGetLastError(); grid = -1; return; }
        grid = cus;
    }
    if (grid < 0) return;
    if (hipMemsetAsync((char*)d_ws + WS_CTL, 0, CTL_ZERO_BYTES, stream) != hipSuccess) return;
    Args a{};
    for (int i = 0; i < 16; ++i) a.in[i] = d_in[i];
    a.out = (float*)d_out; a.ws = (unsigned char*)d_ws;
    for (int j = 0; j < 8; ++j) a.invf[j] = std::pow(500000.0, -(double)j / 8.0) / 6.283185307179586476925;
    if (MK_N_LAUNCHES == 1) { a.ph_lo = 0; a.ph_hi = N_PHASES; a.li = 0; hipLaunchKernelGGL(mega_fwd, dim3(grid), dim3(NTHR), LDS_BYTES, stream, a); }
    else for (int p = 0; p < N_PHASES; ++p) { a.ph_lo = p; a.ph_hi = p + 1; a.li = p; hipLaunchKernelGGL(mega_fwd, dim3(grid), dim3(NTHR), LDS_BYTES, stream, a); }
}
```

```cpp
#include <hip/hip_runtime.h>
#include <cstdio>
#include <cstdint>
#include <cmath>

#ifndef MK_N_LAUNCHES
#define MK_N_LAUNCHES 1
#endif

constexpr int DM = 1024, NBATCH = 8, SEQ = 4096, M = NBATCH * SEQ;
constexpr int NIN = 4352, DFF = 2816, NUP = 2 * DFF;
constexpr int ZQ = 1024, ZK = 2048, ZV = 2176, ZG = 2304;
constexpr float EPS = 1e-6f, LOG2E = 1.4426950408889634f;

#define GAS __attribute__((address_space(1)))
#define LAS __attribute__((address_space(3)))
typedef unsigned short bf16_t;
typedef unsigned v4u __attribute__((ext_vector_type(4)));
typedef float f32x4 __attribute__((ext_vector_type(4)));
typedef short bf16x8 __attribute__((ext_vector_type(8)));
typedef GAS unsigned gu32;
#define RLX_AGENT __ATOMIC_RELAXED, __HIP_MEMORY_SCOPE_AGENT
#define LDS_WAIT() asm volatile("s_waitcnt lgkmcnt(0)" ::: "memory")
#define VM_WAIT() asm volatile("s_waitcnt vmcnt(0)" ::: "memory")

__device__ __forceinline__ unsigned f2bf(float f) { unsigned u = __builtin_bit_cast(unsigned, f); return (u + 0x7fffu + ((u >> 16) & 1u)) >> 16; }
typedef float f32x2_t __attribute__((ext_vector_type(2))); typedef __bf16 bf16x2_t __attribute__((ext_vector_type(2)));
__device__ __forceinline__ unsigned pk2(float lo, float hi) { f32x2_t v = {lo, hi}; bf16x2_t b = __builtin_convertvector(v, bf16x2_t); return __builtin_bit_cast(unsigned, b); }
__device__ __forceinline__ float bflo(unsigned w) { return __uint_as_float(w << 16); }
__device__ __forceinline__ float bfhi(unsigned w) { return __uint_as_float(w & 0xffff0000u); }
__device__ __forceinline__ void unpack8(const v4u w, float (&f)[8]) { f[0] = bflo(w.x); f[1] = bfhi(w.x); f[2] = bflo(w.y); f[3] = bfhi(w.y); f[4] = bflo(w.z); f[5] = bfhi(w.z); f[6] = bflo(w.w); f[7] = bfhi(w.w); }
__device__ __forceinline__ v4u pack8(const float (&f)[8]) { v4u w; w.x = pk2(f[0], f[1]); w.y = pk2(f[2], f[3]); w.z = pk2(f[4], f[5]); w.w = pk2(f[6], f[7]); return w; }
__device__ __forceinline__ float sigmoidf_(float x) { return __builtin_amdgcn_rcpf(1.f + __builtin_amdgcn_exp2f(-x * LOG2E)); }

namespace pg8 {
constexpr int BM = 256, BK = 64, HALF = 128, HTB = HALF * BK * 2, STAGE_BYTES = 8 * HTB, NXCD = 8, WGM = 8;
__host__ __device__ __forceinline__ int lds_byte(int r, int c) { const int st = (r >> 4) * 2 + (c >> 5), rr = r & 15, cc = c & 31, ob = rr * 64 + cc * 2; return st * 1024 + (ob ^ (((ob >> 9) & 1) << 5)); }
__host__ __device__ __forceinline__ void stage_rc(int b, int& R, int& C) { const int st = b / 1024, sb = b % 1024, swz = sb ^ (((sb >> 9) & 1) << 5); R = (st >> 1) * 16 + swz / 64; C = (st & 1) * 32 + (swz % 64) / 2; }
__host__ __device__ __forceinline__ int perm32(int rho) { const int n = rho >> 4, i = rho & 15; return 8 * (i >> 2) + 4 * n + (i & 3); }

struct Unit { const char* a; const char* b; int pm, pn; };
struct Gemm { int lda, ldb, K; size_t hstepA, hstepB; };

struct TileOrder {
    int nM, nN, nwg, G, c; const char* A; const char* B; size_t sA, sB, sApn;
    __device__ void init(int nM_, int nN_, int G_, int c_, const void* A_, const void* B_, size_t sA_, size_t sB_, size_t sApn_) { nM = nM_; nN = nN_; nwg = nM * nN; G = G_; c = c_; A = (const char*)A_; B = (const char*)B_; sA = sA_; sB = sB_; sApn = sApn_; }
    __device__ bool next(int i, Unit& u) const {
        const long L = (long)i * G + c; if (L >= nwg) return false;
        int wgid = (int)L; { const int q = nwg / NXCD, r = nwg % NXCD, xcd = wgid % NXCD, off = wgid / NXCD; wgid = (xcd < r ? xcd * (q + 1) : r * (q + 1) + (xcd - r) * q) + off; }
        const int nig = WGM * nN, gid = wgid / nig, fm = gid * WGM, gsz = (nM - fm) < WGM ? (nM - fm) : WGM;
        u.pm = fm + ((wgid % nig) % gsz); u.pn = (wgid % nig) / gsz;
        u.a = A + (size_t)u.pm * sA + (size_t)u.pn * sApn; u.b = B + (size_t)u.pn * sB; return true;
    }
};

template <int BMODE> __device__ __forceinline__ int mapB(int R) { return BMODE == 1 ? ((R & ~31) + perm32(R & 31)) : (BMODE == 2 ? (64 * (R >> 5) + perm32(R & 31)) : R); }
template <int AMODE> __device__ __forceinline__ int mapA(int R) { return AMODE == 1 ? (128 * (R >> 6) + 8 * (R & 15) + ((R >> 4) & 3)) : R; }

template <class Epi, class Sched, bool ALIGN_EPI>
__device__ __forceinline__ void gemm_phase(LAS unsigned char* lds, const Gemm g, const Sched& S, const Epi& E) {
    const int tid = threadIdx.x, wid = __builtin_amdgcn_readfirstlane(tid >> 6), lane = tid & 63, wr = wid >> 2, wc = wid & 3, fr = lane & 15, fq = lane >> 4;
    const int nt = g.K / BK;
    unsigned voffA[2], voffB[2];
#pragma unroll
    for (int i = 0; i < 2; ++i) { int R, C; stage_rc(tid * 16 + i * 8192, R, C); const int Rb = mapB<Epi::BMODE>(R);
        voffA[i] = (unsigned)(mapA<Epi::AMODE>(R) * g.lda + C) * 2u; voffB[i] = (unsigned)(Rb * g.ldb + C) * 2u; }
    const size_t kstep = (size_t)(BK * 2);
    const size_t hstepA = g.hstepA, hstepB = g.hstepB;
    const unsigned ldsw = (unsigned)wid * 1024u;
    const int aoff = lds_byte(wr * 64 + fr, fq * 8), boff = lds_byte(wc * 32 + fr, fq * 8);
#define PG8_SA(b, h) (((b) * 2 + (h)) * HTB)
#define PG8_SB(b, h) ((4 + (b) * 2 + (h)) * HTB)
#define PG8_STAGE(bufoff, gbase, voff) do { _Pragma("unroll") for (int _i = 0; _i < 2; ++_i) \
        __builtin_amdgcn_global_load_lds((const unsigned*)((const char*)(gbase) + (voff)[_i]), (LAS unsigned*)(lds + (bufoff) + ldsw + _i * 8192), 16, 0, 0); } while (0)
#define PG8_LDA(dst, b, h) do { _Pragma("unroll") for (int m = 0; m < 4; ++m) _Pragma("unroll") for (int k = 0; k < 2; ++k) dst[m][k] = *(const LAS bf16x8*)(lds + PG8_SA(b, h) + aoff + m * 2048 + k * 1024); } while (0)
#define PG8_LDB(dst, b, h) do { _Pragma("unroll") for (int n = 0; n < 2; ++n) _Pragma("unroll") for (int k = 0; k < 2; ++k) dst[n][k] = *(const LAS bf16x8*)(lds + PG8_SB(b, h) + boff + n * 2048 + k * 1024); } while (0)
#define PG8_MMA(ai, bj, At, Bt) do { __builtin_amdgcn_s_setprio(1); _Pragma("unroll") for (int m = 0; m < 4; ++m) _Pragma("unroll") for (int n = 0; n < 2; ++n) _Pragma("unroll") for (int k = 0; k < 2; ++k) \
        acc[ai][bj][m][n] = __builtin_amdgcn_mfma_f32_16x16x32_bf16(Bt[n][k], At[m][k], acc[ai][bj][m][n], 0, 0, 0); __builtin_amdgcn_s_setprio(0); } while (0)
#define PG8_WAIT_V(n) asm volatile("s_waitcnt vmcnt(" #n ")" ::: "memory")
#define PG8_WAIT_L(n) asm volatile("s_waitcnt lgkmcnt(" #n ")" ::: "memory")
#define PG8_BAR __builtin_amdgcn_s_barrier()
#define PG8_SCHED __builtin_amdgcn_sched_barrier(0)
    Unit cur, nxt; int ui = 0;
    if (!S.next(0, cur)) return;
    f32x4 acc[2][2][4][2];
#pragma unroll
    for (int a = 0; a < 2; ++a)
#pragma unroll
        for (int b = 0; b < 2; ++b)
#pragma unroll
            for (int m = 0; m < 4; ++m)
#pragma unroll
                for (int n = 0; n < 2; ++n) acc[a][b][m][n] = (f32x4){0.f, 0.f, 0.f, 0.f};
    bf16x8 At[4][2], B0[2][2], B1[2][2];
    const char* cA = cur.a; const char* cB = cur.b;
    PG8_STAGE(PG8_SB(0, 0), cB, voffB); PG8_STAGE(PG8_SB(0, 1), cB + hstepB, voffB); PG8_STAGE(PG8_SA(0, 0), cA, voffA); PG8_STAGE(PG8_SA(0, 1), cA + hstepA, voffA);
    if (wr == 1) PG8_BAR;
    PG8_WAIT_V(2); PG8_BAR;
    PG8_STAGE(PG8_SB(1, 0), cB + kstep, voffB); PG8_STAGE(PG8_SA(1, 0), cA + kstep, voffA); PG8_STAGE(PG8_SB(1, 1), cB + hstepB + kstep, voffB);
    PG8_WAIT_V(6); PG8_BAR;
    for (;;) {
        const bool has_next = S.next(ui + 1, nxt);
        const char* nA = has_next ? nxt.a : cA; const char* nB = has_next ? nxt.b : cB;
        for (int t = 0; t < nt; t += 2) {
            const bool last = (t == nt - 2);
            const char* a1 = cA + (size_t)(t + 1) * kstep;
            const char* a2 = last ? nA : cA + (size_t)(t + 2) * kstep; const char* b2 = last ? nB : cB + (size_t)(t + 2) * kstep;
            const char* a3 = a2 + kstep; const char* b3 = b2 + kstep;
            PG8_LDB(B0, 0, 0); PG8_LDB(B1, 0, 1); PG8_SCHED; PG8_LDA(At, 0, 0); PG8_STAGE(PG8_SA(1, 1), a1 + hstepA, voffA);
            PG8_WAIT_V(8); PG8_WAIT_L(0); PG8_BAR; PG8_MMA(0, 0, At, B0); PG8_MMA(0, 1, At, B1); PG8_BAR; PG8_SCHED;
            PG8_LDA(At, 0, 1); PG8_STAGE(PG8_SB(0, 0), b2, voffB); PG8_STAGE(PG8_SB(0, 1), b2 + hstepB, voffB); PG8_STAGE(PG8_SA(0, 0), a2, voffA);
            PG8_WAIT_V(8); PG8_WAIT_L(0); PG8_BAR; PG8_MMA(1, 0, At, B0); PG8_MMA(1, 1, At, B1); PG8_BAR; PG8_SCHED;
            PG8_LDB(B0, 1, 0); PG8_LDB(B1, 1, 1); PG8_SCHED; PG8_LDA(At, 1, 0); PG8_STAGE(PG8_SA(0, 1), a2 + hstepA, voffA);
            PG8_WAIT_V(8); PG8_WAIT_L(0); PG8_BAR; PG8_MMA(0, 0, At, B0); PG8_MMA(0, 1, At, B1); PG8_BAR; PG8_SCHED;
            PG8_LDA(At, 1, 1); PG8_STAGE(PG8_SB(1, 0), b3, voffB); PG8_STAGE(PG8_SB(1, 1), b3 + hstepB, voffB); PG8_STAGE(PG8_SA(1, 0), a3, voffA);
            PG8_WAIT_V(8); PG8_WAIT_L(0); PG8_BAR; PG8_MMA(1, 0, At, B0); PG8_MMA(1, 1, At, B1); PG8_BAR; PG8_SCHED;
        }
        if constexpr (ALIGN_EPI) { if (wr == 0) PG8_BAR; }
        E(acc, cur, wr, wc, fr, fq);
        if (!has_next) break;
#pragma unroll
        for (int a = 0; a < 2; ++a)
#pragma unroll
            for (int b = 0; b < 2; ++b)
#pragma unroll
                for (int m = 0; m < 4; ++m)
#pragma unroll
                    for (int n = 0; n < 2; ++n) acc[a][b][m][n] = (f32x4){0.f, 0.f, 0.f, 0.f};
        cur = nxt; cA = nA; cB = nB; ++ui;
        if constexpr (ALIGN_EPI) { if (wr == 1) PG8_BAR; }
    }
    PG8_WAIT_V(0);
    if constexpr (!ALIGN_EPI) { if (wr == 0) PG8_BAR; }
    PG8_BAR;
#undef PG8_SA
#undef PG8_SB
#undef PG8_STAGE
#undef PG8_LDA
#undef PG8_LDB
#undef PG8_MMA
#undef PG8_WAIT_V
#undef PG8_WAIT_L
#undef PG8_BAR
#undef PG8_SCHED
}

struct EpiIn {
    static constexpr int BMODE = 2, AMODE = 0;
    const float* r1; const float* qn; const float* kn; const float* bg; bf16_t* U; bf16_t* Q; bf16_t* Kb; bf16_t* Vb; bf16_t* G;
    __device__ __forceinline__ void operator()(const f32x4 (&acc)[2][2][4][2], const Unit& u, int wr, int wc, int fr, int fq) const {
        const int row0 = u.pm * BM + wr * 64 + fr, hc = wc * 64 + 8 * fq, pn = u.pn;
        int mode, ld, coloff; bf16_t* base; const float* par = nullptr; float qs = 1.f;
        if (pn < 4) { mode = 0; base = U; ld = DM; coloff = pn * 256 + hc; }
        else if (pn < 8) { mode = 1; base = Q; ld = DM; coloff = (pn - 4) * 256 + hc; par = qn + 8 * fq; qs = 0.125f * LOG2E; }
        else if (pn == 8) { if (wc < 2) { mode = 1; base = Kb; ld = 128; coloff = hc; par = kn + 8 * fq; } else { mode = 0; base = Vb; ld = 128; coloff = hc - 128; } }
        else { mode = 2; base = G; ld = 2 * DM; coloff = (pn - 9) * 256 + hc; par = bg + coloff; }
        float rs[8];
#pragma unroll
        for (int e = 0; e < 8; ++e) rs[e] = r1[row0 + (e >> 2) * HALF + (e & 3) * 16];
        f32x4 pv[2][2];
#pragma unroll
        for (int bj = 0; bj < 2; ++bj)
#pragma unroll
            for (int n = 0; n < 2; ++n) pv[bj][n] = par ? *(const f32x4*)(par + 32 * bj + 4 * n) : (f32x4){0.f, 0.f, 0.f, 0.f};
        asm volatile("" : "+v"(rs[0]), "+v"(rs[1]), "+v"(rs[2]), "+v"(rs[3]), "+v"(rs[4]), "+v"(rs[5]), "+v"(rs[6]), "+v"(rs[7]));
        asm volatile("" : "+v"(pv[0][0]), "+v"(pv[0][1]), "+v"(pv[1][0]), "+v"(pv[1][1]));
#pragma unroll
        for (int e = 0; e < 8; ++e) { const int ai = e >> 2, m = e & 3; const int row = row0 + ai * HALF + m * 16;
            f32x4 v[2][2];
#pragma unroll
            for (int bj = 0; bj < 2; ++bj)
#pragma unroll
                for (int n = 0; n < 2; ++n) v[bj][n] = acc[ai][bj][m][n] * rs[e];
            if (mode == 1) { float ss = 0.f;
#pragma unroll
                for (int bj = 0; bj < 2; ++bj)
#pragma unroll
                    for (int n = 0; n < 2; ++n) ss += (v[bj][n][0] * v[bj][n][0] + v[bj][n][1] * v[bj][n][1]) + (v[bj][n][2] * v[bj][n][2] + v[bj][n][3] * v[bj][n][3]);
                ss += __shfl_xor(ss, 16); ss += __shfl_xor(ss, 32);
                const float rr = qs / sqrtf(ss * (1.f / 64.f) + EPS);
#pragma unroll
                for (int bj = 0; bj < 2; ++bj)
#pragma unroll
                    for (int n = 0; n < 2; ++n) v[bj][n] = v[bj][n] * rr * pv[bj][n]; }
            else if (mode == 2) {
#pragma unroll
                for (int bj = 0; bj < 2; ++bj)
#pragma unroll
                    for (int n = 0; n < 2; ++n)
#pragma unroll
                        for (int j = 0; j < 4; ++j) v[bj][n][j] = sigmoidf_(v[bj][n][j] + pv[bj][n][j]); }
            bf16_t* rowp = base + (size_t)row * ld + coloff;
#pragma unroll
            for (int bj = 0; bj < 2; ++bj) { v4u w; w.x = pk2(v[bj][0][0], v[bj][0][1]); w.y = pk2(v[bj][0][2], v[bj][0][3]); w.z = pk2(v[bj][1][0], v[bj][1][1]); w.w = pk2(v[bj][1][2], v[bj][1][3]);
                *(v4u*)(rowp + 32 * bj) = w; } }
    }
};
struct EpiRes {
    static constexpr int BMODE = 0, AMODE = 0;
    const float* base; float* out; int ldc;
    __device__ __forceinline__ void operator()(const f32x4 (&acc)[2][2][4][2], const Unit& u, int wr, int wc, int fr, int fq) const {
        const int row0 = u.pm * BM + wr * 64 + fr, col0 = u.pn * BM + wc * 32 + 4 * fq;
#pragma unroll
        for (int ai = 0; ai < 2; ++ai) { f32x4 b[4][2][2];
#pragma unroll
            for (int m = 0; m < 4; ++m)
#pragma unroll
                for (int bj = 0; bj < 2; ++bj)
#pragma unroll
                    for (int n = 0; n < 2; ++n) b[m][bj][n] = *(const f32x4*)(base + (size_t)(row0 + ai * HALF + m * 16) * ldc + col0 + bj * HALF + n * 16);
#pragma unroll
            for (int m = 0; m < 4; ++m) asm volatile("" : "+v"(b[m][0][0]), "+v"(b[m][0][1]), "+v"(b[m][1][0]), "+v"(b[m][1][1]));
#pragma unroll
            for (int m = 0; m < 4; ++m)
#pragma unroll
                for (int bj = 0; bj < 2; ++bj)
#pragma unroll
                    for (int n = 0; n < 2; ++n) *(f32x4*)(out + (size_t)(row0 + ai * HALF + m * 16) * ldc + col0 + bj * HALF + n * 16) = b[m][bj][n] + acc[ai][bj][m][n];
            asm volatile("" ::: "memory"); }
    }
};
struct EpiMix {
    static constexpr int BMODE = 1, AMODE = 0;
    const bf16_t* G; const bf16_t* BO; bf16_t* MIX;
    __device__ __forceinline__ void operator()(const f32x4 (&acc)[2][2][4][2], const Unit& u, int wr, int wc, int fr, int fq) const {
        const int row0 = u.pm * BM + wr * 64 + fr, col0 = u.pn * BM + wc * 32 + 8 * fq;
#pragma unroll
        for (int ai = 0; ai < 2; ++ai)
#pragma unroll
            for (int mh = 0; mh < 2; ++mh) { v4u gp[2][2], ga[2][2], bo[2][2];
#pragma unroll
                for (int mm = 0; mm < 2; ++mm)
#pragma unroll
                    for (int bj = 0; bj < 2; ++bj) { const size_t row = (size_t)(row0 + ai * HALF + (2 * mh + mm) * 16); const int c = col0 + bj * HALF;
                        gp[mm][bj] = *(const v4u*)(G + row * (2 * DM) + c); ga[mm][bj] = *(const v4u*)(G + row * (2 * DM) + DM + c); bo[mm][bj] = *(const v4u*)(BO + row * DM + c); }
                asm volatile("" : "+v"(gp[0][0]), "+v"(gp[0][1]), "+v"(gp[1][0]), "+v"(gp[1][1]), "+v"(ga[0][0]), "+v"(ga[0][1]), "+v"(ga[1][0]), "+v"(ga[1][1]));
                asm volatile("" : "+v"(bo[0][0]), "+v"(bo[0][1]), "+v"(bo[1][0]), "+v"(bo[1][1]));
#pragma unroll
                for (int mm = 0; mm < 2; ++mm)
#pragma unroll
                    for (int bj = 0; bj < 2; ++bj) { const int m = 2 * mh + mm; const size_t row = (size_t)(row0 + ai * HALF + m * 16); const int c = col0 + bj * HALF;
                        float p[8], a[8], b[8], o[8]; unpack8(gp[mm][bj], p); unpack8(ga[mm][bj], a); unpack8(bo[mm][bj], b);
                        const f32x4 a0 = acc[ai][bj][m][0], a1 = acc[ai][bj][m][1];
#pragma unroll
                        for (int j = 0; j < 4; ++j) { o[j] = p[j] * a0[j] + a[j] * b[j]; o[4 + j] = p[4 + j] * a1[j] + a[4 + j] * b[4 + j]; }
                        *(v4u*)(MIX + row * DM + c) = pack8(o); }
                asm volatile("" ::: "memory"); }
    }
};
struct EpiOut1 {
    static constexpr int BMODE = 1, AMODE = 0;
    const float* x; float* out; bf16_t* X1B; float* SSQ;
    __device__ __forceinline__ void operator()(const f32x4 (&acc)[2][2][4][2], const Unit& u, int wr, int wc, int fr, int fq) const {
        const int row0 = u.pm * BM + wr * 64 + fr, col0 = u.pn * BM + wc * 32 + 8 * fq;
#pragma unroll
        for (int ai = 0; ai < 2; ++ai) { f32x4 xv[4][2][2];
#pragma unroll
            for (int m = 0; m < 4; ++m)
#pragma unroll
                for (int bj = 0; bj < 2; ++bj) { const size_t off = (size_t)(row0 + ai * HALF + m * 16) * DM + col0 + bj * HALF; xv[m][bj][0] = *(const f32x4*)(x + off); xv[m][bj][1] = *(const f32x4*)(x + off + 4); }
#pragma unroll
            for (int m = 0; m < 4; ++m) asm volatile("" : "+v"(xv[m][0][0]), "+v"(xv[m][0][1]), "+v"(xv[m][1][0]), "+v"(xv[m][1][1]));
#pragma unroll
            for (int m = 0; m < 4; ++m) { const size_t row = (size_t)(row0 + ai * HALF + m * 16); float ss = 0.f;
#pragma unroll
                for (int bj = 0; bj < 2; ++bj) { const size_t off = row * DM + col0 + bj * HALF;
                    const f32x4 v0 = xv[m][bj][0] + acc[ai][bj][m][0], v1 = xv[m][bj][1] + acc[ai][bj][m][1];
                    *(f32x4*)(out + off) = v0; *(f32x4*)(out + off + 4) = v1;
                    ss += (v0[0] * v0[0] + v0[1] * v0[1]) + (v0[2] * v0[2] + v0[3] * v0[3]) + (v1[0] * v1[0] + v1[1] * v1[1]) + (v1[2] * v1[2] + v1[3] * v1[3]);
                    v4u w; w.x = pk2(v0[0], v0[1]); w.y = pk2(v0[2], v0[3]); w.z = pk2(v1[0], v1[1]); w.w = pk2(v1[2], v1[3]);
                    *(v4u*)(X1B + off) = w; }
                ss += __shfl_xor(ss, 16); ss += __shfl_xor(ss, 32);
                if (fq == 0) SSQ[row * 16 + u.pn * 4 + wc] = ss; }
            asm volatile("" ::: "memory"); }
    }
};
__device__ __forceinline__ float dpp_shr1(float v) { return __int_as_float(__builtin_amdgcn_update_dpp(0, __float_as_int(v), 0x111, 0xf, 0xf, true)); }
__device__ __forceinline__ f32x4 dpp_shr1(f32x4 v) { f32x4 r; r[0] = dpp_shr1(v[0]); r[1] = dpp_shr1(v[1]); r[2] = dpp_shr1(v[2]); r[3] = dpp_shr1(v[3]); return r; }
struct EpiConv {
    static constexpr int BMODE = 1, AMODE = 1;
    const float* ssq; const float* cw; const float* cb; bf16_t* HACT; float* Y01; float* HALO;
    __device__ __forceinline__ void operator()(f32x4 (&acc)[2][2][4][2], const Unit& u, int wr, int wc, int fr, int fq) const {
#define AE(e, bj, n) acc[(e) >> 2][bj][(e) & 3][n]
        const int trow0 = u.pm * BM + 128 * wr + 8 * fr, q = u.pm * 2 + wr, colg = u.pn * 128 + wc * 32 + 8 * fq;
        f32x4 sp[8], cwv[4][4];
#pragma unroll
        for (int e = 0; e < 8; ++e) sp[e] = *(const f32x4*)(ssq + (size_t)(trow0 + e) * 16 + 4 * fq);
#define LDCW(it) do { const int c = ((it) >> 1) * DFF + colg + 4 * ((it) & 1); cwv[it][0] = *(const f32x4*)(cw + c); cwv[it][1] = *(const f32x4*)(cw + NUP + c); cwv[it][2] = *(const f32x4*)(cw + 2 * NUP + c); cwv[it][3] = *(const f32x4*)(cb + c); } while (0)
        LDCW(0);
        asm volatile("" : "+v"(sp[0]), "+v"(sp[1]), "+v"(sp[2]), "+v"(sp[3]), "+v"(sp[4]), "+v"(sp[5]), "+v"(sp[6]), "+v"(sp[7]));
#pragma unroll
        for (int e = 0; e < 8; ++e) { float t = (sp[e].x + sp[e].y) + (sp[e].z + sp[e].w); t += __shfl_xor(t, 16); t += __shfl_xor(t, 32);
            const float r2 = 1.f / sqrtf(t * (1.f / 1024.f) + EPS);
#pragma unroll
            for (int bj = 0; bj < 2; ++bj) { AE(e, bj, 0) *= r2; AE(e, bj, 1) *= r2; }
            asm volatile("" : "+v"(AE(e, 0, 0)), "+v"(AE(e, 0, 1)), "+v"(AE(e, 1, 0)), "+v"(AE(e, 1, 1))); }
        if (fr == 15) {
#pragma unroll
            for (int e = 6; e < 8; ++e)
#pragma unroll
                for (int bj = 0; bj < 2; ++bj) { float* hp = HALO + ((size_t)(q * 2 + (e - 6)) * NUP + bj * DFF + colg); *(f32x4*)hp = AE(e, bj, 0); *(f32x4*)(hp + 4) = AE(e, bj, 1); } }
#pragma unroll
        for (int it = 0; it < 4; ++it) { const int bj = it >> 1, n = it & 1;
            asm volatile("" ::: "memory");
            if (it < 3) LDCW(it + 1);
            asm volatile("" : "+v"(cwv[it][0]), "+v"(cwv[it][1]), "+v"(cwv[it][2]), "+v"(cwv[it][3]));
            const f32x4 w0 = cwv[it][0], w1 = cwv[it][1], w2 = cwv[it][2], bb = cwv[it][3];
            const f32x4 p6 = dpp_shr1(AE(6, bj, n)), p7 = dpp_shr1(AE(7, bj, n));
#pragma unroll
            for (int e = 7; e >= 2; --e) AE(e, bj, n) = w2 * AE(e, bj, n) + (w1 * AE(e - 1, bj, n) + (w0 * AE(e - 2, bj, n) + bb));
            AE(1, bj, n) = w2 * AE(1, bj, n) + (w1 * AE(0, bj, n) + (w0 * p7 + bb));
            AE(0, bj, n) = w2 * AE(0, bj, n) + (w1 * p7 + (w0 * p6 + bb));
            asm volatile("" : "+v"(AE(0, bj, n)), "+v"(AE(1, bj, n)), "+v"(AE(2, bj, n)), "+v"(AE(3, bj, n)), "+v"(AE(4, bj, n)), "+v"(AE(5, bj, n)), "+v"(AE(6, bj, n)), "+v"(AE(7, bj, n))); }
#undef LDCW
        if (fr == 0) {
#pragma unroll
            for (int e = 0; e < 2; ++e)
#pragma unroll
                for (int bj = 0; bj < 2; ++bj) { float* yp = Y01 + ((size_t)(q * 2 + e) * NUP + bj * DFF + colg); *(f32x4*)yp = AE(e, bj, 0); *(f32x4*)(yp + 4) = AE(e, bj, 1); } }
#pragma unroll
        for (int e = 0; e < 8; ++e) { const f32x4 g0 = AE(e, 0, 0), g1 = AE(e, 0, 1), v0 = AE(e, 1, 0), v1 = AE(e, 1, 1); float o[8];
#pragma unroll
            for (int j = 0; j < 4; ++j) { o[j] = g0[j] * sigmoidf_(g0[j]) * v0[j]; o[4 + j] = g1[j] * sigmoidf_(g1[j]) * v1[j]; }
            *(v4u*)(HACT + (size_t)(trow0 + e) * DFF + colg) = pack8(o); asm volatile("" ::: "memory"); }
#undef AE
    }
};
}

constexpr int NWAVES = 8, NTHR = NWAVES * 64;
constexpr int N_PHASES = 13;
constexpr size_t MiB = 1u << 20;
constexpr size_t WS_CTL = 0, CTL_ZERO_BYTES = 1 * MiB;
constexpr size_t WS_R1 = 1 * MiB;
constexpr size_t WS_SSQ = 498 * MiB;
constexpr size_t WS_TAB = 2 * MiB;
constexpr size_t WS_WIN = 4 * MiB, WS_WP = 13 * MiB, WS_WO = 14 * MiB, WS_WU = 16 * MiB, WS_WD = 28 * MiB;
constexpr size_t WS_XB = 34 * MiB;
constexpr size_t WS_Z = 98 * MiB;
constexpr size_t WS_Y01 = WS_Z, WS_HALO = WS_Z + 16 * MiB, WS_HACT = WS_Z + 176 * MiB;
constexpr size_t WS_B = 370 * MiB;
constexpr size_t WS_AP = 434 * MiB;
constexpr size_t WS_END = 500 * MiB;
static_assert(WS_WIN + (size_t)NIN * DM * 2 <= WS_WP && WS_WU + (size_t)NUP * DM * 2 <= WS_WD && WS_WD + (size_t)DM * DFF * 2 <= WS_XB, "weights map");
static_assert(WS_Z + (size_t)M * NIN * 2 <= WS_B && WS_HACT + (size_t)M * DFF * 2 <= WS_SSQ && WS_AP + (size_t)M * DM * 2 <= WS_SSQ, "activation map");
constexpr int CW_BAR = 4096;
constexpr int RING_BYTES = 131072, LDSCTL_OFF = RING_BYTES, MISC_OFF = LDSCTL_OFF + 320, LDS_BYTES = 147456;

#define XB_TMO      128
#define XB_XCNT(j)  (256  + 64 * (j))
#define XB_XSUB(j)  (1280 + 64 * (j))
#define XB_XGEN(j)  (2304 + 64 * (j))
#define XB_TOP      3328
#define XB_TOPGEN   3392
#define XCD_BAR_WORDS 3456
#define XB_SPIN_CAP (1u << 18)
__device__ __forceinline__ unsigned xb_ld(unsigned* p)              { return __hip_atomic_load(p, __ATOMIC_RELAXED, __HIP_MEMORY_SCOPE_AGENT); }
__device__ __forceinline__ unsigned xb_add(unsigned* p, unsigned v) { return __hip_atomic_fetch_add(p, v, __ATOMIC_RELAXED, __HIP_MEMORY_SCOPE_AGENT); }
__device__ __forceinline__ unsigned xb_xcc_id() { return (unsigned)__builtin_amdgcn_s_getreg((3 << 11) | 20) & 0xFu; }
#define XB_SPIN(cond, bar) do { unsigned _sp = 0; while (cond) { __builtin_amdgcn_s_sleep(1); \
    if ((++_sp & 255u) == 0u) { if (xb_ld(&(bar)[XB_TMO])) break; if (_sp > XB_SPIN_CAP) { atomicAdd(&(bar)[XB_TMO], 1u); break; } } } } while (0)
struct XcdBarrier { unsigned* bar; unsigned x; volatile LAS unsigned* st; };
__device__ __forceinline__ XcdBarrier xcd_barrier_post(unsigned* bar, volatile LAS unsigned* st) {
    XcdBarrier b; b.bar = bar; b.x = xb_xcc_id(); b.st = st;
    if (threadIdx.x == 0) (void)xb_add(&bar[XB_XCNT(b.x)], 1u);
    return b;
}
__device__ __forceinline__ void xcd_barrier_complete(unsigned* bar, unsigned x, unsigned& nloc, unsigned& nx) {
    const unsigned G = gridDim.x * gridDim.y * gridDim.z;
    unsigned sum, cnt, mine, sp = 0u;
    for (;;) {
        sum = 0u; cnt = 0u; mine = 0u;
#pragma unroll
        for (unsigned j = 0; j < 16; ++j) { const unsigned c = xb_ld(&bar[XB_XCNT(j)]); sum += c; cnt += (c > 0u) ? 1u : 0u; mine = (j == x) ? c : mine; }
        if (sum == G) break;
        __builtin_amdgcn_s_sleep(1);
        if ((++sp & 255u) == 0u) { if (xb_ld(&bar[XB_TMO])) break; if (sp > XB_SPIN_CAP) { atomicAdd(&bar[XB_TMO], 1u); break; } }
    }
    nloc = mine > 0u ? mine : 1u; nx = cnt > 0u ? cnt : 1u;
}
__device__ __forceinline__ void xcd_barrier(const XcdBarrier& b) {
    asm volatile("s_waitcnt vmcnt(0)" ::: "memory");
    __syncthreads();
    if (threadIdx.x == 0) {
        unsigned* bar = b.bar;
        __builtin_amdgcn_s_waitcnt(0);
        unsigned nloc = b.st[0], nx = b.st[1];
        if (nloc == 0u) { xcd_barrier_complete(bar, b.x, nloc, nx); b.st[0] = nloc; b.st[1] = nx; }
        const unsigned old = xb_add(&bar[XB_XSUB(b.x)], 1u);
        const unsigned gen = old / nloc;
        if (old + 1u == (gen + 1u) * nloc) {
            __builtin_amdgcn_fence(__ATOMIC_RELEASE, "agent");
            asm volatile("s_waitcnt vmcnt(0)" ::: "memory");
            const unsigned og = xb_add(&bar[XB_TOP], 1u);
            const unsigned tg = og / nx;
            if (og + 1u == (tg + 1u) * nx) xb_add(&bar[XB_TOPGEN], 1u);
            else XB_SPIN(xb_ld(&bar[XB_TOPGEN]) == tg, bar);
            __builtin_amdgcn_fence(__ATOMIC_ACQUIRE, "agent");
            xb_add(&bar[XB_XGEN(b.x)], 1u);
            asm volatile("s_waitcnt vmcnt(0)" ::: "memory");
        } else {
            XB_SPIN(xb_ld(&bar[XB_XGEN(b.x)]) == gen, bar);
            __builtin_amdgcn_fence(__ATOMIC_ACQUIRE, "agent");
            asm volatile("s_waitcnt vmcnt(0)" ::: "memory");
        }
    }
    __syncthreads();
}

struct Frame {
    LAS unsigned char* lds; volatile LAS unsigned* MISC; gu32* ctl;
    int tid, lane, wave, vcu, G;
};
__device__ __forceinline__ float wave_sum(float v) {
#pragma unroll
    for (int o = 1; o < 64; o <<= 1) v += __shfl_xor(v, o);
    return v;
}

__device__ __forceinline__ void p0_transpose_item(const float* W, int K, int N, bf16_t* WT, const float* kscale, const float* nscale, LAS float* scr, int item, int lane) {
    const int nblk = N / 32, kb = item / nblk, nb = item % nblk, k0 = 64 * kb, n0 = 32 * nb;
    const float ns = nscale ? nscale[n0 + (lane & 31)] : 1.f;
#pragma unroll 8
    for (int i = 0; i < 32; ++i) { const int kk = 2 * i + (lane >> 5); const float ks = kscale ? kscale[k0 + kk] : 1.f; scr[kk * 33 + (lane & 31)] = W[(size_t)(k0 + kk) * N + n0 + (lane & 31)] * ks * ns; }
    LDS_WAIT(); asm volatile("" ::: "memory");
    const int c = lane & 7;
#pragma unroll
    for (int j = 0; j < 4; ++j) { const int n = (lane >> 3) + 8 * j; const LAS float* s = scr + (8 * c) * 33 + n;
        v4u o; o.x = pk2(s[0 * 33], s[1 * 33]); o.y = pk2(s[2 * 33], s[3 * 33]); o.z = pk2(s[4 * 33], s[5 * 33]); o.w = pk2(s[6 * 33], s[7 * 33]);
        *(GAS v4u*)(WT + (size_t)(n0 + n) * K + k0 + 8 * c) = o; }
    LDS_WAIT(); asm volatile("" ::: "memory");
}
__device__ __forceinline__ void row_bf16_rs(int lane, const float* xrow, bf16_t* orow, float* rs) {
    const GAS f32x4* xr = (const GAS f32x4*)xrow + lane;
    f32x4 v[4]; float s = 0.f;
#pragma unroll
    for (int j = 0; j < 4; ++j) { v[j] = xr[64 * j]; s += (v[j].x * v[j].x + v[j].y * v[j].y) + (v[j].z * v[j].z + v[j].w * v[j].w); }
    s = wave_sum(s);
    if (lane == 0) *rs = 1.f / sqrtf(s * (1.f / DM) + EPS);
    GAS unsigned long long* o8 = (GAS unsigned long long*)orow + lane;
#pragma unroll
    for (int j = 0; j < 4; ++j) o8[64 * j] = (unsigned long long)pk2(v[j].x, v[j].y) | ((unsigned long long)pk2(v[j].z, v[j].w) << 32);
}

typedef float f32x16 __attribute__((ext_vector_type(16)));
typedef short s16x4 __attribute__((ext_vector_type(4)));
constexpr int AT_KP = 72, AT_VP = 260;
constexpr int AT_K_OFF = 0, AT_V_OFF = 256 * AT_KP * 2, AT_W_OFF = 71680, AT_W_BYTES = 4608;
static_assert(AT_V_OFF + 64 * AT_VP * 2 <= AT_W_OFF && AT_W_OFF + 8 * AT_W_BYTES <= RING_BYTES, "attention LDS map");
__device__ __forceinline__ int crow16(int r, int hi) { return (r & 3) + 8 * (r >> 2) + 4 * hi; }
__device__ __forceinline__ void attn_phase(Frame& F, const bf16_t* Q, int ldq, const bf16_t* K, int ldk, const bf16_t* V, int ldv, const float* TAB, const float* sinks, bf16_t* BO) {
    LAS bf16_t* Ks = (LAS bf16_t*)(F.lds + AT_K_OFF); LAS bf16_t* Vt = (LAS bf16_t*)(F.lds + AT_V_OFF);
    LAS bf16_t* stg = (LAS bf16_t*)(F.lds + AT_W_OFF + F.wave * AT_W_BYTES); LAS float* wsf = (LAS float*)(F.lds + AT_W_OFF + F.wave * AT_W_BYTES + 4096);
    const int lane = F.lane, r32 = lane & 31, hi = lane >> 5;
    const float NEG = -INFINITY;
    for (int unit = F.vcu; unit < NBATCH * 32 * 2; unit += F.G) {
        const int kvh = unit & 1, nblk = (unit >> 1) & 31, b = unit >> 6;
        const long row0 = (long)b * SEQ + (long)nblk * 128;
        __syncthreads();
#pragma unroll
        for (int i = 0; i < 4; ++i) { const int c = F.tid + i * NTHR, r = c >> 3, ch = c & 7; const long grow = row0 - 128 + r; v4u kv = {0u, 0u, 0u, 0u}, vv = {0u, 0u, 0u, 0u};
            const bool live = grow >= (long)b * SEQ;
            if (live) { kv = *(const v4u*)(K + (size_t)grow * ldk + 64 * kvh + 8 * ch); vv = *(const v4u*)(V + (size_t)grow * ldv + 64 * kvh + 8 * ch); }
            {
                v4u pr; pr.x = __shfl_xor(kv.x, 1); pr.y = __shfl_xor(kv.y, 1); pr.z = __shfl_xor(kv.z, 1); pr.w = __shfl_xor(kv.w, 1);
                if (live && ch < 2) { float a[8], p[8], o[8]; unpack8(kv, a); unpack8(pr, p);
                    const float* tb = TAB + (size_t)grow * 16; const f32x4 c0 = *(const f32x4*)tb, c1 = *(const f32x4*)(tb + 4), s0 = *(const f32x4*)(tb + 8), s1 = *(const f32x4*)(tb + 12);
                    const float sg = ch == 0 ? -1.f : 1.f;
#pragma unroll
                    for (int j = 0; j < 4; ++j) { o[j] = a[j] * c0[j] + sg * p[j] * s0[j]; o[4 + j] = a[4 + j] * c1[j] + sg * p[4 + j] * s1[j]; }
                    kv = pack8(o); } }
            *(LAS v4u*)(Ks + r * AT_KP + 8 * ch) = kv;
            LAS bf16_t* vp = Vt + (8 * ch) * AT_VP + r;
            vp[0 * AT_VP] = (bf16_t)(vv.x & 0xffffu); vp[1 * AT_VP] = (bf16_t)(vv.x >> 16); vp[2 * AT_VP] = (bf16_t)(vv.y & 0xffffu); vp[3 * AT_VP] = (bf16_t)(vv.y >> 16);
            vp[4 * AT_VP] = (bf16_t)(vv.z & 0xffffu); vp[5 * AT_VP] = (bf16_t)(vv.z >> 16); vp[6 * AT_VP] = (bf16_t)(vv.w & 0xffffu); vp[7 * AT_VP] = (bf16_t)(vv.w >> 16); }
        __syncthreads();
        const int head = kvh * 8 + F.wave;
        const float sinkv = sinks[head] * LOG2E;
#pragma unroll 1
        for (int c = 0; c < 4; ++c) {
            const bf16_t* qp = Q + (size_t)(row0 + 32 * c + r32) * ldq + 64 * head + 8 * hi;
            bf16x8 qf[4];
#pragma unroll
            for (int s = 0; s < 4; ++s) qf[s] = *(const bf16x8*)(qp + 16 * s);
            {
                const float* tb = TAB + (size_t)(row0 + 32 * c + r32) * 16; const f32x4 c0 = *(const f32x4*)tb, c1 = *(const f32x4*)(tb + 4), s0 = *(const f32x4*)(tb + 8), s1 = *(const f32x4*)(tb + 12);
                const v4u w = __builtin_bit_cast(v4u, qf[0]); v4u pr; pr.x = __shfl_xor(w.x, 32); pr.y = __shfl_xor(w.y, 32); pr.z = __shfl_xor(w.z, 32); pr.w = __shfl_xor(w.w, 32);
                float a[8], p[8], o[8]; unpack8(w, a); unpack8(pr, p); const float sg = hi == 0 ? -1.f : 1.f;
#pragma unroll
                for (int j = 0; j < 4; ++j) { o[j] = a[j] * c0[j] + sg * p[j] * s0[j]; o[4 + j] = a[4 + j] * c1[j] + sg * p[4 + j] * s1[j]; }
                qf[0] = __builtin_bit_cast(bf16x8, pack8(o)); }
            f32x16 S[5];
#pragma unroll
            for (int t = 0; t < 5; ++t) {
#pragma unroll
                for (int r = 0; r < 16; ++r) S[t][r] = 0.f;
                const LAS bf16_t* kp = Ks + ((c + t) * 32 + r32) * AT_KP + 8 * hi;
#pragma unroll
                for (int s = 0; s < 4; ++s) { const bf16x8 kf = *(const LAS bf16x8*)(kp + 16 * s); S[t] = __builtin_amdgcn_mfma_f32_32x32x16_bf16(kf, qf[s], S[t], 0, 0, 0); }
            }
#pragma unroll
            for (int r = 0; r < 16; ++r) { const int jj = crow16(r, hi); if (!(jj > r32)) S[0][r] = NEG; if (!(jj <= r32)) S[4][r] = NEG; }
#pragma unroll
            for (int t = 0; t < 5; ++t) { if (nblk == 0 && c + t < 4) {
#pragma unroll
                for (int r = 0; r < 16; ++r) S[t][r] = NEG; } }
            float mx = NEG;
#pragma unroll
            for (int t = 0; t < 5; ++t)
#pragma unroll
                for (int r = 0; r < 16; ++r) mx = fmaxf(mx, S[t][r]);
            mx = fmaxf(mx, __shfl_xor(mx, 32)); mx = fmaxf(mx, sinkv);
            float l = 0.f;
#pragma unroll
            for (int t = 0; t < 5; ++t)
#pragma unroll
                for (int r = 0; r < 16; ++r) { const float p = __builtin_amdgcn_exp2f(S[t][r] - mx); S[t][r] = p; l += p; }
            l += __shfl_xor(l, 32); l += __builtin_amdgcn_exp2f(sinkv - mx);
            f32x16 O[2];
#pragma unroll
            for (int r = 0; r < 16; ++r) { O[0][r] = 0.f; O[1][r] = 0.f; }
#pragma unroll
            for (int t = 0; t < 5; ++t)
#pragma unroll
                for (int s = 0; s < 2; ++s) {
                    v4u pw; pw.x = pk2(S[t][8 * s + 0], S[t][8 * s + 1]); pw.y = pk2(S[t][8 * s + 2], S[t][8 * s + 3]); pw.z = pk2(S[t][8 * s + 4], S[t][8 * s + 5]); pw.w = pk2(S[t][8 * s + 6], S[t][8 * s + 7]);
                    const bf16x8 xs = __builtin_bit_cast(bf16x8, pw);
#pragma unroll
                    for (int d0 = 0; d0 < 2; ++d0) { const LAS bf16_t* vp = Vt + (32 * d0 + r32) * AT_VP + (c + t) * 32 + 16 * s + 4 * hi;
                        const s16x4 lo = *(const LAS s16x4*)vp, hh = *(const LAS s16x4*)(vp + 8);
                        const bf16x8 vf = __builtin_shufflevector(lo, hh, 0, 1, 2, 3, 4, 5, 6, 7);
                        O[d0] = __builtin_amdgcn_mfma_f32_32x32x16_bf16(xs, vf, O[d0], 0, 0, 0); }
                }
            asm volatile("s_waitcnt lgkmcnt(0)" ::: "memory");
            if (hi == 0) wsf[r32] = 1.f / l;
            asm volatile("s_waitcnt lgkmcnt(0)" ::: "memory");
#pragma unroll
            for (int r = 0; r < 16; ++r) { const int qi = crow16(r, hi); const float inv = wsf[qi];
                stg[qi * 64 + r32] = (bf16_t)f2bf(O[0][r] * inv); stg[qi * 64 + 32 + r32] = (bf16_t)f2bf(O[1][r] * inv); }
            asm volatile("s_waitcnt lgkmcnt(0)" ::: "memory");
#pragma unroll
            for (int i = 0; i < 4; ++i) { const int row = i * 8 + (lane >> 3), ch = lane & 7; const v4u v = *(const LAS v4u*)(stg + row * 64 + ch * 8);
                *(v4u*)(BO + (size_t)(row0 + 32 * c + row) * DM + 64 * head + 8 * ch) = v; }
            asm volatile("s_waitcnt lgkmcnt(0)" ::: "memory");
        }
    }
    __syncthreads();
}

struct Args { const void* in[16]; float* out; unsigned char* ws; double invf[8]; int ph_lo, ph_hi, li, pad; };

__global__ void __launch_bounds__(NTHR, 2) mega_fwd(Args args) {
    extern __shared__ __attribute__((aligned(16))) unsigned char lds[];
    Frame F;
    F.lds = (LAS unsigned char*)lds;
    F.MISC = (volatile LAS unsigned*)(F.lds + MISC_OFF);
    F.tid = threadIdx.x; F.lane = F.tid & 63; F.wave = __builtin_amdgcn_readfirstlane(F.tid >> 6);
    F.G = gridDim.x; { const int bx = blockIdx.x; F.vcu = (F.G % 8 == 0) ? (bx % 8) * (F.G / 8) + bx / 8 : bx; }
    unsigned char* ws = args.ws;
    F.ctl = (gu32*)(ws + WS_CTL);
    const float* x = (const float*)args.in[0]; const int* positions = (const int*)args.in[1]; const float* attn_norm = (const float*)args.in[2];
    const float* w_in = (const float*)args.in[3]; const float* b_gate = (const float*)args.in[4]; const float* w_pool = (const float*)args.in[5];
    const float* pool_scale = (const float*)args.in[6]; const float* q_norm = (const float*)args.in[7]; const float* k_norm = (const float*)args.in[8];
    const float* sinks = (const float*)args.in[9]; const float* w_out = (const float*)args.in[10]; const float* ffn_norm = (const float*)args.in[11];
    const float* w_up = (const float*)args.in[12]; const float* conv_w = (const float*)args.in[13]; const float* conv_b = (const float*)args.in[14];
    const float* w_down = (const float*)args.in[15];
    float* out = args.out;
    float* R1 = (float*)(ws + WS_R1); float* SSQ = (float*)(ws + WS_SSQ); float* TAB = (float*)(ws + WS_TAB);
    bf16_t* Win_t = (bf16_t*)(ws + WS_WIN); bf16_t* Wp_t = (bf16_t*)(ws + WS_WP); bf16_t* Wo_t = (bf16_t*)(ws + WS_WO); bf16_t* Wu_t = (bf16_t*)(ws + WS_WU); bf16_t* Wd_t = (bf16_t*)(ws + WS_WD);
    bf16_t* XB = (bf16_t*)(ws + WS_XB); bf16_t* U = (bf16_t*)(ws + WS_Z); bf16_t* QB = (bf16_t*)(ws + WS_Z + 64 * MiB); bf16_t* KB = (bf16_t*)(ws + WS_Z + 128 * MiB); bf16_t* VB = (bf16_t*)(ws + WS_Z + 136 * MiB); bf16_t* GB = (bf16_t*)(ws + WS_Z + 144 * MiB); float* Y01 = (float*)(ws + WS_Y01); float* HALO = (float*)(ws + WS_HALO); bf16_t* HACT = (bf16_t*)(ws + WS_HACT);
    bf16_t* BO = (bf16_t*)(ws + WS_B); bf16_t* AP = (bf16_t*)(ws + WS_AP);

    for (int u = F.tid; u < (LDS_BYTES - LDSCTL_OFF) / 4; u += NTHR) ((LAS unsigned*)(F.lds + LDSCTL_OFF))[u] = 0u;
    __syncthreads();
    XcdBarrier bar; bar.bar = (unsigned*)(F.ctl + CW_BAR); bar.x = 0; bar.st = nullptr;
    if (MK_N_LAUNCHES == 1) bar = xcd_barrier_post((unsigned*)(F.ctl + CW_BAR), F.MISC + 8);
#define GRID_BAR() do { if (MK_N_LAUNCHES == 1) xcd_barrier(bar); } while (0)
    const int lo = args.ph_lo, hi = args.ph_hi;
#define IN(k) (lo <= (k) && (k) < hi)
#define BOTH(k) (IN(k) && IN((k) + 1))
    const int gt = F.vcu * NTHR + F.tid, GT = F.G * NTHR;
    const int gw = F.vcu * NWAVES + F.wave, NGW = F.G * NWAVES;

    if (IN(0)) {
        LAS float* scr = (LAS float*)(F.lds + F.wave * 16384);
        constexpr int I_IN = (DM / 64) * (NIN / 32), I_P = (256 / 64) * (256 / 32), I_O = (DM / 64) * (DM / 32), I_U = (DM / 64) * (NUP / 32), I_D = (DFF / 64) * (DM / 32);
        constexpr int NITEMS = I_IN + 4 * I_P + I_O + I_U + I_D;
        for (int it = gw; it < NITEMS; it += NGW) {
            int r = it;
            if (r < I_IN) { p0_transpose_item(w_in, DM, NIN, Win_t, attn_norm, nullptr, scr, r, F.lane); continue; } r -= I_IN;
            if (r < 4 * I_P) { const int g = r / I_P; p0_transpose_item(w_pool + (size_t)g * 65536, 256, 256, Wp_t + (size_t)g * 65536, nullptr, pool_scale + 256 * g, scr, r % I_P, F.lane); continue; } r -= 4 * I_P;
            if (r < I_O) { p0_transpose_item(w_out, DM, DM, Wo_t, nullptr, nullptr, scr, r, F.lane); continue; } r -= I_O;
            if (r < I_U) { p0_transpose_item(w_up, DM, NUP, Wu_t, ffn_norm, nullptr, scr, r, F.lane); continue; } r -= I_U;
            p0_transpose_item(w_down, DFF, DM, Wd_t, nullptr, nullptr, scr, r, F.lane);
        }
        for (int m = gw; m < M; m += NGW) row_bf16_rs(F.lane, x + (size_t)m * DM, XB + (size_t)m * DM, R1 + m);
        for (int idx = gt; idx < M * 8; idx += GT) { const int m = idx >> 3, j = idx & 7;
            double rev = (double)positions[m] * args.invf[j]; rev -= floor(rev); const float fr = (float)rev;
            TAB[(size_t)m * 16 + j] = __builtin_amdgcn_cosf(fr); TAB[(size_t)m * 16 + 8 + j] = __builtin_amdgcn_sinf(fr); }
        if (BOTH(0)) GRID_BAR();
    }
    if (IN(1)) {
        pg8::Gemm g{DM, DM, DM, (size_t)128 * DM * 2, (size_t)32 * DM * 2};
        pg8::TileOrder S; S.init(M / 256, NIN / 256, F.G, (int)blockIdx.x, XB, Win_t, (size_t)256 * DM * 2, (size_t)256 * DM * 2, 0);
        pg8::EpiIn E{R1, q_norm, k_norm, b_gate, U, QB, KB, VB, GB};
        pg8::gemm_phase<pg8::EpiIn, pg8::TileOrder, true>(F.lds, g, S, E);
        if (BOTH(1)) GRID_BAR();
    }
    if (IN(2)) {
        bf16_t* P = XB;
        for (int idx = gt; idx < M * 128; idx += GT) { const int m = idx >> 7, ch = idx & 127, g = ch >> 5, w = 2 << g, t = m & (SEQ - 1), cnt = (t + 1 < w) ? t + 1 : w;
            float a[8], u0[8];
#pragma unroll
            for (int j = 0; j < 8; ++j) a[j] = 0.f;
            for (int k = 0; k < cnt; ++k) { float f[8]; unpack8(*(const v4u*)(U + (size_t)(m - k) * DM + 8 * ch), f);
#pragma unroll
                for (int j = 0; j < 8; ++j) { a[j] += f[j]; if (k == 0) u0[j] = f[j]; } }
            const float ic = 1.f / (float)cnt;
#pragma unroll
            for (int j = 0; j < 8; ++j) a[j] = a[j] * ic - u0[j];
            *(v4u*)(P + (size_t)m * DM + 8 * ch) = pack8(a); }
        if (BOTH(2)) GRID_BAR();
    }
    if (IN(3)) {
        attn_phase(F, QB, DM, KB, 128, VB, 128, TAB, sinks, BO);
        if (BOTH(3)) GRID_BAR();
    }
    if (IN(4)) {
        pg8::Gemm g{DM, 256, 256, (size_t)128 * DM * 2, (size_t)128 * 256 * 2};
        pg8::TileOrder S; S.init(M / 256, 4, F.G, (int)blockIdx.x, XB, Wp_t, (size_t)256 * DM * 2, (size_t)256 * 256 * 2, (size_t)256 * 2);
        pg8::EpiMix E{GB, BO, AP};
        pg8::gemm_phase<pg8::EpiMix, pg8::TileOrder, true>(F.lds, g, S, E);
        if (BOTH(4)) GRID_BAR();
    }
    if (IN(6)) {
        pg8::Gemm g{DM, DM, DM, (size_t)128 * DM * 2, (size_t)128 * DM * 2};
        pg8::TileOrder S; S.init(M / 256, DM / 256, F.G, (int)blockIdx.x, AP, Wo_t, (size_t)256 * DM * 2, (size_t)256 * DM * 2, 0);
        pg8::EpiOut1 E{x, out, XB, SSQ};
        pg8::gemm_phase<pg8::EpiOut1, pg8::TileOrder, true>(F.lds, g, S, E);
        if (BOTH(6)) GRID_BAR();
    }
    if (IN(8)) {
        pg8::Gemm g{DM, DM, DM, (size_t)4 * DM * 2, (size_t)DFF * DM * 2};
        pg8::TileOrder S; S.init(M / 256, DFF / 128, F.G, (int)blockIdx.x, XB, Wu_t, (size_t)256 * DM * 2, (size_t)128 * DM * 2, 0);
        pg8::EpiConv E{SSQ, conv_w, conv_b, HACT, Y01, HALO};
        pg8::gemm_phase<pg8::EpiConv, pg8::TileOrder, true>(F.lds, g, S, E);
        if (BOTH(8)) GRID_BAR();
    }
    if (IN(9)) {
        for (int idx = gt; idx < 256 * (DFF / 8); idx += GT) { const int q = idx / (DFF / 8), c8 = idx - q * (DFF / 8);
            if ((q & 31) == 0) continue;
            float y0[16], y1[16];
#pragma unroll
            for (int h = 0; h < 2; ++h)
#pragma unroll
                for (int v = 0; v < 2; ++v) { const int c = h * DFF + 8 * c8 + 4 * v;
                    const f32x4 a0 = *(const f32x4*)(Y01 + (size_t)(q * 2 + 0) * NUP + c), a1 = *(const f32x4*)(Y01 + (size_t)(q * 2 + 1) * NUP + c);
                    const f32x4 h6 = *(const f32x4*)(HALO + (size_t)((q - 1) * 2 + 0) * NUP + c), h7 = *(const f32x4*)(HALO + (size_t)((q - 1) * 2 + 1) * NUP + c);
                    const f32x4 w0 = *(const f32x4*)(conv_w + c), w1 = *(const f32x4*)(conv_w + NUP + c);
                    const f32x4 r0 = a0 + w1 * h7 + w0 * h6, r1 = a1 + w0 * h7;
#pragma unroll
                    for (int j = 0; j < 4; ++j) { y0[8 * h + 4 * v + j] = r0[j]; y1[8 * h + 4 * v + j] = r1[j]; } }
            float o0[8], o1[8];
#pragma unroll
            for (int j = 0; j < 8; ++j) { o0[j] = y0[j] * sigmoidf_(y0[j]) * y0[8 + j]; o1[j] = y1[j] * sigmoidf_(y1[j]) * y1[8 + j]; }
            *(v4u*)(HACT + (size_t)(q * 128 + 0) * DFF + 8 * c8) = pack8(o0); *(v4u*)(HACT + (size_t)(q * 128 + 1) * DFF + 8 * c8) = pack8(o1); }
        if (BOTH(9)) GRID_BAR();
    }
    if (IN(12)) {
        pg8::Gemm g{DFF, DFF, DFF, (size_t)128 * DFF * 2, (size_t)128 * DFF * 2};
        pg8::TileOrder S; S.init(M / 256, DM / 256, F.G, (int)blockIdx.x, HACT, Wd_t, (size_t)256 * DFF * 2, (size_t)256 * DFF * 2, 0);
        pg8::EpiRes E{out, out, DM};
        pg8::gemm_phase<pg8::EpiRes, pg8::TileOrder, true>(F.lds, g, S, E);
    }
#undef IN
#undef BOTH
}

extern "C" void kernel_launch(void* const* d_in, const int* in_sizes, int n_in, void* d_out, int out_size, void* d_ws, size_t ws_size, hipStream_t stream) {
    static int grid = 0;
    if (grid == 0) {
        if (n_in != 16 || in_sizes[0] != M * DM || out_size != M * DM || ws_size < WS_END) { fprintf(stderr, "kernel_launch: unexpected shapes (n_in %d, in0 %d, out %d, ws %zu); nothing launched\n", n_in, n_in > 0 ? in_sizes[0] : -1, out_size, ws_size); grid = -1; return; }
        int dev = 0, cus = 0, per_cu = 0;
        if (hipGetDevice(&dev) != hipSuccess || hipDeviceGetAttribute(&cus, hipDeviceAttributeMultiprocessorCount, dev) != hipSuccess) { grid = -1; return; }
        if (hipFuncSetAttribute((const void*)mega_fwd, hipFuncAttributeMaxDynamicSharedMemorySize, LDS_BYTES) != hipSuccess) { fprintf(stderr, "kernel_launch: hipFuncSetAttribute failed\n"); grid = -1; return; }
        if (hipOccupancyMaxActiveBlocksPerMultiprocessor(&per_cu, (const void*)mega_fwd, NTHR, LDS_BYTES) != hipSuccess || per_cu < 1) { fprintf(stderr, "kernel_launch: occupancy query reports %d blocks per CU\n", per_cu); (void)hipGetLastError(); grid = -1; return; }
        grid = cus;
    }
    if (grid < 0) return;
    if (hipMemsetAsync((char*)d_ws + WS_CTL, 0, CTL_ZERO_BYTES, stream) != hipSuccess) return;
    Args a{};
    for (int i = 0; i < 16; ++i) a.in[i] = d_in[i];
    a.out = (float*)d_out; a.ws = (unsigned char*)d_ws;
    for (int j = 0; j < 8; ++j) a.invf[j] = std::pow(500000.0, -(double)j / 8.0) / 6.283185307179586476925;
    if (MK_N_LAUNCHES == 1) { a.ph_lo = 0; a.ph_hi = N_PHASES; a.li = 0; hipLaunchKernelGGL(mega_fwd, dim3(grid), dim3(NTHR), LDS_BYTES, stream, a); }
    else for (int p = 0; p < N_PHASES; ++p) { a.ph_lo = p; a.ph_hi = p + 1; a.li = p; hipLaunchKernelGGL(mega_fwd, dim3(grid), dim3(NTHR), LDS_BYTES, stream, a); }
}
```

```cpp
#include <hip/hip_runtime.h>
#include <cstdio>
#include <cstdint>
#include <cmath>

#ifndef MK_N_LAUNCHES
#define MK_N_LAUNCHES 1
#endif

constexpr int DM = 1024, NBATCH = 8, SEQ = 4096, M = NBATCH * SEQ;
constexpr int NIN = 4352, DFF = 2816, NUP = 2 * DFF;
constexpr int ZQ = 1024, ZK = 2048, ZV = 2176, ZG = 2304;
constexpr float EPS = 1e-6f, LOG2E = 1.4426950408889634f;

#define GAS __attribute__((address_space(1)))
#define LAS __attribute__((address_space(3)))
typedef unsigned short bf16_t;
typedef unsigned v4u __attribute__((ext_vector_type(4)));
typedef float f32x4 __attribute__((ext_vector_type(4)));
typedef short bf16x8 __attribute__((ext_vector_type(8)));
typedef GAS unsigned gu32;
#define RLX_AGENT __ATOMIC_RELAXED, __HIP_MEMORY_SCOPE_AGENT
#define LDS_WAIT() asm volatile("s_waitcnt lgkmcnt(0)" ::: "memory")
#define VM_WAIT() asm volatile("s_waitcnt vmcnt(0)" ::: "memory")

__device__ __forceinline__ unsigned f2bf(float f) { unsigned u = __builtin_bit_cast(unsigned, f); return (u + 0x7fffu + ((u >> 16) & 1u)) >> 16; }
typedef float f32x2_t __attribute__((ext_vector_type(2))); typedef __bf16 bf16x2_t __attribute__((ext_vector_type(2)));
__device__ __forceinline__ unsigned pk2(float lo, float hi) { f32x2_t v = {lo, hi}; bf16x2_t b = __builtin_convertvector(v, bf16x2_t); return __builtin_bit_cast(unsigned, b); }
__device__ __forceinline__ float bflo(unsigned w) { return __uint_as_float(w << 16); }
__device__ __forceinline__ float bfhi(unsigned w) { return __uint_as_float(w & 0xffff0000u); }
__device__ __forceinline__ void unpack8(const v4u w, float (&f)[8]) { f[0] = bflo(w.x); f[1] = bfhi(w.x); f[2] = bflo(w.y); f[3] = bfhi(w.y); f[4] = bflo(w.z); f[5] = bfhi(w.z); f[6] = bflo(w.w); f[7] = bfhi(w.w); }
__device__ __forceinline__ v4u pack8(const float (&f)[8]) { v4u w; w.x = pk2(f[0], f[1]); w.y = pk2(f[2], f[3]); w.z = pk2(f[4], f[5]); w.w = pk2(f[6], f[7]); return w; }
__device__ __forceinline__ float sigmoidf_(float x) { return __builtin_amdgcn_rcpf(1.f + __builtin_amdgcn_exp2f(-x * LOG2E)); }

namespace pg8 {
constexpr int BM = 256, BK = 64, HALF = 128, HTB = HALF * BK * 2, STAGE_BYTES = 8 * HTB, NXCD = 8, WGM = 8;
__host__ __device__ __forceinline__ int lds_byte(int r, int c) { const int st = (r >> 4) * 2 + (c >> 5), rr = r & 15, cc = c & 31, ob = rr * 64 + cc * 2; return st * 1024 + (ob ^ (((ob >> 9) & 1) << 5)); }
__host__ __device__ __forceinline__ void stage_rc(int b, int& R, int& C) { const int st = b / 1024, sb = b % 1024, swz = sb ^ (((sb >> 9) & 1) << 5); R = (st >> 1) * 16 + swz / 64; C = (st & 1) * 32 + (swz % 64) / 2; }
__host__ __device__ __forceinline__ int perm32(int rho) { const int n = rho >> 4, i = rho & 15; return 8 * (i >> 2) + 4 * n + (i & 3); }

struct Unit { const char* a; const char* b; int pm, pn; };
struct Gemm { int lda, ldb, K; size_t hstepA, hstepB; };

struct TileOrder {
    int nM, nN, nwg, G, c; const char* A; const char* B; size_t sA, sB, sApn;
    __device__ void init(int nM_, int nN_, int G_, int c_, const void* A_, const void* B_, size_t sA_, size_t sB_, size_t sApn_) { nM = nM_; nN = nN_; nwg = nM * nN; G = G_; c = c_; A = (const char*)A_; B = (const char*)B_; sA = sA_; sB = sB_; sApn = sApn_; }
    __device__ bool next(int i, Unit& u) const {
        const long L = (long)i * G + c; if (L >= nwg) return false;
        int wgid = (int)L; { const int q = nwg / NXCD, r = nwg % NXCD, xcd = wgid % NXCD, off = wgid / NXCD; wgid = (xcd < r ? xcd * (q + 1) : r * (q + 1) + (xcd - r) * q) + off; }
        const int nig = WGM * nN, gid = wgid / nig, fm = gid * WGM, gsz = (nM - fm) < WGM ? (nM - fm) : WGM;
        u.pm = fm + ((wgid % nig) % gsz); u.pn = (wgid % nig) / gsz;
        u.a = A + (size_t)u.pm * sA + (size_t)u.pn * sApn; u.b = B + (size_t)u.pn * sB; return true;
    }
};

template <int BMODE> __device__ __forceinline__ int mapB(int R) { return BMODE == 1 ? ((R & ~31) + perm32(R & 31)) : (BMODE == 2 ? (64 * (R >> 5) + perm32(R & 31)) : R); }
template <int AMODE> __device__ __forceinline__ int mapA(int R) { return AMODE == 1 ? (128 * (R >> 6) + 8 * (R & 15) + ((R >> 4) & 3)) : R; }

template <class Epi, class Sched, bool ALIGN_EPI>
__device__ __forceinline__ void gemm_phase(LAS unsigned char* lds, const Gemm g, const Sched& S, const Epi& E) {
    const int tid = threadIdx.x, wid = __builtin_amdgcn_readfirstlane(tid >> 6), lane = tid & 63, wr = wid >> 2, wc = wid & 3, fr = lane & 15, fq = lane >> 4;
    const int nt = g.K / BK;
    unsigned voffA[2], voffB[2];
#pragma unroll
    for (int i = 0; i < 2; ++i) { int R, C; stage_rc(tid * 16 + i * 8192, R, C); const int Rb = mapB<Epi::BMODE>(R);
        voffA[i] = (unsigned)(mapA<Epi::AMODE>(R) * g.lda + C) * 2u; voffB[i] = (unsigned)(Rb * g.ldb + C) * 2u; }
    const size_t kstep = (size_t)(BK * 2);
    const size_t hstepA = g.hstepA, hstepB = g.hstepB;
    const unsigned ldsw = (unsigned)wid * 1024u;
    const int aoff = lds_byte(wr * 64 + fr, fq * 8), boff = lds_byte(wc * 32 + fr, fq * 8);
#define PG8_SA(b, h) (((b) * 2 + (h)) * HTB)
#define PG8_SB(b, h) ((4 + (b) * 2 + (h)) * HTB)
#define PG8_STAGE(bufoff, gbase, voff) do { _Pragma("unroll") for (int _i = 0; _i < 2; ++_i) \
        __builtin_amdgcn_global_load_lds((const unsigned*)((const char*)(gbase) + (voff)[_i]), (LAS unsigned*)(lds + (bufoff) + ldsw + _i * 8192), 16, 0, 0); } while (0)
#define PG8_LDA(dst, b, h) do { _Pragma("unroll") for (int m = 0; m < 4; ++m) _Pragma("unroll") for (int k = 0; k < 2; ++k) dst[m][k] = *(const LAS bf16x8*)(lds + PG8_SA(b, h) + aoff + m * 2048 + k * 1024); } while (0)
#define PG8_LDB(dst, b, h) do { _Pragma("unroll") for (int n = 0; n < 2; ++n) _Pragma("unroll") for (int k = 0; k < 2; ++k) dst[n][k] = *(const LAS bf16x8*)(lds + PG8_SB(b, h) + boff + n * 2048 + k * 1024); } while (0)
#define PG8_MMA(ai, bj, At, Bt) do { __builtin_amdgcn_s_setprio(1); _Pragma("unroll") for (int m = 0; m < 4; ++m) _Pragma("unroll") for (int n = 0; n < 2; ++n) _Pragma("unroll") for (int k = 0; k < 2; ++k) \
        acc[ai][bj][m][n] = __builtin_amdgcn_mfma_f32_16x16x32_bf16(Bt[n][k], At[m][k], acc[ai][bj][m][n], 0, 0, 0); __builtin_amdgcn_s_setprio(0); } while (0)
#define PG8_WAIT_V(n) asm volatile("s_waitcnt vmcnt(" #n ")" ::: "memory")
#define PG8_WAIT_L(n) asm volatile("s_waitcnt lgkmcnt(" #n ")" ::: "memory")
#define PG8_BAR __builtin_amdgcn_s_barrier()
#define PG8_SCHED __builtin_amdgcn_sched_barrier(0)
    Unit cur, nxt; int ui = 0;
    if (!S.next(0, cur)) return;
    f32x4 acc[2][2][4][2];
#pragma unroll
    for (int a = 0; a < 2; ++a)
#pragma unroll
        for (int b = 0; b < 2; ++b)
#pragma unroll
            for (int m = 0; m < 4; ++m)
#pragma unroll
                for (int n = 0; n < 2; ++n) acc[a][b][m][n] = (f32x4){0.f, 0.f, 0.f, 0.f};
    bf16x8 At[4][2], B0[2][2], B1[2][2];
    const char* cA = cur.a; const char* cB = cur.b;
    PG8_STAGE(PG8_SB(0, 0), cB, voffB); PG8_STAGE(PG8_SB(0, 1), cB + hstepB, voffB); PG8_STAGE(PG8_SA(0, 0), cA, voffA); PG8_STAGE(PG8_SA(0, 1), cA + hstepA, voffA);
    if (wr == 1) PG8_BAR;
    PG8_WAIT_V(2); PG8_BAR;
    PG8_STAGE(PG8_SB(1, 0), cB + kstep, voffB); PG8_STAGE(PG8_SA(1, 0), cA + kstep, voffA); PG8_STAGE(PG8_SB(1, 1), cB + hstepB + kstep, voffB);
    PG8_WAIT_V(6); PG8_BAR;
    for (;;) {
        const bool has_next = S.next(ui + 1, nxt);
        const char* nA = has_next ? nxt.a : cA; const char* nB = has_next ? nxt.b : cB;
        for (int t = 0; t < nt; t += 2) {
            const bool last = (t == nt - 2);
            const char* a1 = cA + (size_t)(t + 1) * kstep;
            const char* a2 = last ? nA : cA + (size_t)(t + 2) * kstep; const char* b2 = last ? nB : cB + (size_t)(t + 2) * kstep;
            const char* a3 = a2 + kstep; const char* b3 = b2 + kstep;
            PG8_LDB(B0, 0, 0); PG8_LDB(B1, 0, 1); PG8_SCHED; PG8_LDA(At, 0, 0); PG8_STAGE(PG8_SA(1, 1), a1 + hstepA, voffA);
            PG8_WAIT_V(8); PG8_WAIT_L(0); PG8_BAR; PG8_MMA(0, 0, At, B0); PG8_MMA(0, 1, At, B1); PG8_BAR; PG8_SCHED;
            PG8_LDA(At, 0, 1); PG8_STAGE(PG8_SB(0, 0), b2, voffB); PG8_STAGE(PG8_SB(0, 1), b2 + hstepB, voffB); PG8_STAGE(PG8_SA(0, 0), a2, voffA);
            PG8_WAIT_V(8); PG8_WAIT_L(0); PG8_BAR; PG8_MMA(1, 0, At, B0); PG8_MMA(1, 1, At, B1); PG8_BAR; PG8_SCHED;
            PG8_LDB(B0, 1, 0); PG8_LDB(B1, 1, 1); PG8_SCHED; PG8_LDA(At, 1, 0); PG8_STAGE(PG8_SA(0, 1), a2 + hstepA, voffA);
            PG8_WAIT_V(8); PG8_WAIT_L(0); PG8_BAR; PG8_MMA(0, 0, At, B0); PG8_MMA(0, 1, At, B1); PG8_BAR; PG8_SCHED;
            PG8_LDA(At, 1, 1); PG8_STAGE(PG8_SB(1, 0), b3, voffB); PG8_STAGE(PG8_SB(1, 1), b3 + hstepB, voffB); PG8_STAGE(PG8_SA(1, 0), a3, voffA);
            PG8_WAIT_V(8); PG8_WAIT_L(0); PG8_BAR; PG8_MMA(1, 0, At, B0); PG8_MMA(1, 1, At, B1); PG8_BAR; PG8_SCHED;
        }
        if constexpr (ALIGN_EPI) { if (wr == 0) PG8_BAR; }
        E(acc, cur, wr, wc, fr, fq);
        if (!has_next) break;
#pragma unroll
        for (int a = 0; a < 2; ++a)
#pragma unroll
            for (int b = 0; b < 2; ++b)
#pragma unroll
                for (int m = 0; m < 4; ++m)
#pragma unroll
                    for (int n = 0; n < 2; ++n) acc[a][b][m][n] = (f32x4){0.f, 0.f, 0.f, 0.f};
        cur = nxt; cA = nA; cB = nB; ++ui;
        if constexpr (ALIGN_EPI) { if (wr == 1) PG8_BAR; }
    }
    PG8_WAIT_V(0);
    if constexpr (!ALIGN_EPI) { if (wr == 0) PG8_BAR; }
    PG8_BAR;
#undef PG8_SA
#undef PG8_SB
#undef PG8_STAGE
#undef PG8_LDA
#undef PG8_LDB
#undef PG8_MMA
#undef PG8_WAIT_V
#undef PG8_WAIT_L
#undef PG8_BAR
#undef PG8_SCHED
}

struct EpiIn {
    static constexpr int BMODE = 2, AMODE = 0;
    const float* r1; const float* qn; const float* kn; const float* bg; bf16_t* U; bf16_t* Q; bf16_t* Kb; bf16_t* Vb; bf16_t* G;
    __device__ __forceinline__ void operator()(const f32x4 (&acc)[2][2][4][2], const Unit& u, int wr, int wc, int fr, int fq) const {
        const int row0 = u.pm * BM + wr * 64 + fr, hc = wc * 64 + 8 * fq, pn = u.pn;
        int mode, ld, coloff; bf16_t* base; const float* par = nullptr; float qs = 1.f;
        if (pn < 4) { mode = 0; base = U; ld = DM; coloff = pn * 256 + hc; }
        else if (pn < 8) { mode = 1; base = Q; ld = DM; coloff = (pn - 4) * 256 + hc; par = qn + 8 * fq; qs = 0.125f * LOG2E; }
        else if (pn == 8) { if (wc < 2) { mode = 1; base = Kb; ld = 128; coloff = hc; par = kn + 8 * fq; } else { mode = 0; base = Vb; ld = 128; coloff = hc - 128; } }
        else { mode = 2; base = G; ld = 2 * DM; coloff = (pn - 9) * 256 + hc; par = bg + coloff; }
        float rs[8];
#pragma unroll
        for (int e = 0; e < 8; ++e) rs[e] = r1[row0 + (e >> 2) * HALF + (e & 3) * 16];
        f32x4 pv[2][2];
#pragma unroll
        for (int bj = 0; bj < 2; ++bj)
#pragma unroll
            for (int n = 0; n < 2; ++n) pv[bj][n] = par ? *(const f32x4*)(par + 32 * bj + 4 * n) : (f32x4){0.f, 0.f, 0.f, 0.f};
        asm volatile("" : "+v"(rs[0]), "+v"(rs[1]), "+v"(rs[2]), "+v"(rs[3]), "+v"(rs[4]), "+v"(rs[5]), "+v"(rs[6]), "+v"(rs[7]));
        asm volatile("" : "+v"(pv[0][0]), "+v"(pv[0][1]), "+v"(pv[1][0]), "+v"(pv[1][1]));
#pragma unroll
        for (int e = 0; e < 8; ++e) { const int ai = e >> 2, m = e & 3; const int row = row0 + ai * HALF + m * 16;
            f32x4 v[2][2];
#pragma unroll
            for (int bj = 0; bj < 2; ++bj)
#pragma unroll
                for (int n = 0; n < 2; ++n) v[bj][n] = acc[ai][bj][m][n] * rs[e];
            if (mode == 1) { float ss = 0.f;
#pragma unroll
                for (int bj = 0; bj < 2; ++bj)
#pragma unroll
                    for (int n = 0; n < 2; ++n) ss += (v[bj][n][0] * v[bj][n][0] + v[bj][n][1] * v[bj][n][1]) + (v[bj][n][2] * v[bj][n][2] + v[bj][n][3] * v[bj][n][3]);
                ss += __shfl_xor(ss, 16); ss += __shfl_xor(ss, 32);
                const float rr = qs / sqrtf(ss * (1.f / 64.f) + EPS);
#pragma unroll
                for (int bj = 0; bj < 2; ++bj)
#pragma unroll
                    for (int n = 0; n < 2; ++n) v[bj][n] = v[bj][n] * rr * pv[bj][n]; }
            else if (mode == 2) {
#pragma unroll
                for (int bj = 0; bj < 2; ++bj)
#pragma unroll
                    for (int n = 0; n < 2; ++n)
#pragma unroll
                        for (int j = 0; j < 4; ++j) v[bj][n][j] = sigmoidf_(v[bj][n][j] + pv[bj][n][j]); }
            bf16_t* rowp = base + (size_t)row * ld + coloff;
#pragma unroll
            for (int bj = 0; bj < 2; ++bj) { v4u w; w.x = pk2(v[bj][0][0], v[bj][0][1]); w.y = pk2(v[bj][0][2], v[bj][0][3]); w.z = pk2(v[bj][1][0], v[bj][1][1]); w.w = pk2(v[bj][1][2], v[bj][1][3]);
                *(v4u*)(rowp + 32 * bj) = w; } }
    }
};
struct EpiRes {
    static constexpr int BMODE = 0, AMODE = 0;
    const float* base; float* out; int ldc;
    __device__ __forceinline__ void operator()(const f32x4 (&acc)[2][2][4][2], const Unit& u, int wr, int wc, int fr, int fq) const {
        const int row0 = u.pm * BM + wr * 64 + fr, col0 = u.pn * BM + wc * 32 + 4 * fq;
#pragma unroll
        for (int ai = 0; ai < 2; ++ai) { f32x4 b[4][2][2];
#pragma unroll
            for (int m = 0; m < 4; ++m)
#pragma unroll
                for (int bj = 0; bj < 2; ++bj)
#pragma unroll
                    for (int n = 0; n < 2; ++n) b[m][bj][n] = *(const f32x4*)(base + (size_t)(row0 + ai * HALF + m * 16) * ldc + col0 + bj * HALF + n * 16);
#pragma unroll
            for (int m = 0; m < 4; ++m) asm volatile("" : "+v"(b[m][0][0]), "+v"(b[m][0][1]), "+v"(b[m][1][0]), "+v"(b[m][1][1]));
#pragma unroll
            for (int m = 0; m < 4; ++m)
#pragma unroll
                for (int bj = 0; bj < 2; ++bj)
#pragma unroll
                    for (int n = 0; n < 2; ++n) *(f32x4*)(out + (size_t)(row0 + ai * HALF + m * 16) * ldc + col0 + bj * HALF + n * 16) = b[m][bj][n] + acc[ai][bj][m][n];
            asm volatile("" ::: "memory"); }
    }
};
struct EpiMix {
    static constexpr int BMODE = 1, AMODE = 0;
    const bf16_t* G; const bf16_t* BO; bf16_t* MIX;
    __device__ __forceinline__ void operator()(const f32x4 (&acc)[2][2][4][2], const Unit& u, int wr, int wc, int fr, int fq) const {
        const int row0 = u.pm * BM + wr * 64 + fr, col0 = u.pn * BM + wc * 32 + 8 * fq;
#pragma unroll
        for (int ai = 0; ai < 2; ++ai)
#pragma unroll
            for (int mh = 0; mh < 2; ++mh) { v4u gp[2][2], ga[2][2], bo[2][2];
#pragma unroll
                for (int mm = 0; mm < 2; ++mm)
#pragma unroll
                    for (int bj = 0; bj < 2; ++bj) { const size_t row = (size_t)(row0 + ai * HALF + (2 * mh + mm) * 16); const int c = col0 + bj * HALF;
                        gp[mm][bj] = *(const v4u*)(G + row * (2 * DM) + c); ga[mm][bj] = *(const v4u*)(G + row * (2 * DM) + DM + c); bo[mm][bj] = *(const v4u*)(BO + row * DM + c); }
                asm volatile("" : "+v"(gp[0][0]), "+v"(gp[0][1]), "+v"(gp[1][0]), "+v"(gp[1][1]), "+v"(ga[0][0]), "+v"(ga[0][1]), "+v"(ga[1][0]), "+v"(ga[1][1]));
                asm volatile("" : "+v"(bo[0][0]), "+v"(bo[0][1]), "+v"(bo[1][0]), "+v"(bo[1][1]));
#pragma unroll
                for (int mm = 0; mm < 2; ++mm)
#pragma unroll
                    for (int bj = 0; bj < 2; ++bj) { const int m = 2 * mh + mm; const size_t row = (size_t)(row0 + ai * HALF + m * 16); const int c = col0 + bj * HALF;
                        float p[8], a[8], b[8], o[8]; unpack8(gp[mm][bj], p); unpack8(ga[mm][bj], a); unpack8(bo[mm][bj], b);
                        const f32x4 a0 = acc[ai][bj][m][0], a1 = acc[ai][bj][m][1];
#pragma unroll
                        for (int j = 0; j < 4; ++j) { o[j] = p[j] * a0[j] + a[j] * b[j]; o[4 + j] = p[4 + j] * a1[j] + a[4 + j] * b[4 + j]; }
                        *(v4u*)(MIX + row * DM + c) = pack8(o); }
                asm volatile("" ::: "memory"); }
    }
};
struct EpiOut1 {
    static constexpr int BMODE = 1, AMODE = 0;
    const float* x; float* out; bf16_t* X1B; float* SSQ;
    __device__ __forceinline__ void operator()(const f32x4 (&acc)[2][2][4][2], const Unit& u, int wr, int wc, int fr, int fq) const {
        const int row0 = u.pm * BM + wr * 64 + fr, col0 = u.pn * BM + wc * 32 + 8 * fq;
#pragma unroll
        for (int ai = 0; ai < 2; ++ai) { f32x4 xv[4][2][2];
#pragma unroll
            for (int m = 0; m < 4; ++m)
#pragma unroll
                for (int bj = 0; bj < 2; ++bj) { const size_t off = (size_t)(row0 + ai * HALF + m * 16) * DM + col0 + bj * HALF; xv[m][bj][0] = *(const f32x4*)(x + off); xv[m][bj][1] = *(const f32x4*)(x + off + 4); }
#pragma unroll
            for (int m = 0; m < 4; ++m) asm volatile("" : "+v"(xv[m][0][0]), "+v"(xv[m][0][1]), "+v"(xv[m][1][0]), "+v"(xv[m][1][1]));
#pragma unroll
            for (int m = 0; m < 4; ++m) { const size_t row = (size_t)(row0 + ai * HALF + m * 16); float ss = 0.f;
#pragma unroll
                for (int bj = 0; bj < 2; ++bj) { const size_t off = row * DM + col0 + bj * HALF;
                    const f32x4 v0 = xv[m][bj][0] + acc[ai][bj][m][0], v1 = xv[m][bj][1] + acc[ai][bj][m][1];
                    *(f32x4*)(out + off) = v0; *(f32x4*)(out + off + 4) = v1;
                    ss += (v0[0] * v0[0] + v0[1] * v0[1]) + (v0[2] * v0[2] + v0[3] * v0[3]) + (v1[0] * v1[0] + v1[1] * v1[1]) + (v1[2] * v1[2] + v1[3] * v1[3]);
                    v4u w; w.x = pk2(v0[0], v0[1]); w.y = pk2(v0[2], v0[3]); w.z = pk2(v1[0], v1[1]); w.w = pk2(v1[2], v1[3]);
                    *(v4u*)(X1B + off) = w; }
                ss += __shfl_xor(ss, 16); ss += __shfl_xor(ss, 32);
                if (fq == 0) SSQ[row * 16 + u.pn * 4 + wc] = ss; }
            asm volatile("" ::: "memory"); }
    }
};
__device__ __forceinline__ float dpp_shr1(float v) { return __int_as_float(__builtin_amdgcn_update_dpp(0, __float_as_int(v), 0x111, 0xf, 0xf, true)); }
__device__ __forceinline__ f32x4 dpp_shr1(f32x4 v) { f32x4 r; r[0] = dpp_shr1(v[0]); r[1] = dpp_shr1(v[1]); r[2] = dpp_shr1(v[2]); r[3] = dpp_shr1(v[3]); return r; }
struct EpiConv {
    static constexpr int BMODE = 1, AMODE = 1;
    const float* ssq; const float* cw; const float* cb; bf16_t* HACT; float* Y01; float* HALO;
    __device__ __forceinline__ void operator()(f32x4 (&acc)[2][2][4][2], const Unit& u, int wr, int wc, int fr, int fq) const {
#define AE(e, bj, n) acc[(e) >> 2][bj][(e) & 3][n]
        const int trow0 = u.pm * BM + 128 * wr + 8 * fr, q = u.pm * 2 + wr, colg = u.pn * 128 + wc * 32 + 8 * fq;
        f32x4 sp[8], cwv[4][4];
#pragma unroll
        for (int e = 0; e < 8; ++e) sp[e] = *(const f32x4*)(ssq + (size_t)(trow0 + e) * 16 + 4 * fq);
#define LDCW(it) do { const int c = ((it) >> 1) * DFF + colg + 4 * ((it) & 1); cwv[it][0] = *(const f32x4*)(cw + c); cwv[it][1] = *(const f32x4*)(cw + NUP + c); cwv[it][2] = *(const f32x4*)(cw + 2 * NUP + c); cwv[it][3] = *(const f32x4*)(cb + c); } while (0)
        LDCW(0);
        asm volatile("" : "+v"(sp[0]), "+v"(sp[1]), "+v"(sp[2]), "+v"(sp[3]), "+v"(sp[4]), "+v"(sp[5]), "+v"(sp[6]), "+v"(sp[7]));
#pragma unroll
        for (int e = 0; e < 8; ++e) { float t = (sp[e].x + sp[e].y) + (sp[e].z + sp[e].w); t += __shfl_xor(t, 16); t += __shfl_xor(t, 32);
            const float r2 = 1.f / sqrtf(t * (1.f / 1024.f) + EPS);
#pragma unroll
            for (int bj = 0; bj < 2; ++bj) { AE(e, bj, 0) *= r2; AE(e, bj, 1) *= r2; }
            asm volatile("" : "+v"(AE(e, 0, 0)), "+v"(AE(e, 0, 1)), "+v"(AE(e, 1, 0)), "+v"(AE(e, 1, 1))); }
        if (fr == 15) {
#pragma unroll
            for (int e = 6; e < 8; ++e)
#pragma unroll
                for (int bj = 0; bj < 2; ++bj) { float* hp = HALO + ((size_t)(q * 2 + (e - 6)) * NUP + bj * DFF + colg); *(f32x4*)hp = AE(e, bj, 0); *(f32x4*)(hp + 4) = AE(e, bj, 1); } }
#pragma unroll
        for (int it = 0; it < 4; ++it) { const int bj = it >> 1, n = it & 1;
            asm volatile("" ::: "memory");
            if (it < 3) LDCW(it + 1);
            asm volatile("" : "+v"(cwv[it][0]), "+v"(cwv[it][1]), "+v"(cwv[it][2]), "+v"(cwv[it][3]));
            const f32x4 w0 = cwv[it][0], w1 = cwv[it][1], w2 = cwv[it][2], bb = cwv[it][3];
            const f32x4 p6 = dpp_shr1(AE(6, bj, n)), p7 = dpp_shr1(AE(7, bj, n));
#pragma unroll
            for (int e = 7; e >= 2; --e) AE(e, bj, n) = w2 * AE(e, bj, n) + (w1 * AE(e - 1, bj, n) + (w0 * AE(e - 2, bj, n) + bb));
            AE(1, bj, n) = w2 * AE(1, bj, n) + (w1 * AE(0, bj, n) + (w0 * p7 + bb));
            AE(0, bj, n) = w2 * AE(0, bj, n) + (w1 * p7 + (w0 * p6 + bb));
            asm volatile("" : "+v"(AE(0, bj, n)), "+v"(AE(1, bj, n)), "+v"(AE(2, bj, n)), "+v"(AE(3, bj, n)), "+v"(AE(4, bj, n)), "+v"(AE(5, bj, n)), "+v"(AE(6, bj, n)), "+v"(AE(7, bj, n))); }
#undef LDCW
        if (fr == 0) {
#pragma unroll
            for (int e = 0; e < 2; ++e)
#pragma unroll
                for (int bj = 0; bj < 2; ++bj) { float* yp = Y01 + ((size_t)(q * 2 + e) * NUP + bj * DFF + colg); *(f32x4*)yp = AE(e, bj, 0); *(f32x4*)(yp + 4) = AE(e, bj, 1); } }
#pragma unroll
        for (int e = 0; e < 8; ++e) { const f32x4 g0 = AE(e, 0, 0), g1 = AE(e, 0, 1), v0 = AE(e, 1, 0), v1 = AE(e, 1, 1); float o[8];
#pragma unroll
            for (int j = 0; j < 4; ++j) { o[j] = g0[j] * sigmoidf_(g0[j]) * v0[j]; o[4 + j] = g1[j] * sigmoidf_(g1[j]) * v1[j]; }
            *(v4u*)(HACT + (size_t)(trow0 + e) * DFF + colg) = pack8(o); asm volatile("" ::: "memory"); }
#undef AE
    }
};
}

constexpr int NWAVES = 8, NTHR = NWAVES * 64;
constexpr int N_PHASES = 13;
constexpr size_t MiB = 1u << 20;
constexpr size_t WS_CTL = 0, CTL_ZERO_BYTES = 1 * MiB;
constexpr size_t WS_R1 = 1 * MiB;
constexpr size_t WS_SSQ = 498 * MiB;
constexpr size_t WS_TAB = 2 * MiB;
constexpr size_t WS_WIN = 4 * MiB, WS_WP = 13 * MiB, WS_WO = 14 * MiB, WS_WU = 16 * MiB, WS_WD = 28 * MiB;
constexpr size_t WS_XB = 34 * MiB;
constexpr size_t WS_Z = 98 * MiB;
constexpr size_t WS_Y01 = WS_Z, WS_HALO = WS_Z + 16 * MiB, WS_HACT = WS_Z + 176 * MiB;
constexpr size_t WS_B = 370 * MiB;
constexpr size_t WS_AP = 434 * MiB;
constexpr size_t WS_END = 500 * MiB;
static_assert(WS_WIN + (size_t)NIN * DM * 2 <= WS_WP && WS_WU + (size_t)NUP * DM * 2 <= WS_WD && WS_WD + (size_t)DM * DFF * 2 <= WS_XB, "weights map");
static_assert(WS_Z + (size_t)M * NIN * 2 <= WS_B && WS_HACT + (size_t)M * DFF * 2 <= WS_SSQ && WS_AP + (size_t)M * DM * 2 <= WS_SSQ, "activation map");
constexpr int CW_BAR = 4096;
constexpr int RING_BYTES = 131072, LDSCTL_OFF = RING_BYTES, MISC_OFF = LDSCTL_OFF + 320, LDS_BYTES = 147456;

#define XB_TMO      128
#define XB_XCNT(j)  (256  + 64 * (j))
#define XB_XSUB(j)  (1280 + 64 * (j))
#define XB_XGEN(j)  (2304 + 64 * (j))
#define XB_TOP      3328
#define XB_TOPGEN   3392
#define XCD_BAR_WORDS 3456
#define XB_SPIN_CAP (1u << 18)
__device__ __forceinline__ unsigned xb_ld(unsigned* p)              { return __hip_atomic_load(p, __ATOMIC_RELAXED, __HIP_MEMORY_SCOPE_AGENT); }
__device__ __forceinline__ unsigned xb_add(unsigned* p, unsigned v) { return __hip_atomic_fetch_add(p, v, __ATOMIC_RELAXED, __HIP_MEMORY_SCOPE_AGENT); }
__device__ __forceinline__ unsigned xb_xcc_id() { return (unsigned)__builtin_amdgcn_s_getreg((3 << 11) | 20) & 0xFu; }
#define XB_SPIN(cond, bar) do { unsigned _sp = 0; while (cond) { __builtin_amdgcn_s_sleep(1); \
    if ((++_sp & 255u) == 0u) { if (xb_ld(&(bar)[XB_TMO])) break; if (_sp > XB_SPIN_CAP) { atomicAdd(&(bar)[XB_TMO], 1u); break; } } } } while (0)
struct XcdBarrier { unsigned* bar; unsigned x; volatile LAS unsigned* st; };
__device__ __forceinline__ XcdBarrier xcd_barrier_post(unsigned* bar, volatile LAS unsigned* st) {
    XcdBarrier b; b.bar = bar; b.x = xb_xcc_id(); b.st = st;
    if (threadIdx.x == 0) (void)xb_add(&bar[XB_XCNT(b.x)], 1u);
    return b;
}
__device__ __forceinline__ void xcd_barrier_complete(unsigned* bar, unsigned x, unsigned& nloc, unsigned& nx) {
    const unsigned G = gridDim.x * gridDim.y * gridDim.z;
    unsigned sum, cnt, mine, sp = 0u;
    for (;;) {
        sum = 0u; cnt = 0u; mine = 0u;
#pragma unroll
        for (unsigned j = 0; j < 16; ++j) { const unsigned c = xb_ld(&bar[XB_XCNT(j)]); sum += c; cnt += (c > 0u) ? 1u : 0u; mine = (j == x) ? c : mine; }
        if (sum == G) break;
        __builtin_amdgcn_s_sleep(1);
        if ((++sp & 255u) == 0u) { if (xb_ld(&bar[XB_TMO])) break; if (sp > XB_SPIN_CAP) { atomicAdd(&bar[XB_TMO], 1u); break; } }
    }
    nloc = mine > 0u ? mine : 1u; nx = cnt > 0u ? cnt : 1u;
}
__device__ __forceinline__ void xcd_barrier(const XcdBarrier& b) {
    asm volatile("s_waitcnt vmcnt(0)" ::: "memory");
    __syncthreads();
    if (threadIdx.x == 0) {
        unsigned* bar = b.bar;
        __builtin_amdgcn_s_waitcnt(0);
        unsigned nloc = b.st[0], nx = b.st[1];
        if (nloc == 0u) { xcd_barrier_complete(bar, b.x, nloc, nx); b.st[0] = nloc; b.st[1] = nx; }
        const unsigned old = xb_add(&bar[XB_XSUB(b.x)], 1u);
        const unsigned gen = old / nloc;
        if (old + 1u == (gen + 1u) * nloc) {
            __builtin_amdgcn_fence(__ATOMIC_RELEASE, "agent");
            asm volatile("s_waitcnt vmcnt(0)" ::: "memory");
            const unsigned og = xb_add(&bar[XB_TOP], 1u);
            const unsigned tg = og / nx;
            if (og + 1u == (tg + 1u) * nx) xb_add(&bar[XB_TOPGEN], 1u);
            else XB_SPIN(xb_ld(&bar[XB_TOPGEN]) == tg, bar);
            __builtin_amdgcn_fence(__ATOMIC_ACQUIRE, "agent");
            xb_add(&bar[XB_XGEN(b.x)], 1u);
            asm volatile("s_waitcnt vmcnt(0)" ::: "memory");
        } else {
            XB_SPIN(xb_ld(&bar[XB_XGEN(b.x)]) == gen, bar);
            __builtin_amdgcn_fence(__ATOMIC_ACQUIRE, "agent");
            asm volatile("s_waitcnt vmcnt(0)" ::: "memory");
        }
    }
    __syncthreads();
}

struct Frame {
    LAS unsigned char* lds; volatile LAS unsigned* MISC; gu32* ctl;
    int tid, lane, wave, vcu, G;
};
__device__ __forceinline__ float wave_sum(float v) {
#pragma unroll
    for (int o = 1; o < 64; o <<= 1) v += __shfl_xor(v, o);
    return v;
}

__device__ __forceinline__ void p0_transpose_item(const float* W, int K, int N, bf16_t* WT, const float* kscale, const float* nscale, LAS float* scr, int item, int lane) {
    const int nblk = N / 32, kb = item / nblk, nb = item % nblk, k0 = 64 * kb, n0 = 32 * nb;
    const float ns = nscale ? nscale[n0 + (lane & 31)] : 1.f;
    float wv[32];
#pragma unroll
    for (int i = 0; i < 32; ++i) wv[i] = W[(size_t)(k0 + 2 * i + (lane >> 5)) * N + n0 + (lane & 31)];
#pragma unroll
    for (int i = 0; i < 32; i += 8) asm volatile("" : "+v"(wv[i]), "+v"(wv[i + 1]), "+v"(wv[i + 2]), "+v"(wv[i + 3]), "+v"(wv[i + 4]), "+v"(wv[i + 5]), "+v"(wv[i + 6]), "+v"(wv[i + 7]));
#pragma unroll
    for (int i = 0; i < 32; ++i) { const int kk = 2 * i + (lane >> 5); const float ks = kscale ? kscale[k0 + kk] : 1.f; scr[kk * 33 + (lane & 31)] = wv[i] * ks * ns; }
    LDS_WAIT(); asm volatile("" ::: "memory");
    const int c = lane & 7;
#pragma unroll
    for (int j = 0; j < 4; ++j) { const int n = (lane >> 3) + 8 * j; const LAS float* s = scr + (8 * c) * 33 + n;
        v4u o; o.x = pk2(s[0 * 33], s[1 * 33]); o.y = pk2(s[2 * 33], s[3 * 33]); o.z = pk2(s[4 * 33], s[5 * 33]); o.w = pk2(s[6 * 33], s[7 * 33]);
        *(GAS v4u*)(WT + (size_t)(n0 + n) * K + k0 + 8 * c) = o; }
    LDS_WAIT(); asm volatile("" ::: "memory");
}
__device__ __forceinline__ void row_bf16_rs(int lane, const float* xrow, bf16_t* orow, float* rs) {
    const GAS f32x4* xr = (const GAS f32x4*)xrow + lane;
    f32x4 v[4]; float s = 0.f;
#pragma unroll
    for (int j = 0; j < 4; ++j) { v[j] = xr[64 * j]; s += (v[j].x * v[j].x + v[j].y * v[j].y) + (v[j].z * v[j].z + v[j].w * v[j].w); }
    s = wave_sum(s);
    if (lane == 0) *rs = 1.f / sqrtf(s * (1.f / DM) + EPS);
    GAS unsigned long long* o8 = (GAS unsigned long long*)orow + lane;
#pragma unroll
    for (int j = 0; j < 4; ++j) o8[64 * j] = (unsigned long long)pk2(v[j].x, v[j].y) | ((unsigned long long)pk2(v[j].z, v[j].w) << 32);
}

typedef float f32x16 __attribute__((ext_vector_type(16)));
typedef short s16x4 __attribute__((ext_vector_type(4)));
constexpr int AT_KP = 72, AT_VP = 260;
constexpr int AT_K_OFF = 0, AT_V_OFF = 256 * AT_KP * 2, AT_W_OFF = 71680, AT_W_BYTES = 4608;
static_assert(AT_V_OFF + 64 * AT_VP * 2 <= AT_W_OFF && AT_W_OFF + 8 * AT_W_BYTES <= RING_BYTES, "attention LDS map");
__device__ __forceinline__ int crow16(int r, int hi) { return (r & 3) + 8 * (r >> 2) + 4 * hi; }
__device__ __forceinline__ void attn_phase(Frame& F, const bf16_t* Q, int ldq, const bf16_t* K, int ldk, const bf16_t* V, int ldv, const float* TAB, const float* sinks, bf16_t* BO) {
    LAS bf16_t* Ks = (LAS bf16_t*)(F.lds + AT_K_OFF); LAS bf16_t* Vt = (LAS bf16_t*)(F.lds + AT_V_OFF);
    LAS bf16_t* stg = (LAS bf16_t*)(F.lds + AT_W_OFF + F.wave * AT_W_BYTES); LAS float* wsf = (LAS float*)(F.lds + AT_W_OFF + F.wave * AT_W_BYTES + 4096);
    const int lane = F.lane, r32 = lane & 31, hi = lane >> 5;
    const float NEG = -INFINITY;
    for (int unit = F.vcu; unit < NBATCH * 32 * 2; unit += F.G) {
        const int kvh = unit & 1, nblk = (unit >> 1) & 31, b = unit >> 6;
        const long row0 = (long)b * SEQ + (long)nblk * 128;
        __syncthreads();
#pragma unroll
        for (int i = 0; i < 4; ++i) { const int c = F.tid + i * NTHR, r = c >> 3, ch = c & 7; const long grow = row0 - 128 + r; v4u kv = {0u, 0u, 0u, 0u}, vv = {0u, 0u, 0u, 0u};
            const bool live = grow >= (long)b * SEQ;
            if (live) { kv = *(const v4u*)(K + (size_t)grow * ldk + 64 * kvh + 8 * ch); vv = *(const v4u*)(V + (size_t)grow * ldv + 64 * kvh + 8 * ch); }
            {
                v4u pr; pr.x = __shfl_xor(kv.x, 1); pr.y = __shfl_xor(kv.y, 1); pr.z = __shfl_xor(kv.z, 1); pr.w = __shfl_xor(kv.w, 1);
                if (live && ch < 2) { float a[8], p[8], o[8]; unpack8(kv, a); unpack8(pr, p);
                    const float* tb = TAB + (size_t)grow * 16; const f32x4 c0 = *(const f32x4*)tb, c1 = *(const f32x4*)(tb + 4), s0 = *(const f32x4*)(tb + 8), s1 = *(const f32x4*)(tb + 12);
                    const float sg = ch == 0 ? -1.f : 1.f;
#pragma unroll
                    for (int j = 0; j < 4; ++j) { o[j] = a[j] * c0[j] + sg * p[j] * s0[j]; o[4 + j] = a[4 + j] * c1[j] + sg * p[4 + j] * s1[j]; }
                    kv = pack8(o); } }
            *(LAS v4u*)(Ks + r * AT_KP + 8 * ch) = kv;
            LAS bf16_t* vp = Vt + (8 * ch) * AT_VP + r;
            vp[0 * AT_VP] = (bf16_t)(vv.x & 0xffffu); vp[1 * AT_VP] = (bf16_t)(vv.x >> 16); vp[2 * AT_VP] = (bf16_t)(vv.y & 0xffffu); vp[3 * AT_VP] = (bf16_t)(vv.y >> 16);
            vp[4 * AT_VP] = (bf16_t)(vv.z & 0xffffu); vp[5 * AT_VP] = (bf16_t)(vv.z >> 16); vp[6 * AT_VP] = (bf16_t)(vv.w & 0xffffu); vp[7 * AT_VP] = (bf16_t)(vv.w >> 16); }
        __syncthreads();
        const int head = kvh * 8 + F.wave;
        const float sinkv = sinks[head] * LOG2E;
#pragma unroll 1
        for (int c = 0; c < 4; ++c) {
            const bf16_t* qp = Q + (size_t)(row0 + 32 * c + r32) * ldq + 64 * head + 8 * hi;
            bf16x8 qf[4];
#pragma unroll
            for (int s = 0; s < 4; ++s) qf[s] = *(const bf16x8*)(qp + 16 * s);
            {
                const float* tb = TAB + (size_t)(row0 + 32 * c + r32) * 16; const f32x4 c0 = *(const f32x4*)tb, c1 = *(const f32x4*)(tb + 4), s0 = *(const f32x4*)(tb + 8), s1 = *(const f32x4*)(tb + 12);
                const v4u w = __builtin_bit_cast(v4u, qf[0]); v4u pr; pr.x = __shfl_xor(w.x, 32); pr.y = __shfl_xor(w.y, 32); pr.z = __shfl_xor(w.z, 32); pr.w = __shfl_xor(w.w, 32);
                float a[8], p[8], o[8]; unpack8(w, a); unpack8(pr, p); const float sg = hi == 0 ? -1.f : 1.f;
#pragma unroll
                for (int j = 0; j < 4; ++j) { o[j] = a[j] * c0[j] + sg * p[j] * s0[j]; o[4 + j] = a[4 + j] * c1[j] + sg * p[4 + j] * s1[j]; }
                qf[0] = __builtin_bit_cast(bf16x8, pack8(o)); }
            f32x16 S[5];
#pragma unroll
            for (int t = 0; t < 5; ++t) {
#pragma unroll
                for (int r = 0; r < 16; ++r) S[t][r] = 0.f;
                const LAS bf16_t* kp = Ks + ((c + t) * 32 + r32) * AT_KP + 8 * hi;
#pragma unroll
                for (int s = 0; s < 4; ++s) { const bf16x8 kf = *(const LAS bf16x8*)(kp + 16 * s); S[t] = __builtin_amdgcn_mfma_f32_32x32x16_bf16(kf, qf[s], S[t], 0, 0, 0); }
            }
#pragma unroll
            for (int r = 0; r < 16; ++r) { const int jj = crow16(r, hi); if (!(jj > r32)) S[0][r] = NEG; if (!(jj <= r32)) S[4][r] = NEG; }
#pragma unroll
            for (int t = 0; t < 5; ++t) { if (nblk == 0 && c + t < 4) {
#pragma unroll
                for (int r = 0; r < 16; ++r) S[t][r] = NEG; } }
            float mx = NEG;
#pragma unroll
            for (int t = 0; t < 5; ++t)
#pragma unroll
                for (int r = 0; r < 16; ++r) mx = fmaxf(mx, S[t][r]);
            mx = fmaxf(mx, __shfl_xor(mx, 32)); mx = fmaxf(mx, sinkv);
            float l = 0.f;
#pragma unroll
            for (int t = 0; t < 5; ++t)
#pragma unroll
                for (int r = 0; r < 16; ++r) { const float p = __builtin_amdgcn_exp2f(S[t][r] - mx); S[t][r] = p; l += p; }
            l += __shfl_xor(l, 32); l += __builtin_amdgcn_exp2f(sinkv - mx);
            f32x16 O[2];
#pragma unroll
            for (int r = 0; r < 16; ++r) { O[0][r] = 0.f; O[1][r] = 0.f; }
#pragma unroll
            for (int t = 0; t < 5; ++t)
#pragma unroll
                for (int s = 0; s < 2; ++s) {
                    v4u pw; pw.x = pk2(S[t][8 * s + 0], S[t][8 * s + 1]); pw.y = pk2(S[t][8 * s + 2], S[t][8 * s + 3]); pw.z = pk2(S[t][8 * s + 4], S[t][8 * s + 5]); pw.w = pk2(S[t][8 * s + 6], S[t][8 * s + 7]);
                    const bf16x8 xs = __builtin_bit_cast(bf16x8, pw);
#pragma unroll
                    for (int d0 = 0; d0 < 2; ++d0) { const LAS bf16_t* vp = Vt + (32 * d0 + r32) * AT_VP + (c + t) * 32 + 16 * s + 4 * hi;
                        const s16x4 lo = *(const LAS s16x4*)vp, hh = *(const LAS s16x4*)(vp + 8);
                        const bf16x8 vf = __builtin_shufflevector(lo, hh, 0, 1, 2, 3, 4, 5, 6, 7);
                        O[d0] = __builtin_amdgcn_mfma_f32_32x32x16_bf16(xs, vf, O[d0], 0, 0, 0); }
                }
            asm volatile("s_waitcnt lgkmcnt(0)" ::: "memory");
            if (hi == 0) wsf[r32] = 1.f / l;
            asm volatile("s_waitcnt lgkmcnt(0)" ::: "memory");
#pragma unroll
            for (int r = 0; r < 16; ++r) { const int qi = crow16(r, hi); const float inv = wsf[qi];
                stg[qi * 64 + r32] = (bf16_t)f2bf(O[0][r] * inv); stg[qi * 64 + 32 + r32] = (bf16_t)f2bf(O[1][r] * inv); }
            asm volatile("s_waitcnt lgkmcnt(0)" ::: "memory");
#pragma unroll
            for (int i = 0; i < 4; ++i) { const int row = i * 8 + (lane >> 3), ch = lane & 7; const v4u v = *(const LAS v4u*)(stg + row * 64 + ch * 8);
                *(v4u*)(BO + (size_t)(row0 + 32 * c + row) * DM + 64 * head + 8 * ch) = v; }
            asm volatile("s_waitcnt lgkmcnt(0)" ::: "memory");
        }
    }
    __syncthreads();
}

template <int G_> __device__ __forceinline__ void pool_prep_item(const bf16_t* U, bf16_t* P, int tb, int ch) {
    constexpr int W = 2 << G_, NR = 8 + W - 1;
    const int t0 = tb * 8, ts0 = t0 & (SEQ - 1);
    v4u rows[NR];
#pragma unroll
    for (int k = 0; k < NR; ++k) { const int tseq = ts0 - (W - 1) + k; rows[k] = (v4u){0u, 0u, 0u, 0u}; if (tseq >= 0) rows[k] = *(const v4u*)(U + (size_t)(t0 - (W - 1) + k) * DM + 8 * ch); }
    float s[8];
#pragma unroll
    for (int j = 0; j < 8; ++j) s[j] = 0.f;
#pragma unroll
    for (int k = 0; k < W; ++k) { float f[8]; unpack8(rows[k], f);
#pragma unroll
        for (int j = 0; j < 8; ++j) s[j] += f[j]; }
#pragma unroll
    for (int t = 0; t < 8; ++t) { float u[8]; unpack8(rows[t + W - 1], u);
        if (t > 0) { float o[8]; unpack8(rows[t - 1], o);
#pragma unroll
            for (int j = 0; j < 8; ++j) s[j] += u[j] - o[j]; }
        const int cnt = (ts0 + t + 1 < W) ? ts0 + t + 1 : W; const float ic = 1.f / (float)cnt; float r[8];
#pragma unroll
        for (int j = 0; j < 8; ++j) r[j] = s[j] * ic - u[j];
        *(v4u*)(P + (size_t)(t0 + t) * DM + 8 * ch) = pack8(r); }
}

__device__ __forceinline__ void rows4_bf16_rs(int lane, const float* xrow, bf16_t* orow, float* rs) {
    f32x4 v[4][4];
#pragma unroll
    for (int r = 0; r < 4; ++r)
#pragma unroll
        for (int j = 0; j < 4; ++j) v[r][j] = *((const GAS f32x4*)(xrow + (size_t)r * DM) + lane + 64 * j);
#pragma unroll
    for (int r = 0; r < 4; ++r) asm volatile("" : "+v"(v[r][0]), "+v"(v[r][1]), "+v"(v[r][2]), "+v"(v[r][3]));
#pragma unroll
    for (int r = 0; r < 4; ++r) { float s = 0.f;
#pragma unroll
        for (int j = 0; j < 4; ++j) s += (v[r][j].x * v[r][j].x + v[r][j].y * v[r][j].y) + (v[r][j].z * v[r][j].z + v[r][j].w * v[r][j].w);
        s = wave_sum(s);
        if (lane == 0) rs[r] = 1.f / sqrtf(s * (1.f / DM) + EPS);
        GAS unsigned long long* o8 = (GAS unsigned long long*)(orow + (size_t)r * DM) + lane;
#pragma unroll
        for (int j = 0; j < 4; ++j) o8[64 * j] = (unsigned long long)pk2(v[r][j].x, v[r][j].y) | ((unsigned long long)pk2(v[r][j].z, v[r][j].w) << 32); }
}

struct Args { const void* in[16]; float* out; unsigned char* ws; double invf[8]; int ph_lo, ph_hi, li, pad; };

__global__ void __launch_bounds__(NTHR, 2) mega_fwd(Args args) {
    extern __shared__ __attribute__((aligned(16))) unsigned char lds[];
    Frame F;
    F.lds = (LAS unsigned char*)lds;
    F.MISC = (volatile LAS unsigned*)(F.lds + MISC_OFF);
    F.tid = threadIdx.x; F.lane = F.tid & 63; F.wave = __builtin_amdgcn_readfirstlane(F.tid >> 6);
    F.G = gridDim.x; { const int bx = blockIdx.x; F.vcu = (F.G % 8 == 0) ? (bx % 8) * (F.G / 8) + bx / 8 : bx; }
    unsigned char* ws = args.ws;
    F.ctl = (gu32*)(ws + WS_CTL);
    const float* x = (const float*)args.in[0]; const int* positions = (const int*)args.in[1]; const float* attn_norm = (const float*)args.in[2];
    const float* w_in = (const float*)args.in[3]; const float* b_gate = (const float*)args.in[4]; const float* w_pool = (const float*)args.in[5];
    const float* pool_scale = (const float*)args.in[6]; const float* q_norm = (const float*)args.in[7]; const float* k_norm = (const float*)args.in[8];
    const float* sinks = (const float*)args.in[9]; const float* w_out = (const float*)args.in[10]; const float* ffn_norm = (const float*)args.in[11];
    const float* w_up = (const float*)args.in[12]; const float* conv_w = (const float*)args.in[13]; const float* conv_b = (const float*)args.in[14];
    const float* w_down = (const float*)args.in[15];
    float* out = args.out;
    float* R1 = (float*)(ws + WS_R1); float* SSQ = (float*)(ws + WS_SSQ); float* TAB = (float*)(ws + WS_TAB);
    bf16_t* Win_t = (bf16_t*)(ws + WS_WIN); bf16_t* Wp_t = (bf16_t*)(ws + WS_WP); bf16_t* Wo_t = (bf16_t*)(ws + WS_WO); bf16_t* Wu_t = (bf16_t*)(ws + WS_WU); bf16_t* Wd_t = (bf16_t*)(ws + WS_WD);
    bf16_t* XB = (bf16_t*)(ws + WS_XB); bf16_t* U = (bf16_t*)(ws + WS_Z); bf16_t* QB = (bf16_t*)(ws + WS_Z + 64 * MiB); bf16_t* KB = (bf16_t*)(ws + WS_Z + 128 * MiB); bf16_t* VB = (bf16_t*)(ws + WS_Z + 136 * MiB); bf16_t* GB = (bf16_t*)(ws + WS_Z + 144 * MiB); float* Y01 = (float*)(ws + WS_Y01); float* HALO = (float*)(ws + WS_HALO); bf16_t* HACT = (bf16_t*)(ws + WS_HACT);
    bf16_t* BO = (bf16_t*)(ws + WS_B); bf16_t* AP = (bf16_t*)(ws + WS_AP);

    for (int u = F.tid; u < (LDS_BYTES - LDSCTL_OFF) / 4; u += NTHR) ((LAS unsigned*)(F.lds + LDSCTL_OFF))[u] = 0u;
    __syncthreads();
    XcdBarrier bar; bar.bar = (unsigned*)(F.ctl + CW_BAR) + args.li * XCD_BAR_WORDS; bar.x = 0; bar.st = nullptr;
    if (MK_N_LAUNCHES == 1) bar = xcd_barrier_post((unsigned*)(F.ctl + CW_BAR) + args.li * XCD_BAR_WORDS, F.MISC + 8);
#define GRID_BAR() do { if (MK_N_LAUNCHES == 1) xcd_barrier(bar); } while (0)
    const int lo = args.ph_lo, hi = args.ph_hi;
#define IN(k) (lo <= (k) && (k) < hi)
#define BOTH(k) (IN(k) && IN((k) + 1))
    const int gt = F.vcu * NTHR + F.tid, GT = F.G * NTHR;
    const int gw = F.vcu * NWAVES + F.wave, NGW = F.G * NWAVES;

    if (IN(0)) {
        LAS float* scr = (LAS float*)(F.lds + F.wave * 16384);
        constexpr int I_IN = (DM / 64) * (NIN / 32), I_P = (256 / 64) * (256 / 32), I_O = (DM / 64) * (DM / 32), I_U = (DM / 64) * (NUP / 32), I_D = (DFF / 64) * (DM / 32);
        constexpr int NITEMS = I_IN + 4 * I_P + I_O + I_U + I_D;
        for (int it = gw; it < NITEMS; it += NGW) {
            int r = it;
            if (r < I_IN) { p0_transpose_item(w_in, DM, NIN, Win_t, attn_norm, nullptr, scr, r, F.lane); continue; } r -= I_IN;
            if (r < 4 * I_P) { const int g = r / I_P; p0_transpose_item(w_pool + (size_t)g * 65536, 256, 256, Wp_t + (size_t)g * 65536, nullptr, pool_scale + 256 * g, scr, r % I_P, F.lane); continue; } r -= 4 * I_P;
            if (r < I_O) { p0_transpose_item(w_out, DM, DM, Wo_t, nullptr, nullptr, scr, r, F.lane); continue; } r -= I_O;
            if (r < I_U) { p0_transpose_item(w_up, DM, NUP, Wu_t, ffn_norm, nullptr, scr, r, F.lane); continue; } r -= I_U;
            p0_transpose_item(w_down, DFF, DM, Wd_t, nullptr, nullptr, scr, r, F.lane);
        }
        for (int m = 4 * gw; m < M; m += 4 * NGW) rows4_bf16_rs(F.lane, x + (size_t)m * DM, XB + (size_t)m * DM, R1 + m);
        for (int idx = gt; idx < M * 8; idx += GT) { const int m = idx >> 3, j = idx & 7;
            double rev = (double)positions[m] * args.invf[j]; rev -= floor(rev); const float fr = (float)rev;
            TAB[(size_t)m * 16 + j] = __builtin_amdgcn_cosf(fr); TAB[(size_t)m * 16 + 8 + j] = __builtin_amdgcn_sinf(fr); }
        if (BOTH(0)) GRID_BAR();
    }
    if (IN(1)) {
        pg8::Gemm g{DM, DM, DM, (size_t)128 * DM * 2, (size_t)32 * DM * 2};
        pg8::TileOrder S; S.init(M / 256, NIN / 256, F.G, (int)blockIdx.x, XB, Win_t, (size_t)256 * DM * 2, (size_t)256 * DM * 2, 0);
        pg8::EpiIn E{R1, q_norm, k_norm, b_gate, U, QB, KB, VB, GB};
        pg8::gemm_phase<pg8::EpiIn, pg8::TileOrder, true>(F.lds, g, S, E);
        if (BOTH(1)) GRID_BAR();
    }
    if (IN(2)) {
        bf16_t* P = XB;
        for (int wi = gw; wi < 8192; wi += NGW) { const int g = wi >> 11, tb = 2 * (wi & 2047) + (F.lane >> 5), ch = 32 * g + (F.lane & 31);
            if (g == 0) pool_prep_item<0>(U, P, tb, ch); else if (g == 1) pool_prep_item<1>(U, P, tb, ch); else if (g == 2) pool_prep_item<2>(U, P, tb, ch); else pool_prep_item<3>(U, P, tb, ch); }
        attn_phase(F, QB, DM, KB, 128, VB, 128, TAB, sinks, BO);
        if (BOTH(2)) GRID_BAR();
    }
    if (IN(4)) {
        pg8::Gemm g{DM, 256, 256, (size_t)128 * DM * 2, (size_t)128 * 256 * 2};
        pg8::TileOrder S; S.init(M / 256, 4, F.G, (int)blockIdx.x, XB, Wp_t, (size_t)256 * DM * 2, (size_t)256 * 256 * 2, (size_t)256 * 2);
        pg8::EpiMix E{GB, BO, AP};
        pg8::gemm_phase<pg8::EpiMix, pg8::TileOrder, true>(F.lds, g, S, E);
        if (BOTH(4)) GRID_BAR();
    }
    if (IN(6)) {
        pg8::Gemm g{DM, DM, DM, (size_t)128 * DM * 2, (size_t)128 * DM * 2};
        pg8::TileOrder S; S.init(M / 256, DM / 256, F.G, (int)blockIdx.x, AP, Wo_t, (size_t)256 * DM * 2, (size_t)256 * DM * 2, 0);
        pg8::EpiOut1 E{x, out, XB, SSQ};
        pg8::gemm_phase<pg8::EpiOut1, pg8::TileOrder, true>(F.lds, g, S, E);
        if (BOTH(6)) GRID_BAR();
    }
    if (IN(8)) {
        pg8::Gemm g{DM, DM, DM, (size_t)4 * DM * 2, (size_t)DFF * DM * 2};
        pg8::TileOrder S; S.init(M / 256, DFF / 128, F.G, (int)blockIdx.x, XB, Wu_t, (size_t)256 * DM * 2, (size_t)128 * DM * 2, 0);
        pg8::EpiConv E{SSQ, conv_w, conv_b, HACT, Y01, HALO};
        pg8::gemm_phase<pg8::EpiConv, pg8::TileOrder, true>(F.lds, g, S, E);
        if (BOTH(8)) GRID_BAR();
    }
    if (IN(12)) {
        pg8::Gemm g{DFF, DFF, DFF, (size_t)128 * DFF * 2, (size_t)128 * DFF * 2};
        pg8::TileOrder S; S.init(M / 256, DM / 256, F.G, (int)blockIdx.x, HACT, Wd_t, (size_t)256 * DFF * 2, (size_t)256 * DFF * 2, 0);
        { pg8::Unit fu;
          for (int ui = 0; S.next(ui, fu); ++ui)
            for (int idx = F.tid; idx < 2 * (DFF / 8); idx += NTHR) { const int q = fu.pm * 2 + idx / (DFF / 8), c8 = idx % (DFF / 8);
                if ((q & 31) == 0) continue;
                float y0[16], y1[16];
#pragma unroll
                for (int h = 0; h < 2; ++h)
#pragma unroll
                    for (int v = 0; v < 2; ++v) { const int c = h * DFF + 8 * c8 + 4 * v;
                        const f32x4 a0 = *(const f32x4*)(Y01 + (size_t)(q * 2 + 0) * NUP + c), a1 = *(const f32x4*)(Y01 + (size_t)(q * 2 + 1) * NUP + c);
                        const f32x4 h6 = *(const f32x4*)(HALO + (size_t)((q - 1) * 2 + 0) * NUP + c), h7 = *(const f32x4*)(HALO + (size_t)((q - 1) * 2 + 1) * NUP + c);
                        const f32x4 w0 = *(const f32x4*)(conv_w + c), w1 = *(const f32x4*)(conv_w + NUP + c);
                        const f32x4 r0 = a0 + w1 * h7 + w0 * h6, r1 = a1 + w0 * h7;
#pragma unroll
                        for (int j = 0; j < 4; ++j) { y0[8 * h + 4 * v + j] = r0[j]; y1[8 * h + 4 * v + j] = r1[j]; } }
                float o0[8], o1[8];
#pragma unroll
                for (int j = 0; j < 8; ++j) { o0[j] = y0[j] * sigmoidf_(y0[j]) * y0[8 + j]; o1[j] = y1[j] * sigmoidf_(y1[j]) * y1[8 + j]; }
                *(v4u*)(HACT + (size_t)(q * 128 + 0) * DFF + 8 * c8) = pack8(o0); *(v4u*)(HACT + (size_t)(q * 128 + 1) * DFF + 8 * c8) = pack8(o1); }
          VM_WAIT(); __syncthreads(); }
        pg8::EpiRes E{out, out, DM};
        pg8::gemm_phase<pg8::EpiRes, pg8::TileOrder, true>(F.lds, g, S, E);
    }
#undef IN
#undef BOTH
}

extern "C" void kernel_launch(void* const* d_in, const int* in_sizes, int n_in, void* d_out, int out_size, void* d_ws, size_t ws_size, hipStream_t stream) {
    static int grid = 0;
    if (grid == 0) {
        if (n_in != 16 || in_sizes[0] != M * DM || out_size != M * DM || ws_size < WS_END) { fprintf(stderr, "kernel_launch: unexpected shapes (n_in %d, in0 %d, out %d, ws %zu); nothing launched\n", n_in, n_in > 0 ? in_sizes[0] : -1, out_size, ws_size); grid = -1; return; }
        int dev = 0, cus = 0, per_cu = 0;
        if (hipGetDevice(&dev) != hipSuccess || hipDeviceGetAttribute(&cus, hipDeviceAttributeMultiprocessorCount, dev) != hipSuccess) { grid = -1; return; }
        if (hipFuncSetAttribute((const void*)mega_fwd, hipFuncAttributeMaxDynamicSharedMemorySize, LDS_BYTES) != hipSuccess) { fprintf(stderr, "kernel_launch: hipFuncSetAttribute failed\n"); grid = -1; return; }
        if (hipOccupancyMaxActiveBlocksPerMultiprocessor(&per_cu, (const void*)mega_fwd, NTHR, LDS_BYTES) != hipSuccess || per_cu < 1) { fprintf(stderr, "kernel_launch: occupancy query reports %d blocks per CU\n", per_cu); (void)hipGetLastError(); grid = -1; return; }
        grid = cus;
    }
    if (grid < 0) return;
    if (hipMemsetAsync((char*)d_ws + WS_CTL, 0, CTL_ZERO_BYTES, stream) != hipSuccess) return;
    Args a{};
    for (int i = 0; i < 16; ++i) a.in[i] = d_in[i];
    a.out = (float*)d_out; a.ws = (unsigned char*)d_ws;
    for (int j = 0; j < 8; ++j) a.invf[j] = std::pow(500000.0, -(double)j / 8.0) / 6.283185307179586476925;
#ifdef PROBE_HI
    a.ph_lo = 0; a.ph_hi = PROBE_HI; a.li = 1; hipLaunchKernelGGL(mega_fwd, dim3(grid), dim3(NTHR), LDS_BYTES, stream, a);
#endif
    if (MK_N_LAUNCHES == 1) { a.ph_lo = 0; a.ph_hi = N_PHASES; a.li = 0; hipLaunchKernelGGL(mega_fwd, dim3(grid), dim3(NTHR), LDS_BYTES, stream, a); }
    else for (int p = 0; p < N_PHASES; ++p) { a.ph_lo = p; a.ph_hi = p + 1; a.li = p; hipLaunchKernelGGL(mega_fwd, dim3(grid), dim3(NTHR), LDS_BYTES, stream, a); }
}
```

```cpp
#include <hip/hip_runtime.h>
#include <cstdio>
#include <cstdint>
#include <cmath>

#ifndef MK_N_LAUNCHES
#define MK_N_LAUNCHES 1
#endif

constexpr int DM = 1024, NBATCH = 8, SEQ = 4096, M = NBATCH * SEQ;
constexpr int NIN = 4352, DFF = 2816, NUP = 2 * DFF;
constexpr int ZQ = 1024, ZK = 2048, ZV = 2176, ZG = 2304;
constexpr float EPS = 1e-6f, LOG2E = 1.4426950408889634f;

#define GAS __attribute__((address_space(1)))
#define LAS __attribute__((address_space(3)))
typedef unsigned short bf16_t;
typedef unsigned v4u __attribute__((ext_vector_type(4)));
typedef float f32x4 __attribute__((ext_vector_type(4)));
typedef short bf16x8 __attribute__((ext_vector_type(8)));
typedef GAS unsigned gu32;
#define RLX_AGENT __ATOMIC_RELAXED, __HIP_MEMORY_SCOPE_AGENT
#define LDS_WAIT() asm volatile("s_waitcnt lgkmcnt(0)" ::: "memory")
#define VM_WAIT() asm volatile("s_waitcnt vmcnt(0)" ::: "memory")

__device__ __forceinline__ unsigned f2bf(float f) { unsigned u = __builtin_bit_cast(unsigned, f); return (u + 0x7fffu + ((u >> 16) & 1u)) >> 16; }
typedef float f32x2_t __attribute__((ext_vector_type(2))); typedef __bf16 bf16x2_t __attribute__((ext_vector_type(2)));
__device__ __forceinline__ unsigned pk2(float lo, float hi) { f32x2_t v = {lo, hi}; bf16x2_t b = __builtin_convertvector(v, bf16x2_t); return __builtin_bit_cast(unsigned, b); }
__device__ __forceinline__ float bflo(unsigned w) { return __uint_as_float(w << 16); }
__device__ __forceinline__ float bfhi(unsigned w) { return __uint_as_float(w & 0xffff0000u); }
__device__ __forceinline__ void unpack8(const v4u w, float (&f)[8]) { f[0] = bflo(w.x); f[1] = bfhi(w.x); f[2] = bflo(w.y); f[3] = bfhi(w.y); f[4] = bflo(w.z); f[5] = bfhi(w.z); f[6] = bflo(w.w); f[7] = bfhi(w.w); }
__device__ __forceinline__ v4u pack8(const float (&f)[8]) { v4u w; w.x = pk2(f[0], f[1]); w.y = pk2(f[2], f[3]); w.z = pk2(f[4], f[5]); w.w = pk2(f[6], f[7]); return w; }
__device__ __forceinline__ float sigmoidf_(float x) { return __builtin_amdgcn_rcpf(1.f + __builtin_amdgcn_exp2f(-x * LOG2E)); }

namespace pg8 {
constexpr int BM = 256, BK = 64, HALF = 128, HTB = HALF * BK * 2, STAGE_BYTES = 8 * HTB, NXCD = 8, WGM = 8;
__host__ __device__ __forceinline__ int lds_byte(int r, int c) { const int st = (r >> 4) * 2 + (c >> 5), rr = r & 15, cc = c & 31, ob = rr * 64 + cc * 2; return st * 1024 + (ob ^ (((ob >> 9) & 1) << 5)); }
__host__ __device__ __forceinline__ void stage_rc(int b, int& R, int& C) { const int st = b / 1024, sb = b % 1024, swz = sb ^ (((sb >> 9) & 1) << 5); R = (st >> 1) * 16 + swz / 64; C = (st & 1) * 32 + (swz % 64) / 2; }
__host__ __device__ __forceinline__ int perm32(int rho) { const int n = rho >> 4, i = rho & 15; return 8 * (i >> 2) + 4 * n + (i & 3); }

struct Unit { const char* a; const char* b; int pm, pn; };
struct Gemm { int lda, ldb, K; size_t hstepA, hstepB; };

struct TileOrder {
    int nM, nN, nwg, G, c; const char* A; const char* B; size_t sA, sB, sApn;
    __device__ void init(int nM_, int nN_, int G_, int c_, const void* A_, const void* B_, size_t sA_, size_t sB_, size_t sApn_) { nM = nM_; nN = nN_; nwg = nM * nN; G = G_; c = c_; A = (const char*)A_; B = (const char*)B_; sA = sA_; sB = sB_; sApn = sApn_; }
    __device__ bool next(int i, Unit& u) const {
        const long L = (long)i * G + c; if (L >= nwg) return false;
        int wgid = (int)L; { const int q = nwg / NXCD, r = nwg % NXCD, xcd = wgid % NXCD, off = wgid / NXCD; wgid = (xcd < r ? xcd * (q + 1) : r * (q + 1) + (xcd - r) * q) + off; }
        const int nig = WGM * nN, gid = wgid / nig, fm = gid * WGM, gsz = (nM - fm) < WGM ? (nM - fm) : WGM;
        u.pm = fm + ((wgid % nig) % gsz); u.pn = (wgid % nig) / gsz;
        u.a = A + (size_t)u.pm * sA + (size_t)u.pn * sApn; u.b = B + (size_t)u.pn * sB; return true;
    }
};

template <int BMODE> __device__ __forceinline__ int mapB(int R) { return BMODE == 1 ? ((R & ~31) + perm32(R & 31)) : (BMODE == 2 ? (64 * (R >> 5) + perm32(R & 31)) : R); }
template <int AMODE> __device__ __forceinline__ int mapA(int R) { return AMODE == 1 ? (128 * (R >> 6) + 8 * (R & 15) + ((R >> 4) & 3)) : R; }

template <class Epi, class Sched, bool ALIGN_EPI>
__device__ __forceinline__ void gemm_phase(LAS unsigned char* lds, const Gemm g, const Sched& S, const Epi& E) {
    const int tid = threadIdx.x, wid = __builtin_amdgcn_readfirstlane(tid >> 6), lane = tid & 63, wr = wid >> 2, wc = wid & 3, fr = lane & 15, fq = lane >> 4;
    const int nt = g.K / BK;
    unsigned voffA[2], voffB[2];
#pragma unroll
    for (int i = 0; i < 2; ++i) { int R, C; stage_rc(tid * 16 + i * 8192, R, C); const int Rb = mapB<Epi::BMODE>(R);
        voffA[i] = (unsigned)(mapA<Epi::AMODE>(R) * g.lda + C) * 2u; voffB[i] = (unsigned)(Rb * g.ldb + C) * 2u; }
    const size_t kstep = (size_t)(BK * 2);
    const size_t hstepA = g.hstepA, hstepB = g.hstepB;
    const unsigned ldsw = (unsigned)wid * 1024u;
    const int aoff = lds_byte(wr * 64 + fr, fq * 8), boff = lds_byte(wc * 32 + fr, fq * 8);
#define PG8_SA(b, h) (((b) * 2 + (h)) * HTB)
#define PG8_SB(b, h) ((4 + (b) * 2 + (h)) * HTB)
#define PG8_STAGE(bufoff, gbase, voff) do { _Pragma("unroll") for (int _i = 0; _i < 2; ++_i) \
        __builtin_amdgcn_global_load_lds((const unsigned*)((const char*)(gbase) + (voff)[_i]), (LAS unsigned*)(lds + (bufoff) + ldsw + _i * 8192), 16, 0, 0); } while (0)
#define PG8_LDA(dst, b, h) do { _Pragma("unroll") for (int m = 0; m < 4; ++m) _Pragma("unroll") for (int k = 0; k < 2; ++k) dst[m][k] = *(const LAS bf16x8*)(lds + PG8_SA(b, h) + aoff + m * 2048 + k * 1024); } while (0)
#define PG8_LDB(dst, b, h) do { _Pragma("unroll") for (int n = 0; n < 2; ++n) _Pragma("unroll") for (int k = 0; k < 2; ++k) dst[n][k] = *(const LAS bf16x8*)(lds + PG8_SB(b, h) + boff + n * 2048 + k * 1024); } while (0)
#define PG8_MMA(ai, bj, At, Bt) do { __builtin_amdgcn_s_setprio(1); _Pragma("unroll") for (int m = 0; m < 4; ++m) _Pragma("unroll") for (int n = 0; n < 2; ++n) _Pragma("unroll") for (int k = 0; k < 2; ++k) \
        acc[ai][bj][m][n] = __builtin_amdgcn_mfma_f32_16x16x32_bf16(Bt[n][k], At[m][k], acc[ai][bj][m][n], 0, 0, 0); __builtin_amdgcn_s_setprio(0); } while (0)
#define PG8_WAIT_V(n) asm volatile("s_waitcnt vmcnt(" #n ")" ::: "memory")
#define PG8_WAIT_L(n) asm volatile("s_waitcnt lgkmcnt(" #n ")" ::: "memory")
#define PG8_BAR __builtin_amdgcn_s_barrier()
#define PG8_SCHED __builtin_amdgcn_sched_barrier(0)
    Unit cur, nxt; int ui = 0;
    if (!S.next(0, cur)) return;
    f32x4 acc[2][2][4][2];
#pragma unroll
    for (int a = 0; a < 2; ++a)
#pragma unroll
        for (int b = 0; b < 2; ++b)
#pragma unroll
            for (int m = 0; m < 4; ++m)
#pragma unroll
                for (int n = 0; n < 2; ++n) acc[a][b][m][n] = (f32x4){0.f, 0.f, 0.f, 0.f};
    bf16x8 At[4][2], B0[2][2], B1[2][2];
    const char* cA = cur.a; const char* cB = cur.b;
    PG8_STAGE(PG8_SB(0, 0), cB, voffB); PG8_STAGE(PG8_SB(0, 1), cB + hstepB, voffB); PG8_STAGE(PG8_SA(0, 0), cA, voffA); PG8_STAGE(PG8_SA(0, 1), cA + hstepA, voffA);
    if (wr == 1) PG8_BAR;
    PG8_WAIT_V(2); PG8_BAR;
    PG8_STAGE(PG8_SB(1, 0), cB + kstep, voffB); PG8_STAGE(PG8_SA(1, 0), cA + kstep, voffA); PG8_STAGE(PG8_SB(1, 1), cB + hstepB + kstep, voffB);
    PG8_WAIT_V(6); PG8_BAR;
    for (;;) {
        const bool has_next = S.next(ui + 1, nxt);
        const char* nA = has_next ? nxt.a : cA; const char* nB = has_next ? nxt.b : cB;
        for (int t = 0; t < nt; t += 2) {
            const bool last = (t == nt - 2);
            const char* a1 = cA + (size_t)(t + 1) * kstep;
            const char* a2 = last ? nA : cA + (size_t)(t + 2) * kstep; const char* b2 = last ? nB : cB + (size_t)(t + 2) * kstep;
            const char* a3 = a2 + kstep; const char* b3 = b2 + kstep;
            PG8_LDB(B0, 0, 0); PG8_LDB(B1, 0, 1); PG8_SCHED; PG8_LDA(At, 0, 0); PG8_STAGE(PG8_SA(1, 1), a1 + hstepA, voffA);
            PG8_WAIT_V(8); PG8_WAIT_L(0); PG8_BAR; PG8_MMA(0, 0, At, B0); PG8_MMA(0, 1, At, B1); PG8_BAR; PG8_SCHED;
            PG8_LDA(At, 0, 1); PG8_STAGE(PG8_SB(0, 0), b2, voffB); PG8_STAGE(PG8_SB(0, 1), b2 + hstepB, voffB); PG8_STAGE(PG8_SA(0, 0), a2, voffA);
            PG8_WAIT_V(8); PG8_WAIT_L(0); PG8_BAR; PG8_MMA(1, 0, At, B0); PG8_MMA(1, 1, At, B1); PG8_BAR; PG8_SCHED;
            PG8_LDB(B0, 1, 0); PG8_LDB(B1, 1, 1); PG8_SCHED; PG8_LDA(At, 1, 0); PG8_STAGE(PG8_SA(0, 1), a2 + hstepA, voffA);
            PG8_WAIT_V(8); PG8_WAIT_L(0); PG8_BAR; PG8_MMA(0, 0, At, B0); PG8_MMA(0, 1, At, B1); PG8_BAR; PG8_SCHED;
            PG8_LDA(At, 1, 1); PG8_STAGE(PG8_SB(1, 0), b3, voffB); PG8_STAGE(PG8_SB(1, 1), b3 + hstepB, voffB); PG8_STAGE(PG8_SA(1, 0), a3, voffA);
            PG8_WAIT_V(8); PG8_WAIT_L(0); PG8_BAR; PG8_MMA(1, 0, At, B0); PG8_MMA(1, 1, At, B1); PG8_BAR; PG8_SCHED;
        }
        if constexpr (ALIGN_EPI) { if (wr == 0) PG8_BAR; }
        E(acc, cur, wr, wc, fr, fq);
        if (!has_next) break;
#pragma unroll
        for (int a = 0; a < 2; ++a)
#pragma unroll
            for (int b = 0; b < 2; ++b)
#pragma unroll
                for (int m = 0; m < 4; ++m)
#pragma unroll
                    for (int n = 0; n < 2; ++n) acc[a][b][m][n] = (f32x4){0.f, 0.f, 0.f, 0.f};
        cur = nxt; cA = nA; cB = nB; ++ui;
        if constexpr (ALIGN_EPI) { if (wr == 1) PG8_BAR; }
    }
    PG8_WAIT_V(0);
    if constexpr (!ALIGN_EPI) { if (wr == 0) PG8_BAR; }
    PG8_BAR;
#undef PG8_SA
#undef PG8_SB
#undef PG8_STAGE
#undef PG8_LDA
#undef PG8_LDB
#undef PG8_MMA
#undef PG8_WAIT_V
#undef PG8_WAIT_L
#undef PG8_BAR
#undef PG8_SCHED
}

struct EpiIn {
    static constexpr int BMODE = 2, AMODE = 0;
    const float* r1; const float* qn; const float* kn; const float* bg; bf16_t* U; bf16_t* Q; bf16_t* Kb; bf16_t* Vb; bf16_t* G; const float* TAB; int fl;
    __device__ __forceinline__ void operator()(const f32x4 (&acc)[2][2][4][2], const Unit& u, int wr, int wc, int fr, int fq) const {
        if (fl & 2) return;
        const int row0 = u.pm * BM + wr * 64 + fr, hc = wc * 64 + 8 * fq, pn = u.pn;
        int mode, ld, coloff; bf16_t* base; const float* par = nullptr; float qs = 1.f; bool rope = false;
        if (pn < 4) { mode = 0; base = U; ld = DM; coloff = pn * 256 + hc; }
        else if (pn < 8) { mode = 1; base = Q; ld = DM; coloff = (pn - 4) * 256 + hc; par = qn + 8 * fq; qs = 0.125f * LOG2E; }
        else if (pn == 8) { if (wc < 2) { mode = 1; base = Kb; ld = 128; coloff = hc; par = kn + 8 * fq; rope = true; } else { mode = 0; base = Vb; ld = 128; coloff = hc - 128; } }
        else { mode = 2; base = G; ld = 2 * DM; coloff = (pn - 9) * 256 + hc; par = bg + coloff; }
        float rs[8];
#pragma unroll
        for (int e = 0; e < 8; ++e) rs[e] = r1[row0 + (e >> 2) * HALF + (e & 3) * 16];
        f32x4 pv[2][2];
#pragma unroll
        for (int bj = 0; bj < 2; ++bj)
#pragma unroll
            for (int n = 0; n < 2; ++n) pv[bj][n] = par ? *(const f32x4*)(par + 32 * bj + 4 * n) : (f32x4){0.f, 0.f, 0.f, 0.f};
        asm volatile("" : "+v"(rs[0]), "+v"(rs[1]), "+v"(rs[2]), "+v"(rs[3]), "+v"(rs[4]), "+v"(rs[5]), "+v"(rs[6]), "+v"(rs[7]));
        asm volatile("" : "+v"(pv[0][0]), "+v"(pv[0][1]), "+v"(pv[1][0]), "+v"(pv[1][1]));
#pragma unroll
        for (int e = 0; e < 8; ++e) { const int ai = e >> 2, m = e & 3; const int row = row0 + ai * HALF + m * 16;
            f32x4 v[2][2];
#pragma unroll
            for (int bj = 0; bj < 2; ++bj)
#pragma unroll
                for (int n = 0; n < 2; ++n) v[bj][n] = acc[ai][bj][m][n] * rs[e];
            if (mode == 1) { float ss = 0.f;
#pragma unroll
                for (int bj = 0; bj < 2; ++bj)
#pragma unroll
                    for (int n = 0; n < 2; ++n) ss += (v[bj][n][0] * v[bj][n][0] + v[bj][n][1] * v[bj][n][1]) + (v[bj][n][2] * v[bj][n][2] + v[bj][n][3] * v[bj][n][3]);
                ss += __shfl_xor(ss, 16); ss += __shfl_xor(ss, 32);
                const float rr = qs * __builtin_amdgcn_rsqf(ss * (1.f / 64.f) + EPS);
#pragma unroll
                for (int bj = 0; bj < 2; ++bj)
#pragma unroll
                    for (int n = 0; n < 2; ++n) v[bj][n] = v[bj][n] * rr * pv[bj][n];
                if (rope) {
                    f32x4 p0, p1;
#pragma unroll
                    for (int j = 0; j < 4; ++j) { p0[j] = __shfl_xor(v[0][0][j], 16); p1[j] = __shfl_xor(v[0][1][j], 16); }
                    if (fq < 2) { const float* tb = TAB + (size_t)row * 16; const f32x4 c0 = *(const f32x4*)tb, c1 = *(const f32x4*)(tb + 4), s0 = *(const f32x4*)(tb + 8), s1 = *(const f32x4*)(tb + 12);
                        const float sg = fq == 0 ? -1.f : 1.f; v[0][0] = v[0][0] * c0 + sg * (p0 * s0); v[0][1] = v[0][1] * c1 + sg * (p1 * s1); } } }
            else if (mode == 2) {
#pragma unroll
                for (int bj = 0; bj < 2; ++bj)
#pragma unroll
                    for (int n = 0; n < 2; ++n)
#pragma unroll
                        for (int j = 0; j < 4; ++j) v[bj][n][j] = v[bj][n][j] + pv[bj][n][j]; }
            bf16_t* rowp = base + (size_t)row * ld + coloff;
#pragma unroll
            for (int bj = 0; bj < 2; ++bj) { v4u w; w.x = pk2(v[bj][0][0], v[bj][0][1]); w.y = pk2(v[bj][0][2], v[bj][0][3]); w.z = pk2(v[bj][1][0], v[bj][1][1]); w.w = pk2(v[bj][1][2], v[bj][1][3]);
                if (!(fl & 1)) *(v4u*)(rowp + 32 * bj) = w; else asm volatile("" :: "v"(w)); } }
    }
};
struct EpiRes {
    static constexpr int BMODE = 0, AMODE = 0;
    const float* base; float* out; int ldc;
    __device__ __forceinline__ void operator()(const f32x4 (&acc)[2][2][4][2], const Unit& u, int wr, int wc, int fr, int fq) const {
        const int row0 = u.pm * BM + wr * 64 + fr, col0 = u.pn * BM + wc * 32 + 4 * fq;
#pragma unroll
        for (int ai = 0; ai < 2; ++ai) { f32x4 b[4][2][2];
#pragma unroll
            for (int m = 0; m < 4; ++m)
#pragma unroll
                for (int bj = 0; bj < 2; ++bj)
#pragma unroll
                    for (int n = 0; n < 2; ++n) b[m][bj][n] = *(const f32x4*)(base + (size_t)(row0 + ai * HALF + m * 16) * ldc + col0 + bj * HALF + n * 16);
#pragma unroll
            for (int m = 0; m < 4; ++m) asm volatile("" : "+v"(b[m][0][0]), "+v"(b[m][0][1]), "+v"(b[m][1][0]), "+v"(b[m][1][1]));
#pragma unroll
            for (int m = 0; m < 4; ++m)
#pragma unroll
                for (int bj = 0; bj < 2; ++bj)
#pragma unroll
                    for (int n = 0; n < 2; ++n) *(f32x4*)(out + (size_t)(row0 + ai * HALF + m * 16) * ldc + col0 + bj * HALF + n * 16) = b[m][bj][n] + acc[ai][bj][m][n];
            asm volatile("" ::: "memory"); }
    }
};
struct EpiOut2 {
    static constexpr int BMODE = 1, AMODE = 0;
    const bf16_t* base; float* out;
    __device__ __forceinline__ void operator()(const f32x4 (&acc)[2][2][4][2], const Unit& u, int wr, int wc, int fr, int fq) const {
        const int row0 = u.pm * BM + wr * 64 + fr, col0 = u.pn * BM + wc * 32 + 8 * fq;
#pragma unroll
        for (int ai = 0; ai < 2; ++ai) { v4u b[4][2];
#pragma unroll
            for (int m = 0; m < 4; ++m)
#pragma unroll
                for (int bj = 0; bj < 2; ++bj) b[m][bj] = *(const v4u*)(base + (size_t)(row0 + ai * HALF + m * 16) * DM + col0 + bj * HALF);
            asm volatile("" : "+v"(b[0][0]), "+v"(b[0][1]), "+v"(b[1][0]), "+v"(b[1][1]), "+v"(b[2][0]), "+v"(b[2][1]), "+v"(b[3][0]), "+v"(b[3][1]));
#pragma unroll
            for (int m = 0; m < 4; ++m)
#pragma unroll
                for (int bj = 0; bj < 2; ++bj) { float f[8]; unpack8(b[m][bj], f); float* op = out + (size_t)(row0 + ai * HALF + m * 16) * DM + col0 + bj * HALF;
                    const f32x4 a0 = acc[ai][bj][m][0], a1 = acc[ai][bj][m][1];
                    *(f32x4*)op = (f32x4){f[0] + a0[0], f[1] + a0[1], f[2] + a0[2], f[3] + a0[3]}; *(f32x4*)(op + 4) = (f32x4){f[4] + a1[0], f[5] + a1[1], f[6] + a1[2], f[7] + a1[3]}; }
            asm volatile("" ::: "memory"); }
    }
};
struct EpiMix {
    static constexpr int BMODE = 1, AMODE = 0;
    const bf16_t* G; const bf16_t* BO; bf16_t* MIX;
    __device__ __forceinline__ void operator()(const f32x4 (&acc)[2][2][4][2], const Unit& u, int wr, int wc, int fr, int fq) const {
        const int row0 = u.pm * BM + wr * 64 + fr, col0 = u.pn * BM + wc * 32 + 8 * fq;
#pragma unroll
        for (int ai = 0; ai < 2; ++ai)
#pragma unroll
            for (int mh = 0; mh < 2; ++mh) { v4u gp[2][2], ga[2][2], bo[2][2];
#pragma unroll
                for (int mm = 0; mm < 2; ++mm)
#pragma unroll
                    for (int bj = 0; bj < 2; ++bj) { const size_t row = (size_t)(row0 + ai * HALF + (2 * mh + mm) * 16); const int c = col0 + bj * HALF;
                        gp[mm][bj] = *(const v4u*)(G + row * (2 * DM) + c); ga[mm][bj] = *(const v4u*)(G + row * (2 * DM) + DM + c); bo[mm][bj] = *(const v4u*)(BO + row * DM + c); }
                asm volatile("" : "+v"(gp[0][0]), "+v"(gp[0][1]), "+v"(gp[1][0]), "+v"(gp[1][1]), "+v"(ga[0][0]), "+v"(ga[0][1]), "+v"(ga[1][0]), "+v"(ga[1][1]));
                asm volatile("" : "+v"(bo[0][0]), "+v"(bo[0][1]), "+v"(bo[1][0]), "+v"(bo[1][1]));
#pragma unroll
                for (int mm = 0; mm < 2; ++mm)
#pragma unroll
                    for (int bj = 0; bj < 2; ++bj) { const int m = 2 * mh + mm; const size_t row = (size_t)(row0 + ai * HALF + m * 16); const int c = col0 + bj * HALF;
                        float p[8], a[8], b[8], o[8]; unpack8(gp[mm][bj], p); unpack8(ga[mm][bj], a); unpack8(bo[mm][bj], b);
                        const f32x4 a0 = acc[ai][bj][m][0], a1 = acc[ai][bj][m][1];
#pragma unroll
                        for (int j = 0; j < 4; ++j) { o[j] = sigmoidf_(p[j]) * a0[j] + sigmoidf_(a[j]) * b[j]; o[4 + j] = sigmoidf_(p[4 + j]) * a1[j] + sigmoidf_(a[4 + j]) * b[4 + j]; }
                        *(v4u*)(MIX + row * DM + c) = pack8(o); }
                asm volatile("" ::: "memory"); }
    }
};
struct EpiOut1 {
    static constexpr int BMODE = 1, AMODE = 0;
    const float* x; float* out; bf16_t* X1B; float* SSQ;
    __device__ __forceinline__ void operator()(const f32x4 (&acc)[2][2][4][2], const Unit& u, int wr, int wc, int fr, int fq) const {
        const int row0 = u.pm * BM + wr * 64 + fr, col0 = u.pn * BM + wc * 32 + 8 * fq;
#pragma unroll
        for (int ai = 0; ai < 2; ++ai) { f32x4 xv[4][2][2];
#pragma unroll
            for (int m = 0; m < 4; ++m)
#pragma unroll
                for (int bj = 0; bj < 2; ++bj) { const size_t off = (size_t)(row0 + ai * HALF + m * 16) * DM + col0 + bj * HALF; xv[m][bj][0] = *(const f32x4*)(x + off); xv[m][bj][1] = *(const f32x4*)(x + off + 4); }
#pragma unroll
            for (int m = 0; m < 4; ++m) asm volatile("" : "+v"(xv[m][0][0]), "+v"(xv[m][0][1]), "+v"(xv[m][1][0]), "+v"(xv[m][1][1]));
#pragma unroll
            for (int m = 0; m < 4; ++m) { const size_t row = (size_t)(row0 + ai * HALF + m * 16); float ss = 0.f;
#pragma unroll
                for (int bj = 0; bj < 2; ++bj) { const size_t off = row * DM + col0 + bj * HALF;
                    const f32x4 v0 = xv[m][bj][0] + acc[ai][bj][m][0], v1 = xv[m][bj][1] + acc[ai][bj][m][1];
                    ss += (v0[0] * v0[0] + v0[1] * v0[1]) + (v0[2] * v0[2] + v0[3] * v0[3]) + (v1[0] * v1[0] + v1[1] * v1[1]) + (v1[2] * v1[2] + v1[3] * v1[3]);
                    v4u w; w.x = pk2(v0[0], v0[1]); w.y = pk2(v0[2], v0[3]); w.z = pk2(v1[0], v1[1]); w.w = pk2(v1[2], v1[3]);
                    *(v4u*)(X1B + off) = w; }
                ss += __shfl_xor(ss, 16); ss += __shfl_xor(ss, 32);
                if (fq == 0) SSQ[row * 16 + u.pn * 4 + wc] = ss; }
            asm volatile("" ::: "memory"); }
    }
};
__device__ __forceinline__ float dpp_shr1(float v) { return __int_as_float(__builtin_amdgcn_update_dpp(0, __float_as_int(v), 0x111, 0xf, 0xf, true)); }
__device__ __forceinline__ f32x4 dpp_shr1(f32x4 v) { f32x4 r; r[0] = dpp_shr1(v[0]); r[1] = dpp_shr1(v[1]); r[2] = dpp_shr1(v[2]); r[3] = dpp_shr1(v[3]); return r; }
struct EpiConv {
    static constexpr int BMODE = 1, AMODE = 1;
    const float* ssq; const float* cw; const float* cb; bf16_t* HACT; float* Y01; float* HALO; int fl;
    __device__ __forceinline__ void operator()(f32x4 (&acc)[2][2][4][2], const Unit& u, int wr, int wc, int fr, int fq) const {
        if (fl & 2) return;
#define AE(e, bj, n) acc[(e) >> 2][bj][(e) & 3][n]
        const int trow0 = u.pm * BM + 128 * wr + 8 * fr, q = u.pm * 2 + wr, colg = u.pn * 128 + wc * 32 + 8 * fq;
        f32x4 sp[8], cwv[4][4];
#pragma unroll
        for (int e = 0; e < 8; ++e) sp[e] = *(const f32x4*)(ssq + (size_t)(trow0 + e) * 16 + 4 * fq);
#define LDCW(it) do { const int c = ((it) >> 1) * DFF + colg + 4 * ((it) & 1); cwv[it][0] = *(const f32x4*)(cw + c); cwv[it][1] = *(const f32x4*)(cw + NUP + c); cwv[it][2] = *(const f32x4*)(cw + 2 * NUP + c); cwv[it][3] = *(const f32x4*)(cb + c); } while (0)
        LDCW(0);
        asm volatile("" : "+v"(sp[0]), "+v"(sp[1]), "+v"(sp[2]), "+v"(sp[3]), "+v"(sp[4]), "+v"(sp[5]), "+v"(sp[6]), "+v"(sp[7]));
#pragma unroll
        for (int e = 0; e < 8; ++e) { float t = (sp[e].x + sp[e].y) + (sp[e].z + sp[e].w); t += __shfl_xor(t, 16); t += __shfl_xor(t, 32);
            const float r2 = __builtin_amdgcn_rsqf(t * (1.f / 1024.f) + EPS);
#pragma unroll
            for (int bj = 0; bj < 2; ++bj) { AE(e, bj, 0) *= r2; AE(e, bj, 1) *= r2; }
            asm volatile("" : "+v"(AE(e, 0, 0)), "+v"(AE(e, 0, 1)), "+v"(AE(e, 1, 0)), "+v"(AE(e, 1, 1))); }
        if (fr == 15) {
#pragma unroll
            for (int e = 6; e < 8; ++e)
#pragma unroll
                for (int bj = 0; bj < 2; ++bj) { float* hp = HALO + ((size_t)(q * 2 + (e - 6)) * NUP + bj * DFF + colg); *(f32x4*)hp = AE(e, bj, 0); *(f32x4*)(hp + 4) = AE(e, bj, 1); } }
#pragma unroll
        for (int it = 0; it < 4; ++it) { const int bj = it >> 1, n = it & 1;
            asm volatile("" ::: "memory");
            if (it < 3) LDCW(it + 1);
            asm volatile("" : "+v"(cwv[it][0]), "+v"(cwv[it][1]), "+v"(cwv[it][2]), "+v"(cwv[it][3]));
            const f32x4 w0 = cwv[it][0], w1 = cwv[it][1], w2 = cwv[it][2], bb = cwv[it][3];
            const f32x4 p6 = dpp_shr1(AE(6, bj, n)), p7 = dpp_shr1(AE(7, bj, n));
#pragma unroll
            for (int e = 7; e >= 2; --e) AE(e, bj, n) = w2 * AE(e, bj, n) + (w1 * AE(e - 1, bj, n) + (w0 * AE(e - 2, bj, n) + bb));
            AE(1, bj, n) = w2 * AE(1, bj, n) + (w1 * AE(0, bj, n) + (w0 * p7 + bb));
            AE(0, bj, n) = w2 * AE(0, bj, n) + (w1 * p7 + (w0 * p6 + bb));
            asm volatile("" : "+v"(AE(0, bj, n)), "+v"(AE(1, bj, n)), "+v"(AE(2, bj, n)), "+v"(AE(3, bj, n)), "+v"(AE(4, bj, n)), "+v"(AE(5, bj, n)), "+v"(AE(6, bj, n)), "+v"(AE(7, bj, n))); }
#undef LDCW
        if (fr == 0) {
#pragma unroll
            for (int e = 0; e < 2; ++e)
#pragma unroll
                for (int bj = 0; bj < 2; ++bj) { float* yp = Y01 + ((size_t)(q * 2 + e) * NUP + bj * DFF + colg); *(f32x4*)yp = AE(e, bj, 0); *(f32x4*)(yp + 4) = AE(e, bj, 1); } }
#pragma unroll
        for (int e = 0; e < 8; ++e) { const f32x4 g0 = AE(e, 0, 0), g1 = AE(e, 0, 1), v0 = AE(e, 1, 0), v1 = AE(e, 1, 1); float o[8];
#pragma unroll
            for (int j = 0; j < 4; ++j) { o[j] = g0[j] * sigmoidf_(g0[j]) * v0[j]; o[4 + j] = g1[j] * sigmoidf_(g1[j]) * v1[j]; }
            const v4u pw = pack8(o); if (!(fl & 1)) *(v4u*)(HACT + (size_t)(trow0 + e) * DFF + colg) = pw; else asm volatile("" :: "v"(pw)); asm volatile("" ::: "memory"); }
#undef AE
    }
};
}

constexpr int NWAVES = 8, NTHR = NWAVES * 64;
constexpr int N_PHASES = 13;
constexpr size_t MiB = 1u << 20;
constexpr size_t WS_CTL = 0, CTL_ZERO_BYTES = 1 * MiB;
constexpr size_t WS_R1 = 1 * MiB;
constexpr size_t WS_SSQ = 498 * MiB;
constexpr size_t WS_TAB = 2 * MiB;
constexpr size_t WS_WIN = 4 * MiB, WS_WP = 13 * MiB, WS_WO = 14 * MiB, WS_WU = 16 * MiB, WS_WD = 28 * MiB;
constexpr size_t WS_XB = 34 * MiB;
constexpr size_t WS_Z = 98 * MiB;
constexpr size_t WS_Y01 = WS_Z, WS_HALO = WS_Z + 16 * MiB, WS_HACT = WS_Z + 176 * MiB;
constexpr size_t WS_B = 370 * MiB;
constexpr size_t WS_AP = 434 * MiB;
constexpr size_t WS_END = 500 * MiB;
static_assert(WS_WIN + (size_t)NIN * DM * 2 <= WS_WP && WS_WU + (size_t)NUP * DM * 2 <= WS_WD && WS_WD + (size_t)DM * DFF * 2 <= WS_XB, "weights map");
static_assert(WS_Z + (size_t)M * NIN * 2 <= WS_B && WS_HACT + (size_t)M * DFF * 2 <= WS_SSQ && WS_AP + (size_t)M * DM * 2 <= WS_SSQ, "activation map");
constexpr int CW_BAR = 4096;
constexpr int RING_BYTES = 131072, LDSCTL_OFF = RING_BYTES, MISC_OFF = LDSCTL_OFF + 320, LDS_BYTES = 147456;

#define XB_TMO      128
#define XB_XCNT(j)  (256  + 64 * (j))
#define XB_XSUB(j)  (1280 + 64 * (j))
#define XB_XGEN(j)  (2304 + 64 * (j))
#define XB_TOP      3328
#define XB_TOPGEN   3392
#define XCD_BAR_WORDS 3456
#define XB_SPIN_CAP (1u << 18)
__device__ __forceinline__ unsigned xb_ld(unsigned* p)              { return __hip_atomic_load(p, __ATOMIC_RELAXED, __HIP_MEMORY_SCOPE_AGENT); }
__device__ __forceinline__ unsigned xb_add(unsigned* p, unsigned v) { return __hip_atomic_fetch_add(p, v, __ATOMIC_RELAXED, __HIP_MEMORY_SCOPE_AGENT); }
__device__ __forceinline__ unsigned xb_xcc_id() { return (unsigned)__builtin_amdgcn_s_getreg((3 << 11) | 20) & 0xFu; }
#define XB_SPIN(cond, bar) do { unsigned _sp = 0; while (cond) { __builtin_amdgcn_s_sleep(1); \
    if ((++_sp & 255u) == 0u) { if (xb_ld(&(bar)[XB_TMO])) break; if (_sp > XB_SPIN_CAP) { atomicAdd(&(bar)[XB_TMO], 1u); break; } } } } while (0)
struct XcdBarrier { unsigned* bar; unsigned x; volatile LAS unsigned* st; };
__device__ __forceinline__ XcdBarrier xcd_barrier_post(unsigned* bar, volatile LAS unsigned* st) {
    XcdBarrier b; b.bar = bar; b.x = xb_xcc_id(); b.st = st;
    if (threadIdx.x == 0) (void)xb_add(&bar[XB_XCNT(b.x)], 1u);
    return b;
}
__device__ __forceinline__ void xcd_barrier_complete(unsigned* bar, unsigned x, unsigned& nloc, unsigned& nx) {
    const unsigned G = gridDim.x * gridDim.y * gridDim.z;
    unsigned sum, cnt, mine, sp = 0u;
    for (;;) {
        sum = 0u; cnt = 0u; mine = 0u;
#pragma unroll
        for (unsigned j = 0; j < 16; ++j) { const unsigned c = xb_ld(&bar[XB_XCNT(j)]); sum += c; cnt += (c > 0u) ? 1u : 0u; mine = (j == x) ? c : mine; }
        if (sum == G) break;
        __builtin_amdgcn_s_sleep(1);
        if ((++sp & 255u) == 0u) { if (xb_ld(&bar[XB_TMO])) break; if (sp > XB_SPIN_CAP) { atomicAdd(&bar[XB_TMO], 1u); break; } }
    }
    nloc = mine > 0u ? mine : 1u; nx = cnt > 0u ? cnt : 1u;
}
__device__ __forceinline__ void xcd_barrier(const XcdBarrier& b) {
    asm volatile("s_waitcnt vmcnt(0)" ::: "memory");
    __syncthreads();
    if (threadIdx.x == 0) {
        unsigned* bar = b.bar;
        __builtin_amdgcn_s_waitcnt(0);
        unsigned nloc = b.st[0], nx = b.st[1];
        if (nloc == 0u) { xcd_barrier_complete(bar, b.x, nloc, nx); b.st[0] = nloc; b.st[1] = nx; }
        const unsigned old = xb_add(&bar[XB_XSUB(b.x)], 1u);
        const unsigned gen = old / nloc;
        if (old + 1u == (gen + 1u) * nloc) {
            __builtin_amdgcn_fence(__ATOMIC_RELEASE, "agent");
            asm volatile("s_waitcnt vmcnt(0)" ::: "memory");
            const unsigned og = xb_add(&bar[XB_TOP], 1u);
            const unsigned tg = og / nx;
            if (og + 1u == (tg + 1u) * nx) xb_add(&bar[XB_TOPGEN], 1u);
            else XB_SPIN(xb_ld(&bar[XB_TOPGEN]) == tg, bar);
            __builtin_amdgcn_fence(__ATOMIC_ACQUIRE, "agent");
            xb_add(&bar[XB_XGEN(b.x)], 1u);
            asm volatile("s_waitcnt vmcnt(0)" ::: "memory");
        } else {
            XB_SPIN(xb_ld(&bar[XB_XGEN(b.x)]) == gen, bar);
            __builtin_amdgcn_fence(__ATOMIC_ACQUIRE, "agent");
            asm volatile("s_waitcnt vmcnt(0)" ::: "memory");
        }
    }
    __syncthreads();
}

struct Frame {
    LAS unsigned char* lds; volatile LAS unsigned* MISC; gu32* ctl;
    int tid, lane, wave, vcu, G;
};
__device__ __forceinline__ float wave_sum(float v) {
#pragma unroll
    for (int o = 1; o < 64; o <<= 1) v += __shfl_xor(v, o);
    return v;
}

__device__ __forceinline__ void p0_transpose_item(const float* W, int K, int N, bf16_t* WT, const float* kscale, const float* nscale, LAS float* scr, int item, int lane) {
    const int nblk = N / 32, kb = item / nblk, nb = item % nblk, k0 = 64 * kb, n0 = 32 * nb;
    const float ns = nscale ? nscale[n0 + (lane & 31)] : 1.f;
    float wv[32];
#pragma unroll
    for (int i = 0; i < 32; ++i) wv[i] = W[(size_t)(k0 + 2 * i + (lane >> 5)) * N + n0 + (lane & 31)];
#pragma unroll
    for (int i = 0; i < 32; i += 8) asm volatile("" : "+v"(wv[i]), "+v"(wv[i + 1]), "+v"(wv[i + 2]), "+v"(wv[i + 3]), "+v"(wv[i + 4]), "+v"(wv[i + 5]), "+v"(wv[i + 6]), "+v"(wv[i + 7]));
#pragma unroll
    for (int i = 0; i < 32; ++i) { const int kk = 2 * i + (lane >> 5); const float ks = kscale ? kscale[k0 + kk] : 1.f; scr[kk * 33 + (lane & 31)] = wv[i] * ks * ns; }
    LDS_WAIT(); asm volatile("" ::: "memory");
    const int c = lane & 7;
#pragma unroll
    for (int j = 0; j < 4; ++j) { const int n = (lane >> 3) + 8 * j; const LAS float* s = scr + (8 * c) * 33 + n;
        v4u o; o.x = pk2(s[0 * 33], s[1 * 33]); o.y = pk2(s[2 * 33], s[3 * 33]); o.z = pk2(s[4 * 33], s[5 * 33]); o.w = pk2(s[6 * 33], s[7 * 33]);
        *(GAS v4u*)(WT + (size_t)(n0 + n) * K + k0 + 8 * c) = o; }
    LDS_WAIT(); asm volatile("" ::: "memory");
}
__device__ __forceinline__ void row_bf16_rs(int lane, const float* xrow, bf16_t* orow, float* rs) {
    const GAS f32x4* xr = (const GAS f32x4*)xrow + lane;
    f32x4 v[4]; float s = 0.f;
#pragma unroll
    for (int j = 0; j < 4; ++j) { v[j] = xr[64 * j]; s += (v[j].x * v[j].x + v[j].y * v[j].y) + (v[j].z * v[j].z + v[j].w * v[j].w); }
    s = wave_sum(s);
    if (lane == 0) *rs = __builtin_amdgcn_rsqf(s * (1.f / DM) + EPS);
    GAS unsigned long long* o8 = (GAS unsigned long long*)orow + lane;
#pragma unroll
    for (int j = 0; j < 4; ++j) o8[64 * j] = (unsigned long long)pk2(v[j].x, v[j].y) | ((unsigned long long)pk2(v[j].z, v[j].w) << 32);
}

typedef float f32x16 __attribute__((ext_vector_type(16)));
typedef short s16x4 __attribute__((ext_vector_type(4)));
constexpr int AT_KP = 72, AT_VP = 260;
constexpr int AT_K_OFF = 0, AT_V_OFF = 256 * AT_KP * 2, AT_W_OFF = 71680, AT_W_BYTES = 4608;
static_assert(AT_V_OFF + 64 * AT_VP * 2 <= AT_W_OFF && AT_W_OFF + 8 * AT_W_BYTES <= RING_BYTES, "attention LDS map");
__device__ __forceinline__ int crow16(int r, int hi) { return (r & 3) + 8 * (r >> 2) + 4 * hi; }
__device__ __forceinline__ void attn_chunk(int c, int nblk, int lane, bf16x8 q0, bf16x8 q1, bf16x8 q2, bf16x8 q3, f32x4 t0, f32x4 t1, f32x4 t2, f32x4 t3, float sinkv,
                                           const LAS bf16_t* Ks, const LAS bf16_t* Vt, LAS bf16_t* stg, LAS float* wsf, bf16_t* orow  ) {
    const int r32 = lane & 31, hi = lane >> 5; const float NEG = -INFINITY;
    {
        const v4u w = __builtin_bit_cast(v4u, q0); v4u pr; pr.x = __shfl_xor(w.x, 32); pr.y = __shfl_xor(w.y, 32); pr.z = __shfl_xor(w.z, 32); pr.w = __shfl_xor(w.w, 32);
        float a[8], p[8], o[8]; unpack8(w, a); unpack8(pr, p); const float sg = hi == 0 ? -1.f : 1.f;
#pragma unroll
        for (int j = 0; j < 4; ++j) { o[j] = a[j] * t0[j] + sg * p[j] * t2[j]; o[4 + j] = a[4 + j] * t1[j] + sg * p[4 + j] * t3[j]; }
        q0 = __builtin_bit_cast(bf16x8, pack8(o)); }
    f32x16 S[5];
#pragma unroll
    for (int t = 0; t < 5; ++t) {
#pragma unroll
        for (int r = 0; r < 16; ++r) S[t][r] = 0.f;
        const LAS bf16_t* kp = Ks + ((c + t) * 32 + r32) * AT_KP + 8 * hi;
        S[t] = __builtin_amdgcn_mfma_f32_32x32x16_bf16(*(const LAS bf16x8*)(kp), q0, S[t], 0, 0, 0);
        S[t] = __builtin_amdgcn_mfma_f32_32x32x16_bf16(*(const LAS bf16x8*)(kp + 16), q1, S[t], 0, 0, 0);
        S[t] = __builtin_amdgcn_mfma_f32_32x32x16_bf16(*(const LAS bf16x8*)(kp + 32), q2, S[t], 0, 0, 0);
        S[t] = __builtin_amdgcn_mfma_f32_32x32x16_bf16(*(const LAS bf16x8*)(kp + 48), q3, S[t], 0, 0, 0);
    }
#pragma unroll
    for (int r = 0; r < 16; ++r) { const int jj = crow16(r, hi); if (!(jj > r32)) S[0][r] = NEG; if (!(jj <= r32)) S[4][r] = NEG; }
#pragma unroll
    for (int t = 0; t < 5; ++t) { if (nblk == 0 && c + t < 4) {
#pragma unroll
        for (int r = 0; r < 16; ++r) S[t][r] = NEG; } }
    float mx = NEG;
#pragma unroll
    for (int t = 0; t < 5; ++t)
#pragma unroll
        for (int r = 0; r < 16; ++r) mx = fmaxf(mx, S[t][r]);
    mx = fmaxf(mx, __shfl_xor(mx, 32)); mx = fmaxf(mx, sinkv);
    float l = 0.f;
#pragma unroll
    for (int t = 0; t < 5; ++t)
#pragma unroll
        for (int r = 0; r < 16; ++r) { const float p = __builtin_amdgcn_exp2f(S[t][r] - mx); S[t][r] = p; l += p; }
    l += __shfl_xor(l, 32); l += __builtin_amdgcn_exp2f(sinkv - mx);
    f32x16 O[2];
#pragma unroll
    for (int r = 0; r < 16; ++r) { O[0][r] = 0.f; O[1][r] = 0.f; }
#pragma unroll
    for (int t = 0; t < 5; ++t)
#pragma unroll
        for (int s = 0; s < 2; ++s) {
            v4u pw; pw.x = pk2(S[t][8 * s + 0], S[t][8 * s + 1]); pw.y = pk2(S[t][8 * s + 2], S[t][8 * s + 3]); pw.z = pk2(S[t][8 * s + 4], S[t][8 * s + 5]); pw.w = pk2(S[t][8 * s + 6], S[t][8 * s + 7]);
            const bf16x8 xs = __builtin_bit_cast(bf16x8, pw);
#pragma unroll
            for (int d0 = 0; d0 < 2; ++d0) { const LAS bf16_t* vp = Vt + (32 * d0 + r32) * AT_VP + (c + t) * 32 + 16 * s + 4 * hi;
                const s16x4 lo = *(const LAS s16x4*)vp, hh = *(const LAS s16x4*)(vp + 8);
                const bf16x8 vf = __builtin_shufflevector(lo, hh, 0, 1, 2, 3, 4, 5, 6, 7);
                O[d0] = __builtin_amdgcn_mfma_f32_32x32x16_bf16(xs, vf, O[d0], 0, 0, 0); }
        }
    asm volatile("s_waitcnt lgkmcnt(0)" ::: "memory");
    if (hi == 0) wsf[r32] = 1.f / l;
    asm volatile("s_waitcnt lgkmcnt(0)" ::: "memory");
#pragma unroll
    for (int r = 0; r < 16; ++r) { const int qi = crow16(r, hi); const float inv = wsf[qi];
        stg[qi * 64 + r32] = (bf16_t)f2bf(O[0][r] * inv); stg[qi * 64 + 32 + r32] = (bf16_t)f2bf(O[1][r] * inv); }
    asm volatile("s_waitcnt lgkmcnt(0)" ::: "memory");
#pragma unroll
    for (int i = 0; i < 4; ++i) { const int row = i * 8 + (lane >> 3), ch = lane & 7; const v4u v = *(const LAS v4u*)(stg + row * 64 + ch * 8);
        *(v4u*)(orow + (size_t)row * DM + 8 * ch) = v; }
    asm volatile("s_waitcnt lgkmcnt(0)" ::: "memory");
}
__device__ __forceinline__ void attn_phase(Frame& F, const bf16_t* Q, int ldq, const bf16_t* K, int ldk, const bf16_t* V, int ldv, const float* TAB, const float* sinks, bf16_t* BO) {
    LAS bf16_t* Ks = (LAS bf16_t*)(F.lds + AT_K_OFF); LAS bf16_t* Vt = (LAS bf16_t*)(F.lds + AT_V_OFF);
    LAS bf16_t* stg = (LAS bf16_t*)(F.lds + AT_W_OFF + F.wave * AT_W_BYTES); LAS float* wsf = (LAS float*)(F.lds + AT_W_OFF + F.wave * AT_W_BYTES + 4096);
    const int lane = F.lane, r32 = lane & 31, hi = lane >> 5;
    constexpr int NU = NBATCH * 32 * 2;
    v4u kvr[4], vvr[4];
#define AT_LOAD_KV(un) do { const int kvh_ = (un) & 1, b_ = (un) >> 6; const long row0_ = (long)b_ * SEQ + (long)(((un) >> 1) & 31) * 128; \
        _Pragma("unroll") for (int i = 0; i < 4; ++i) { const int c_ = F.tid + i * NTHR, r_ = c_ >> 3, ch_ = c_ & 7; const long grow_ = row0_ - 128 + r_; kvr[i] = (v4u){0u, 0u, 0u, 0u}; vvr[i] = (v4u){0u, 0u, 0u, 0u}; \
            if (grow_ >= (long)b_ * SEQ) { kvr[i] = *(const v4u*)(K + (size_t)grow_ * ldk + 64 * kvh_ + 8 * ch_); vvr[i] = *(const v4u*)(V + (size_t)grow_ * ldv + 64 * kvh_ + 8 * ch_); } } } while (0)
#define AT_LOAD_Q(c, qq, tt) do { const size_t qrow_ = (size_t)(row0 + 32 * (c) + r32); const bf16_t* qp_ = Q + qrow_ * ldq + 64 * head + 8 * hi; const float* tb_ = TAB + qrow_ * 16; \
        qq[0] = *(const bf16x8*)qp_; qq[1] = *(const bf16x8*)(qp_ + 16); qq[2] = *(const bf16x8*)(qp_ + 32); qq[3] = *(const bf16x8*)(qp_ + 48); \
        tt[0] = *(const f32x4*)tb_; tt[1] = *(const f32x4*)(tb_ + 4); tt[2] = *(const f32x4*)(tb_ + 8); tt[3] = *(const f32x4*)(tb_ + 12); } while (0)
    int unit = F.vcu;
    if (unit < NU) AT_LOAD_KV(unit);
    while (unit < NU) {
        const int kvh = unit & 1, nblk = (unit >> 1) & 31, b = unit >> 6;
        const long row0 = (long)b * SEQ + (long)nblk * 128;
        const int head = kvh * 8 + F.wave;
        const float sinkv = sinks[head] * LOG2E;
        bf16x8 qa[4], qb[4]; f32x4 ta[4], tb[4];
        AT_LOAD_Q(0, qa, ta);
        __syncthreads();
#pragma unroll
        for (int i = 0; i < 4; ++i) { const int c = F.tid + i * NTHR, r = c >> 3, ch = c & 7;
            *(LAS v4u*)(Ks + r * AT_KP + 8 * ch) = kvr[i];
            LAS bf16_t* vp = Vt + (8 * ch) * AT_VP + r; const v4u vv = vvr[i];
            vp[0 * AT_VP] = (bf16_t)(vv.x & 0xffffu); vp[1 * AT_VP] = (bf16_t)(vv.x >> 16); vp[2 * AT_VP] = (bf16_t)(vv.y & 0xffffu); vp[3 * AT_VP] = (bf16_t)(vv.y >> 16);
            vp[4 * AT_VP] = (bf16_t)(vv.z & 0xffffu); vp[5 * AT_VP] = (bf16_t)(vv.z >> 16); vp[6 * AT_VP] = (bf16_t)(vv.w & 0xffffu); vp[7 * AT_VP] = (bf16_t)(vv.w >> 16); }
        __syncthreads();
        const int next = unit + F.G;
        if (next < NU) AT_LOAD_KV(next);
        bf16_t* ob = BO + (size_t)row0 * DM + 64 * head;
        AT_LOAD_Q(1, qb, tb); attn_chunk(0, nblk, lane, qa[0], qa[1], qa[2], qa[3], ta[0], ta[1], ta[2], ta[3], sinkv, Ks, Vt, stg, wsf, ob);
        AT_LOAD_Q(2, qa, ta); attn_chunk(1, nblk, lane, qb[0], qb[1], qb[2], qb[3], tb[0], tb[1], tb[2], tb[3], sinkv, Ks, Vt, stg, wsf, ob + (size_t)32 * DM);
        AT_LOAD_Q(3, qb, tb); attn_chunk(2, nblk, lane, qa[0], qa[1], qa[2], qa[3], ta[0], ta[1], ta[2], ta[3], sinkv, Ks, Vt, stg, wsf, ob + (size_t)64 * DM);
        attn_chunk(3, nblk, lane, qb[0], qb[1], qb[2], qb[3], tb[0], tb[1], tb[2], tb[3], sinkv, Ks, Vt, stg, wsf, ob + (size_t)96 * DM);
        unit = next;
    }
#undef AT_LOAD_KV
#undef AT_LOAD_Q
    __syncthreads();
}

template <int G_> __device__ __forceinline__ void pool_prep_item(const bf16_t* U, bf16_t* P, int tb, int ch) {
    constexpr int W = 2 << G_, NR = 8 + W - 1;
    const int t0 = tb * 8, ts0 = t0 & (SEQ - 1);
    v4u rows[NR];
#pragma unroll
    for (int k = 0; k < NR; ++k) { const int tseq = ts0 - (W - 1) + k; rows[k] = (v4u){0u, 0u, 0u, 0u}; if (tseq >= 0) rows[k] = *(const v4u*)(U + (size_t)(t0 - (W - 1) + k) * DM + 8 * ch); }
    float s[8];
#pragma unroll
    for (int j = 0; j < 8; ++j) s[j] = 0.f;
#pragma unroll
    for (int k = 0; k < W; ++k) { float f[8]; unpack8(rows[k], f);
#pragma unroll
        for (int j = 0; j < 8; ++j) s[j] += f[j]; }
#pragma unroll
    for (int t = 0; t < 8; ++t) { float u[8]; unpack8(rows[t + W - 1], u);
        if (t > 0) { float o[8]; unpack8(rows[t - 1], o);
#pragma unroll
            for (int j = 0; j < 8; ++j) s[j] += u[j] - o[j]; }
        const int cnt = (ts0 + t + 1 < W) ? ts0 + t + 1 : W; const float ic = 1.f / (float)cnt; float r[8];
#pragma unroll
        for (int j = 0; j < 8; ++j) r[j] = s[j] * ic - u[j];
        *(v4u*)(P + (size_t)(t0 + t) * DM + 8 * ch) = pack8(r); }
}

__device__ __forceinline__ void rows4_bf16_rs(int lane, const float* xrow, bf16_t* orow, float* rs) {
    f32x4 v[4][4];
#pragma unroll
    for (int r = 0; r < 4; ++r)
#pragma unroll
        for (int j = 0; j < 4; ++j) v[r][j] = *((const GAS f32x4*)(xrow + (size_t)r * DM) + lane + 64 * j);
#pragma unroll
    for (int r = 0; r < 4; ++r) asm volatile("" : "+v"(v[r][0]), "+v"(v[r][1]), "+v"(v[r][2]), "+v"(v[r][3]));
#pragma unroll
    for (int r = 0; r < 4; ++r) { float s = 0.f;
#pragma unroll
        for (int j = 0; j < 4; ++j) s += (v[r][j].x * v[r][j].x + v[r][j].y * v[r][j].y) + (v[r][j].z * v[r][j].z + v[r][j].w * v[r][j].w);
        s = wave_sum(s);
        if (lane == 0) rs[r] = __builtin_amdgcn_rsqf(s * (1.f / DM) + EPS);
        GAS unsigned long long* o8 = (GAS unsigned long long*)(orow + (size_t)r * DM) + lane;
#pragma unroll
        for (int j = 0; j < 4; ++j) o8[64 * j] = (unsigned long long)pk2(v[r][j].x, v[r][j].y) | ((unsigned long long)pk2(v[r][j].z, v[r][j].w) << 32); }
}

struct Args { const void* in[16]; float* out; unsigned char* ws; double invf[8]; int ph_lo, ph_hi, li, flags; };

__global__ void __launch_bounds__(NTHR, 2) mega_fwd(Args args) {
    extern __shared__ __attribute__((aligned(16))) unsigned char lds[];
    Frame F;
    F.lds = (LAS unsigned char*)lds;
    F.MISC = (volatile LAS unsigned*)(F.lds + MISC_OFF);
    F.tid = threadIdx.x; F.lane = F.tid & 63; F.wave = __builtin_amdgcn_readfirstlane(F.tid >> 6);
    F.G = gridDim.x; { const int bx = blockIdx.x; F.vcu = (F.G % 8 == 0) ? (bx % 8) * (F.G / 8) + bx / 8 : bx; }
    unsigned char* ws = args.ws;
    F.ctl = (gu32*)(ws + WS_CTL);
    const float* x = (const float*)args.in[0]; const int* positions = (const int*)args.in[1]; const float* attn_norm = (const float*)args.in[2];
    const float* w_in = (const float*)args.in[3]; const float* b_gate = (const float*)args.in[4]; const float* w_pool = (const float*)args.in[5];
    const float* pool_scale = (const float*)args.in[6]; const float* q_norm = (const float*)args.in[7]; const float* k_norm = (const float*)args.in[8];
    const float* sinks = (const float*)args.in[9]; const float* w_out = (const float*)args.in[10]; const float* ffn_norm = (const float*)args.in[11];
    const float* w_up = (const float*)args.in[12]; const float* conv_w = (const float*)args.in[13]; const float* conv_b = (const float*)args.in[14];
    const float* w_down = (const float*)args.in[15];
    float* out = args.out;
    float* R1 = (float*)(ws + WS_R1); float* SSQ = (float*)(ws + WS_SSQ); float* TAB = (float*)(ws + WS_TAB);
    bf16_t* Win_t = (bf16_t*)(ws + WS_WIN); bf16_t* Wp_t = (bf16_t*)(ws + WS_WP); bf16_t* Wo_t = (bf16_t*)(ws + WS_WO); bf16_t* Wu_t = (bf16_t*)(ws + WS_WU); bf16_t* Wd_t = (bf16_t*)(ws + WS_WD);
    bf16_t* XB = (bf16_t*)(ws + WS_XB); bf16_t* U = (bf16_t*)(ws + WS_Z); bf16_t* QB = (bf16_t*)(ws + WS_Z + 64 * MiB); bf16_t* KB = (bf16_t*)(ws + WS_Z + 128 * MiB); bf16_t* VB = (bf16_t*)(ws + WS_Z + 136 * MiB); bf16_t* GB = (bf16_t*)(ws + WS_Z + 144 * MiB); float* Y01 = (float*)(ws + WS_Y01); float* HALO = (float*)(ws + WS_HALO); bf16_t* HACT = (bf16_t*)(ws + WS_HACT);
    bf16_t* BO = (bf16_t*)(ws + WS_B); bf16_t* AP = (bf16_t*)(ws + WS_AP);

    for (int u = F.tid; u < (LDS_BYTES - LDSCTL_OFF) / 4; u += NTHR) ((LAS unsigned*)(F.lds + LDSCTL_OFF))[u] = 0u;
    __syncthreads();
    XcdBarrier bar; bar.bar = (unsigned*)(F.ctl + CW_BAR) + args.li * XCD_BAR_WORDS; bar.x = 0; bar.st = nullptr;
    if (MK_N_LAUNCHES == 1) bar = xcd_barrier_post((unsigned*)(F.ctl + CW_BAR) + args.li * XCD_BAR_WORDS, F.MISC + 8);
#define GRID_BAR() do { if (MK_N_LAUNCHES == 1) xcd_barrier(bar); } while (0)
    const int lo = args.ph_lo, hi = args.ph_hi;
#define IN(k) (lo <= (k) && (k) < hi)
#define BOTH(k) (IN(k) && IN((k) + 1))
    const int gt = F.vcu * NTHR + F.tid, GT = F.G * NTHR;
    const int gw = F.vcu * NWAVES + F.wave, NGW = F.G * NWAVES;

    if (IN(0)) {
        LAS float* scr = (LAS float*)(F.lds + F.wave * 16384);
        constexpr int I_IN = (DM / 64) * (NIN / 32), I_P = (256 / 64) * (256 / 32), I_O = (DM / 64) * (DM / 32), I_U = (DM / 64) * (NUP / 32), I_D = (DFF / 64) * (DM / 32);
        constexpr int NITEMS = I_IN + 4 * I_P + I_O + I_U + I_D;
        for (int it = gw; it < NITEMS; it += NGW) {
            int r = it;
            if (r < I_IN) { p0_transpose_item(w_in, DM, NIN, Win_t, attn_norm, nullptr, scr, r, F.lane); continue; } r -= I_IN;
            if (r < 4 * I_P) { const int g = r / I_P; p0_transpose_item(w_pool + (size_t)g * 65536, 256, 256, Wp_t + (size_t)g * 65536, nullptr, pool_scale + 256 * g, scr, r % I_P, F.lane); continue; } r -= 4 * I_P;
            if (r < I_O) { p0_transpose_item(w_out, DM, DM, Wo_t, nullptr, nullptr, scr, r, F.lane); continue; } r -= I_O;
            if (r < I_U) { p0_transpose_item(w_up, DM, NUP, Wu_t, ffn_norm, nullptr, scr, r, F.lane); continue; } r -= I_U;
            p0_transpose_item(w_down, DFF, DM, Wd_t, nullptr, nullptr, scr, r, F.lane);
        }
        for (int m = 4 * gw; m < M; m += 4 * NGW) rows4_bf16_rs(F.lane, x + (size_t)m * DM, XB + (size_t)m * DM, R1 + m);
        for (int idx = gt; idx < M * 8; idx += GT) { const int m = idx >> 3, j = idx & 7;
            double rev = (double)positions[m] * args.invf[j]; rev -= floor(rev); const float fr = (float)rev;
            TAB[(size_t)m * 16 + j] = __builtin_amdgcn_cosf(fr); TAB[(size_t)m * 16 + 8 + j] = __builtin_amdgcn_sinf(fr); }
        if (BOTH(0)) GRID_BAR();
    }
    if (IN(1)) {
        pg8::Gemm g{DM, DM, DM, (size_t)128 * DM * 2, (size_t)32 * DM * 2};
        pg8::TileOrder S; S.init(M / 256, NIN / 256, F.G, (int)blockIdx.x, XB, Win_t, (size_t)256 * DM * 2, (size_t)256 * DM * 2, 0);
        pg8::EpiIn E{R1, q_norm, k_norm, b_gate, U, QB, KB, VB, GB, TAB, args.flags};
        pg8::gemm_phase<pg8::EpiIn, pg8::TileOrder, true>(F.lds, g, S, E);
        if (BOTH(1)) GRID_BAR();
    }
    if (IN(2)) {
        bf16_t* P = XB;
        for (int wi = gw; wi < 8192; wi += NGW) { const int g = wi >> 11, tb = 2 * (wi & 2047) + (F.lane >> 5), ch = 32 * g + (F.lane & 31);
            if (g == 0) pool_prep_item<0>(U, P, tb, ch); else if (g == 1) pool_prep_item<1>(U, P, tb, ch); else if (g == 2) pool_prep_item<2>(U, P, tb, ch); else pool_prep_item<3>(U, P, tb, ch); }
        if (!(args.flags & 4)) attn_phase(F, QB, DM, KB, 128, VB, 128, TAB, sinks, BO);
        if (BOTH(2)) GRID_BAR();
    }
    if (IN(4)) {
        pg8::Gemm g{DM, 256, 256, (size_t)128 * DM * 2, (size_t)128 * 256 * 2};
        pg8::TileOrder S; S.init(M / 256, 4, F.G, (int)blockIdx.x, XB, Wp_t, (size_t)256 * DM * 2, (size_t)256 * 256 * 2, (size_t)256 * 2);
        pg8::EpiMix E{GB, BO, AP};
        pg8::gemm_phase<pg8::EpiMix, pg8::TileOrder, true>(F.lds, g, S, E);
        if (BOTH(4)) GRID_BAR();
    }
    if (IN(6)) {
        pg8::Gemm g{DM, DM, DM, (size_t)128 * DM * 2, (size_t)128 * DM * 2};
        pg8::TileOrder S; S.init(M / 256, DM / 256, F.G, (int)blockIdx.x, AP, Wo_t, (size_t)256 * DM * 2, (size_t)256 * DM * 2, 0);
        pg8::EpiOut1 E{x, out, XB, SSQ};
        pg8::gemm_phase<pg8::EpiOut1, pg8::TileOrder, true>(F.lds, g, S, E);
        if (BOTH(6)) GRID_BAR();
    }
    if (IN(8)) {
        pg8::Gemm g{DM, DM, DM, (size_t)4 * DM * 2, (size_t)DFF * DM * 2};
        pg8::TileOrder S; S.init(M / 256, DFF / 128, F.G, (int)blockIdx.x, XB, Wu_t, (size_t)256 * DM * 2, (size_t)128 * DM * 2, 0);
        pg8::EpiConv E{SSQ, conv_w, conv_b, HACT, Y01, HALO, args.flags};
        pg8::gemm_phase<pg8::EpiConv, pg8::TileOrder, true>(F.lds, g, S, E);
        if (BOTH(8)) GRID_BAR();
    }
    if (IN(12)) {
        pg8::Gemm g{DFF, DFF, DFF, (size_t)128 * DFF * 2, (size_t)128 * DFF * 2};
        pg8::TileOrder S; S.init(M / 256, DM / 256, F.G, (int)blockIdx.x, HACT, Wd_t, (size_t)256 * DFF * 2, (size_t)256 * DFF * 2, 0);
        { pg8::Unit fu;
          for (int ui = 0; S.next(ui, fu); ++ui)
            for (int idx = F.tid; idx < 2 * (DFF / 8); idx += NTHR) { const int q = fu.pm * 2 + idx / (DFF / 8), c8 = idx % (DFF / 8);
                if ((q & 31) == 0) continue;
                float y0[16], y1[16];
#pragma unroll
                for (int h = 0; h < 2; ++h)
#pragma unroll
                    for (int v = 0; v < 2; ++v) { const int c = h * DFF + 8 * c8 + 4 * v;
                        const f32x4 a0 = *(const f32x4*)(Y01 + (size_t)(q * 2 + 0) * NUP + c), a1 = *(const f32x4*)(Y01 + (size_t)(q * 2 + 1) * NUP + c);
                        const f32x4 h6 = *(const f32x4*)(HALO + (size_t)((q - 1) * 2 + 0) * NUP + c), h7 = *(const f32x4*)(HALO + (size_t)((q - 1) * 2 + 1) * NUP + c);
                        const f32x4 w0 = *(const f32x4*)(conv_w + c), w1 = *(const f32x4*)(conv_w + NUP + c);
                        const f32x4 r0 = a0 + w1 * h7 + w0 * h6, r1 = a1 + w0 * h7;
#pragma unroll
                        for (int j = 0; j < 4; ++j) { y0[8 * h + 4 * v + j] = r0[j]; y1[8 * h + 4 * v + j] = r1[j]; } }
                float o0[8], o1[8];
#pragma unroll
                for (int j = 0; j < 8; ++j) { o0[j] = y0[j] * sigmoidf_(y0[j]) * y0[8 + j]; o1[j] = y1[j] * sigmoidf_(y1[j]) * y1[8 + j]; }
                *(v4u*)(HACT + (size_t)(q * 128 + 0) * DFF + 8 * c8) = pack8(o0); *(v4u*)(HACT + (size_t)(q * 128 + 1) * DFF + 8 * c8) = pack8(o1); }
          VM_WAIT(); __syncthreads(); }
        pg8::EpiOut2 E{XB, out};
        pg8::gemm_phase<pg8::EpiOut2, pg8::TileOrder, true>(F.lds, g, S, E);
    }
#undef IN
#undef BOTH
}

extern "C" void kernel_launch(void* const* d_in, const int* in_sizes, int n_in, void* d_out, int out_size, void* d_ws, size_t ws_size, hipStream_t stream) {
    static int grid = 0;
    if (grid == 0) {
        if (n_in != 16 || in_sizes[0] != M * DM || out_size != M * DM || ws_size < WS_END) { fprintf(stderr, "kernel_launch: unexpected shapes (n_in %d, in0 %d, out %d, ws %zu); nothing launched\n", n_in, n_in > 0 ? in_sizes[0] : -1, out_size, ws_size); grid = -1; return; }
        int dev = 0, cus = 0, per_cu = 0;
        if (hipGetDevice(&dev) != hipSuccess || hipDeviceGetAttribute(&cus, hipDeviceAttributeMultiprocessorCount, dev) != hipSuccess) { grid = -1; return; }
        if (hipFuncSetAttribute((const void*)mega_fwd, hipFuncAttributeMaxDynamicSharedMemorySize, LDS_BYTES) != hipSuccess) { fprintf(stderr, "kernel_launch: hipFuncSetAttribute failed\n"); grid = -1; return; }
        if (hipOccupancyMaxActiveBlocksPerMultiprocessor(&per_cu, (const void*)mega_fwd, NTHR, LDS_BYTES) != hipSuccess || per_cu < 1) { fprintf(stderr, "kernel_launch: occupancy query reports %d blocks per CU\n", per_cu); (void)hipGetLastError(); grid = -1; return; }
        grid = cus;
    }
    if (grid < 0) return;
    if (hipMemsetAsync((char*)d_ws + WS_CTL, 0, CTL_ZERO_BYTES, stream) != hipSuccess) return;
    Args a{};
    for (int i = 0; i < 16; ++i) a.in[i] = d_in[i];
    a.out = (float*)d_out; a.ws = (unsigned char*)d_ws;
    for (int j = 0; j < 8; ++j) a.invf[j] = std::pow(500000.0, -(double)j / 8.0) / 6.283185307179586476925;
#ifdef PROBE_PH
#define PROBE_AFTER 1
#endif
#ifdef PROBE_HI
    a.ph_lo = 0; a.ph_hi = PROBE_HI; a.li = 1; hipLaunchKernelGGL(mega_fwd, dim3(grid), dim3(NTHR), LDS_BYTES, stream, a);
#endif
    if (MK_N_LAUNCHES == 1) { a.ph_lo = 0; a.ph_hi = N_PHASES; a.li = 0; hipLaunchKernelGGL(mega_fwd, dim3(grid), dim3(NTHR), LDS_BYTES, stream, a);
#ifdef PROBE_AFTER
        a.ph_lo = PROBE_PH; a.ph_hi = PROBE_PH + 1; a.li = 1; a.flags = PROBE_FL; hipLaunchKernelGGL(mega_fwd, dim3(grid), dim3(NTHR), LDS_BYTES, stream, a);
#endif
    }
    else for (int p = 0; p < N_PHASES; ++p) { a.ph_lo = p; a.ph_hi = p + 1; a.li = p; hipLaunchKernelGGL(mega_fwd, dim3(grid), dim3(NTHR), LDS_BYTES, stream, a); }
}
```

```cpp
#include <hip/hip_runtime.h>
#include <cstdio>
#include <cstdint>
#include <cmath>

#ifndef MK_N_LAUNCHES
#define MK_N_LAUNCHES 1
#endif

constexpr int DM = 1024, NBATCH = 8, SEQ = 4096, M = NBATCH * SEQ;
constexpr int NIN = 4352, DFF = 2816, NUP = 2 * DFF;
constexpr int ZQ = 1024, ZK = 2048, ZV = 2176, ZG = 2304;
constexpr float EPS = 1e-6f, LOG2E = 1.4426950408889634f;

#define GAS __attribute__((address_space(1)))
#define LAS __attribute__((address_space(3)))
typedef unsigned short bf16_t;
typedef unsigned v4u __attribute__((ext_vector_type(4)));
typedef float f32x4 __attribute__((ext_vector_type(4)));
typedef short bf16x8 __attribute__((ext_vector_type(8)));
typedef GAS unsigned gu32;
#define RLX_AGENT __ATOMIC_RELAXED, __HIP_MEMORY_SCOPE_AGENT
#define LDS_WAIT() asm volatile("s_waitcnt lgkmcnt(0)" ::: "memory")
#define VM_WAIT() asm volatile("s_waitcnt vmcnt(0)" ::: "memory")

__device__ __forceinline__ unsigned f2bf(float f) { unsigned u = __builtin_bit_cast(unsigned, f); return (u + 0x7fffu + ((u >> 16) & 1u)) >> 16; }
typedef float f32x2_t __attribute__((ext_vector_type(2))); typedef __bf16 bf16x2_t __attribute__((ext_vector_type(2)));
__device__ __forceinline__ unsigned pk2(float lo, float hi) { f32x2_t v = {lo, hi}; bf16x2_t b = __builtin_convertvector(v, bf16x2_t); return __builtin_bit_cast(unsigned, b); }
__device__ __forceinline__ float bflo(unsigned w) { return __uint_as_float(w << 16); }
__device__ __forceinline__ float bfhi(unsigned w) { return __uint_as_float(w & 0xffff0000u); }
__device__ __forceinline__ void unpack8(const v4u w, float (&f)[8]) { f[0] = bflo(w.x); f[1] = bfhi(w.x); f[2] = bflo(w.y); f[3] = bfhi(w.y); f[4] = bflo(w.z); f[5] = bfhi(w.z); f[6] = bflo(w.w); f[7] = bfhi(w.w); }
__device__ __forceinline__ v4u pack8(const float (&f)[8]) { v4u w; w.x = pk2(f[0], f[1]); w.y = pk2(f[2], f[3]); w.z = pk2(f[4], f[5]); w.w = pk2(f[6], f[7]); return w; }
__device__ __forceinline__ float sigmoidf_(float x) { return __builtin_amdgcn_rcpf(1.f + __builtin_amdgcn_exp2f(-x * LOG2E)); }

namespace pg8 {
constexpr int BM = 256, BK = 64, HALF = 128, HTB = HALF * BK * 2, STAGE_BYTES = 8 * HTB, NXCD = 8, WGM = 8;
__host__ __device__ __forceinline__ int lds_byte(int r, int c) { const int st = (r >> 4) * 2 + (c >> 5), rr = r & 15, cc = c & 31, ob = rr * 64 + cc * 2; return st * 1024 + (ob ^ (((ob >> 9) & 1) << 5)); }
__host__ __device__ __forceinline__ void stage_rc(int b, int& R, int& C) { const int st = b / 1024, sb = b % 1024, swz = sb ^ (((sb >> 9) & 1) << 5); R = (st >> 1) * 16 + swz / 64; C = (st & 1) * 32 + (swz % 64) / 2; }
__host__ __device__ __forceinline__ int perm32(int rho) { const int n = rho >> 4, i = rho & 15; return 8 * (i >> 2) + 4 * n + (i & 3); }

struct Unit { const char* a; const char* b; int pm, pn, idx; };
struct Gemm { int lda, ldb, K; size_t hstepA, hstepB; };

struct PairOrder {
    int pm, g0; const char* A; const char* B;
    __device__ bool next(int i, Unit& u) const { if (i >= 2) return false; u.pm = pm; u.pn = g0 + i; u.idx = i; u.a = A + (size_t)pm * 256 * DM * 2 + (size_t)(g0 + i) * 512; u.b = B + (size_t)(g0 + i) * 65536 * 2; return true; }
};
struct TileOrder {
    int nM, nN, nwg, G, c; const char* A; const char* B; size_t sA, sB, sApn;
    __device__ void init(int nM_, int nN_, int G_, int c_, const void* A_, const void* B_, size_t sA_, size_t sB_, size_t sApn_) { nM = nM_; nN = nN_; nwg = nM * nN; G = G_; c = c_; A = (const char*)A_; B = (const char*)B_; sA = sA_; sB = sB_; sApn = sApn_; }
    __device__ bool next(int i, Unit& u) const {
        const long L = (long)i * G + c; if (L >= nwg) return false;
        int wgid = (int)L; { const int q = nwg / NXCD, r = nwg % NXCD, xcd = wgid % NXCD, off = wgid / NXCD; wgid = (xcd < r ? xcd * (q + 1) : r * (q + 1) + (xcd - r) * q) + off; }
        const int nig = WGM * nN, gid = wgid / nig, fm = gid * WGM, gsz = (nM - fm) < WGM ? (nM - fm) : WGM;
        u.pm = fm + ((wgid % nig) % gsz); u.pn = (wgid % nig) / gsz; u.idx = i;
        u.a = A + (size_t)u.pm * sA + (size_t)u.pn * sApn; u.b = B + (size_t)u.pn * sB; return true;
    }
};

template <int BMODE> __device__ __forceinline__ int mapB(int R) { return BMODE == 1 ? ((R & ~31) + perm32(R & 31)) : (BMODE == 2 ? (64 * (R >> 5) + perm32(R & 31)) : R); }
template <int AMODE> __device__ __forceinline__ int mapA(int R) { return AMODE == 1 ? (128 * (R >> 6) + 8 * (R & 15) + ((R >> 4) & 3)) : R; }

template <class Epi, class Sched, bool ALIGN_EPI>
__device__ __forceinline__ void gemm_phase(LAS unsigned char* lds, const Gemm g, const Sched& S, const Epi& E) {
    const int tid = threadIdx.x, wid = __builtin_amdgcn_readfirstlane(tid >> 6), lane = tid & 63, wr = wid >> 2, wc = wid & 3, fr = lane & 15, fq = lane >> 4;
    const int nt = g.K / BK;
    unsigned voffA[2], voffB[2];
#pragma unroll
    for (int i = 0; i < 2; ++i) { int R, C; stage_rc(tid * 16 + i * 8192, R, C); const int Rb = mapB<Epi::BMODE>(R);
        voffA[i] = (unsigned)(mapA<Epi::AMODE>(R) * g.lda + C) * 2u; voffB[i] = (unsigned)(Rb * g.ldb + C) * 2u; }
    const size_t kstep = (size_t)(BK * 2);
    const size_t hstepA = g.hstepA, hstepB = g.hstepB;
    const unsigned ldsw = (unsigned)wid * 1024u;
    const int aoff = lds_byte(wr * 64 + fr, fq * 8), boff = lds_byte(wc * 32 + fr, fq * 8);
#define PG8_SA(b, h) (((b) * 2 + (h)) * HTB)
#define PG8_SB(b, h) ((4 + (b) * 2 + (h)) * HTB)
#define PG8_STAGE(bufoff, gbase, voff) do { _Pragma("unroll") for (int _i = 0; _i < 2; ++_i) \
        __builtin_amdgcn_global_load_lds((const unsigned*)((const char*)(gbase) + (voff)[_i]), (LAS unsigned*)(lds + (bufoff) + ldsw + _i * 8192), 16, 0, 0); } while (0)
#define PG8_LDA(dst, b, h) do { _Pragma("unroll") for (int m = 0; m < 4; ++m) _Pragma("unroll") for (int k = 0; k < 2; ++k) dst[m][k] = *(const LAS bf16x8*)(lds + PG8_SA(b, h) + aoff + m * 2048 + k * 1024); } while (0)
#define PG8_LDB(dst, b, h) do { _Pragma("unroll") for (int n = 0; n < 2; ++n) _Pragma("unroll") for (int k = 0; k < 2; ++k) dst[n][k] = *(const LAS bf16x8*)(lds + PG8_SB(b, h) + boff + n * 2048 + k * 1024); } while (0)
#define PG8_MMA(ai, bj, At, Bt) do { __builtin_amdgcn_s_setprio(1); _Pragma("unroll") for (int m = 0; m < 4; ++m) _Pragma("unroll") for (int n = 0; n < 2; ++n) _Pragma("unroll") for (int k = 0; k < 2; ++k) \
        acc[ai][bj][m][n] = __builtin_amdgcn_mfma_f32_16x16x32_bf16(Bt[n][k], At[m][k], acc[ai][bj][m][n], 0, 0, 0); __builtin_amdgcn_s_setprio(0); } while (0)
#define PG8_WAIT_V(n) asm volatile("s_waitcnt vmcnt(" #n ")" ::: "memory")
#define PG8_WAIT_L(n) asm volatile("s_waitcnt lgkmcnt(" #n ")" ::: "memory")
#define PG8_BAR __builtin_amdgcn_s_barrier()
#define PG8_SCHED __builtin_amdgcn_sched_barrier(0)
    Unit cur, nxt; int ui = 0;
    if (!S.next(0, cur)) return;
    typename Epi::State est;
    E.prefetch(est, cur, wr, wc, fr, fq);
    f32x4 acc[2][2][4][2];
#pragma unroll
    for (int a = 0; a < 2; ++a)
#pragma unroll
        for (int b = 0; b < 2; ++b)
#pragma unroll
            for (int m = 0; m < 4; ++m)
#pragma unroll
                for (int n = 0; n < 2; ++n) acc[a][b][m][n] = (f32x4){0.f, 0.f, 0.f, 0.f};
    bf16x8 At[4][2], B0[2][2], B1[2][2];
    const char* cA = cur.a; const char* cB = cur.b;
    PG8_STAGE(PG8_SB(0, 0), cB, voffB); PG8_STAGE(PG8_SB(0, 1), cB + hstepB, voffB); PG8_STAGE(PG8_SA(0, 0), cA, voffA); PG8_STAGE(PG8_SA(0, 1), cA + hstepA, voffA);
    if (wr == 1) PG8_BAR;
    PG8_WAIT_V(2); PG8_BAR;
    PG8_STAGE(PG8_SB(1, 0), cB + kstep, voffB); PG8_STAGE(PG8_SA(1, 0), cA + kstep, voffA); PG8_STAGE(PG8_SB(1, 1), cB + hstepB + kstep, voffB);
    PG8_WAIT_V(6); PG8_BAR;
    for (;;) {
        const bool has_next = S.next(ui + 1, nxt);
        const char* nA = has_next ? nxt.a : cA; const char* nB = has_next ? nxt.b : cB;
        for (int t = 0; t < nt; t += 2) {
            const bool last = (t == nt - 2);
            const char* a1 = cA + (size_t)(t + 1) * kstep;
            const char* a2 = last ? nA : cA + (size_t)(t + 2) * kstep; const char* b2 = last ? nB : cB + (size_t)(t + 2) * kstep;
            const char* a3 = a2 + kstep; const char* b3 = b2 + kstep;
            PG8_LDB(B0, 0, 0); PG8_LDB(B1, 0, 1); PG8_SCHED; PG8_LDA(At, 0, 0); PG8_STAGE(PG8_SA(1, 1), a1 + hstepA, voffA);
            PG8_WAIT_V(8); PG8_WAIT_L(0); PG8_BAR; PG8_MMA(0, 0, At, B0); PG8_MMA(0, 1, At, B1); PG8_BAR; PG8_SCHED;
            PG8_LDA(At, 0, 1); PG8_STAGE(PG8_SB(0, 0), b2, voffB); PG8_STAGE(PG8_SB(0, 1), b2 + hstepB, voffB); PG8_STAGE(PG8_SA(0, 0), a2, voffA);
            PG8_WAIT_V(8); PG8_WAIT_L(0); PG8_BAR; PG8_MMA(1, 0, At, B0); PG8_MMA(1, 1, At, B1); PG8_BAR; PG8_SCHED;
            PG8_LDB(B0, 1, 0); PG8_LDB(B1, 1, 1); PG8_SCHED; PG8_LDA(At, 1, 0); PG8_STAGE(PG8_SA(0, 1), a2 + hstepA, voffA);
            PG8_WAIT_V(8); PG8_WAIT_L(0); PG8_BAR; PG8_MMA(0, 0, At, B0); PG8_MMA(0, 1, At, B1); PG8_BAR; PG8_SCHED;
            PG8_LDA(At, 1, 1); PG8_STAGE(PG8_SB(1, 0), b3, voffB); PG8_STAGE(PG8_SB(1, 1), b3 + hstepB, voffB); PG8_STAGE(PG8_SA(1, 0), a3, voffA);
            PG8_WAIT_V(8); PG8_WAIT_L(0); PG8_BAR; PG8_MMA(1, 0, At, B0); PG8_MMA(1, 1, At, B1); PG8_BAR; PG8_SCHED;
        }
        if constexpr (ALIGN_EPI) { if (wr == 0) PG8_BAR; }
        E(acc, cur, nxt, has_next, est, wr, wc, fr, fq);
        if (!has_next) break;
#pragma unroll
        for (int a = 0; a < 2; ++a)
#pragma unroll
            for (int b = 0; b < 2; ++b)
#pragma unroll
                for (int m = 0; m < 4; ++m)
#pragma unroll
                    for (int n = 0; n < 2; ++n) acc[a][b][m][n] = (f32x4){0.f, 0.f, 0.f, 0.f};
        cur = nxt; cA = nA; cB = nB; ++ui;
        if constexpr (ALIGN_EPI) { if (wr == 1) PG8_BAR; }
    }
    PG8_WAIT_V(0);
    if constexpr (!ALIGN_EPI) { if (wr == 0) PG8_BAR; }
    PG8_BAR;
#undef PG8_SA
#undef PG8_SB
#undef PG8_STAGE
#undef PG8_LDA
#undef PG8_LDB
#undef PG8_MMA
#undef PG8_WAIT_V
#undef PG8_WAIT_L
#undef PG8_BAR
#undef PG8_SCHED
}

struct EpiIn {
    static constexpr int BMODE = 2, AMODE = 0;
    const LAS float* rtab;
    const float* qn; const float* kn; const float* bg; bf16_t* U; bf16_t* Q; bf16_t* Kb; bf16_t* Vb; bf16_t* G; const float* TAB; int fl;
    struct State { f32x4 pv[2][2]; };
    __device__ __forceinline__ const float* par_of(const Unit& u, int wc, int fq) const { const int pn = u.pn, hc = wc * 64 + 8 * fq;
        if (pn < 4) return nullptr; if (pn < 8) return qn + 8 * fq; if (pn == 8) return wc < 2 ? kn + 8 * fq : nullptr; return bg + (pn - 9) * 256 + hc; }
    __device__ __forceinline__ void prefetch(State& st, const Unit& u, int wr, int wc, int fr, int fq) const { const float* par = par_of(u, wc, fq);
#pragma unroll
        for (int bj = 0; bj < 2; ++bj)
#pragma unroll
            for (int n = 0; n < 2; ++n) st.pv[bj][n] = par ? *(const f32x4*)(par + 32 * bj + 4 * n) : (f32x4){0.f, 0.f, 0.f, 0.f}; }
    __device__ __forceinline__ void operator()(const f32x4 (&acc)[2][2][4][2], const Unit& u, const Unit& nx, bool has_next, State& st, int wr, int wc, int fr, int fq) const {
        if (fl & 2) return;
        const int row0 = u.pm * BM + wr * 64 + fr, hc = wc * 64 + 8 * fq, pn = u.pn;
        int mode, ld, coloff; bf16_t* base; float qs = 1.f; bool rope = false;
        if (pn < 4) { mode = 0; base = U; ld = DM; coloff = pn * 256 + hc; }
        else if (pn < 8) { mode = 1; base = Q; ld = DM; coloff = (pn - 4) * 256 + hc; qs = 0.125f * LOG2E; }
        else if (pn == 8) { if (wc < 2) { mode = 1; base = Kb; ld = 128; coloff = hc; rope = true; } else { mode = 0; base = Vb; ld = 128; coloff = hc - 128; } }
        else { mode = 2; base = G; ld = 2 * DM; coloff = (pn - 9) * 256 + hc; }
        float rs[8];
#pragma unroll
        for (int e = 0; e < 8; ++e) rs[e] = rtab[u.idx * 256 + wr * 64 + fr + (e >> 2) * HALF + (e & 3) * 16];
        f32x4 pv[2][2];
#pragma unroll
        for (int bj = 0; bj < 2; ++bj)
#pragma unroll
            for (int n = 0; n < 2; ++n) pv[bj][n] = st.pv[bj][n];
        if (has_next) prefetch(st, nx, wr, wc, fr, fq);
#pragma unroll
        for (int e = 0; e < 8; ++e) { const int ai = e >> 2, m = e & 3; const int row = row0 + ai * HALF + m * 16;
            f32x4 v[2][2];
#pragma unroll
            for (int bj = 0; bj < 2; ++bj)
#pragma unroll
                for (int n = 0; n < 2; ++n) v[bj][n] = acc[ai][bj][m][n] * rs[e];
            if (mode == 1) { float ss = 0.f;
#pragma unroll
                for (int bj = 0; bj < 2; ++bj)
#pragma unroll
                    for (int n = 0; n < 2; ++n) ss += (v[bj][n][0] * v[bj][n][0] + v[bj][n][1] * v[bj][n][1]) + (v[bj][n][2] * v[bj][n][2] + v[bj][n][3] * v[bj][n][3]);
                ss += __shfl_xor(ss, 16); ss += __shfl_xor(ss, 32);
                const float rr = qs * __builtin_amdgcn_rsqf(ss * (1.f / 64.f) + EPS);
#pragma unroll
                for (int bj = 0; bj < 2; ++bj)
#pragma unroll
                    for (int n = 0; n < 2; ++n) v[bj][n] = v[bj][n] * rr * pv[bj][n];
                if (rope) {
                    f32x4 p0, p1;
#pragma unroll
                    for (int j = 0; j < 4; ++j) { p0[j] = __shfl_xor(v[0][0][j], 16); p1[j] = __shfl_xor(v[0][1][j], 16); }
                    if (fq < 2) { const float* tb = TAB + (size_t)row * 16; const f32x4 c0 = *(const f32x4*)tb, c1 = *(const f32x4*)(tb + 4), s0 = *(const f32x4*)(tb + 8), s1 = *(const f32x4*)(tb + 12);
                        const float sg = fq == 0 ? -1.f : 1.f; v[0][0] = v[0][0] * c0 + sg * (p0 * s0); v[0][1] = v[0][1] * c1 + sg * (p1 * s1); } } }
            else if (mode == 2) {
#pragma unroll
                for (int bj = 0; bj < 2; ++bj)
#pragma unroll
                    for (int n = 0; n < 2; ++n) v[bj][n] = v[bj][n] + pv[bj][n]; }
            bf16_t* rowp = base + (size_t)row * ld + coloff;
#pragma unroll
            for (int bj = 0; bj < 2; ++bj) { v4u w; w.x = pk2(v[bj][0][0], v[bj][0][1]); w.y = pk2(v[bj][0][2], v[bj][0][3]); w.z = pk2(v[bj][1][0], v[bj][1][1]); w.w = pk2(v[bj][1][2], v[bj][1][3]);
                if (!(fl & 1)) __builtin_nontemporal_store(w, (v4u*)(rowp + 32 * bj)); else asm volatile("" :: "v"(w)); } }
    }
};
struct EpiRes {
    static constexpr int BMODE = 0, AMODE = 0;
    const float* base; float* out; int ldc;
    struct State {}; __device__ __forceinline__ void prefetch(State&, const Unit&, int, int, int, int) const {}
    __device__ __forceinline__ void operator()(const f32x4 (&acc)[2][2][4][2], const Unit& u, const Unit&, bool, State&, int wr, int wc, int fr, int fq) const {
        const int row0 = u.pm * BM + wr * 64 + fr, col0 = u.pn * BM + wc * 32 + 4 * fq;
#pragma unroll
        for (int ai = 0; ai < 2; ++ai) { f32x4 b[4][2][2];
#pragma unroll
            for (int m = 0; m < 4; ++m)
#pragma unroll
                for (int bj = 0; bj < 2; ++bj)
#pragma unroll
                    for (int n = 0; n < 2; ++n) b[m][bj][n] = *(const f32x4*)(base + (size_t)(row0 + ai * HALF + m * 16) * ldc + col0 + bj * HALF + n * 16);
#pragma unroll
            for (int m = 0; m < 4; ++m) asm volatile("" : "+v"(b[m][0][0]), "+v"(b[m][0][1]), "+v"(b[m][1][0]), "+v"(b[m][1][1]));
#pragma unroll
            for (int m = 0; m < 4; ++m)
#pragma unroll
                for (int bj = 0; bj < 2; ++bj)
#pragma unroll
                    for (int n = 0; n < 2; ++n) *(f32x4*)(out + (size_t)(row0 + ai * HALF + m * 16) * ldc + col0 + bj * HALF + n * 16) = b[m][bj][n] + acc[ai][bj][m][n];
            asm volatile("" ::: "memory"); }
    }
};
struct EpiOut2 {
    static constexpr int BMODE = 1, AMODE = 0;
    const bf16_t* base; float* out;
    struct State {}; __device__ __forceinline__ void prefetch(State&, const Unit&, int, int, int, int) const {}
    __device__ __forceinline__ void operator()(const f32x4 (&acc)[2][2][4][2], const Unit& u, const Unit&, bool, State&, int wr, int wc, int fr, int fq) const {
        const int row0 = u.pm * BM + wr * 64 + fr, col0 = u.pn * BM + wc * 32 + 8 * fq;
#pragma unroll
        for (int ai = 0; ai < 2; ++ai) { v4u b[4][2];
#pragma unroll
            for (int m = 0; m < 4; ++m)
#pragma unroll
                for (int bj = 0; bj < 2; ++bj) b[m][bj] = *(const v4u*)(base + (size_t)(row0 + ai * HALF + m * 16) * DM + col0 + bj * HALF);
            asm volatile("" : "+v"(b[0][0]), "+v"(b[0][1]), "+v"(b[1][0]), "+v"(b[1][1]), "+v"(b[2][0]), "+v"(b[2][1]), "+v"(b[3][0]), "+v"(b[3][1]));
#pragma unroll
            for (int m = 0; m < 4; ++m)
#pragma unroll
                for (int bj = 0; bj < 2; ++bj) { float f[8]; unpack8(b[m][bj], f); float* op = out + (size_t)(row0 + ai * HALF + m * 16) * DM + col0 + bj * HALF;
                    const f32x4 a0 = acc[ai][bj][m][0], a1 = acc[ai][bj][m][1];
                    *(f32x4*)op = (f32x4){f[0] + a0[0], f[1] + a0[1], f[2] + a0[2], f[3] + a0[3]}; *(f32x4*)(op + 4) = (f32x4){f[4] + a1[0], f[5] + a1[1], f[6] + a1[2], f[7] + a1[3]}; }
            asm volatile("" ::: "memory"); }
    }
};
struct EpiMix {
    static constexpr int BMODE = 1, AMODE = 0;
    const bf16_t* G; const bf16_t* BO; bf16_t* MIX;
    struct State {}; __device__ __forceinline__ void prefetch(State&, const Unit&, int, int, int, int) const {}
    __device__ __forceinline__ void operator()(const f32x4 (&acc)[2][2][4][2], const Unit& u, const Unit&, bool, State&, int wr, int wc, int fr, int fq) const {
        const int row0 = u.pm * BM + wr * 64 + fr, col0 = u.pn * BM + wc * 32 + 8 * fq;
#pragma unroll
        for (int ai = 0; ai < 2; ++ai)
#pragma unroll
            for (int mh = 0; mh < 2; ++mh) { v4u gp[2][2], ga[2][2], bo[2][2];
#pragma unroll
                for (int mm = 0; mm < 2; ++mm)
#pragma unroll
                    for (int bj = 0; bj < 2; ++bj) { const size_t row = (size_t)(row0 + ai * HALF + (2 * mh + mm) * 16); const int c = col0 + bj * HALF;
                        gp[mm][bj] = *(const v4u*)(G + row * (2 * DM) + c); ga[mm][bj] = *(const v4u*)(G + row * (2 * DM) + DM + c); bo[mm][bj] = *(const v4u*)(BO + row * DM + c); }
                asm volatile("" : "+v"(gp[0][0]), "+v"(gp[0][1]), "+v"(gp[1][0]), "+v"(gp[1][1]), "+v"(ga[0][0]), "+v"(ga[0][1]), "+v"(ga[1][0]), "+v"(ga[1][1]));
                asm volatile("" : "+v"(bo[0][0]), "+v"(bo[0][1]), "+v"(bo[1][0]), "+v"(bo[1][1]));
#pragma unroll
                for (int mm = 0; mm < 2; ++mm)
#pragma unroll
                    for (int bj = 0; bj < 2; ++bj) { const int m = 2 * mh + mm; const size_t row = (size_t)(row0 + ai * HALF + m * 16); const int c = col0 + bj * HALF;
                        float p[8], a[8], b[8], o[8]; unpack8(gp[mm][bj], p); unpack8(ga[mm][bj], a); unpack8(bo[mm][bj], b);
                        const f32x4 a0 = acc[ai][bj][m][0], a1 = acc[ai][bj][m][1];
#pragma unroll
                        for (int j = 0; j < 4; ++j) { o[j] = sigmoidf_(p[j]) * a0[j] + sigmoidf_(a[j]) * b[j]; o[4 + j] = sigmoidf_(p[4 + j]) * a1[j] + sigmoidf_(a[4 + j]) * b[4 + j]; }
                        *(v4u*)(MIX + row * DM + c) = pack8(o); }
                asm volatile("" ::: "memory"); }
    }
};
struct EpiOut1 {
    static constexpr int BMODE = 1, AMODE = 0;
    const float* x; float* out; bf16_t* X1B; float* SSQ;
    struct State {}; __device__ __forceinline__ void prefetch(State&, const Unit&, int, int, int, int) const {}
    __device__ __forceinline__ void operator()(const f32x4 (&acc)[2][2][4][2], const Unit& u, const Unit&, bool, State&, int wr, int wc, int fr, int fq) const {
        const int row0 = u.pm * BM + wr * 64 + fr, col0 = u.pn * BM + wc * 32 + 8 * fq;
#pragma unroll
        for (int ai = 0; ai < 2; ++ai) { f32x4 xv[4][2][2];
#pragma unroll
            for (int m = 0; m < 4; ++m)
#pragma unroll
                for (int bj = 0; bj < 2; ++bj) { const size_t off = (size_t)(row0 + ai * HALF + m * 16) * DM + col0 + bj * HALF; xv[m][bj][0] = *(const f32x4*)(x + off); xv[m][bj][1] = *(const f32x4*)(x + off + 4); }
#pragma unroll
            for (int m = 0; m < 4; ++m) asm volatile("" : "+v"(xv[m][0][0]), "+v"(xv[m][0][1]), "+v"(xv[m][1][0]), "+v"(xv[m][1][1]));
#pragma unroll
            for (int m = 0; m < 4; ++m) { const size_t row = (size_t)(row0 + ai * HALF + m * 16); float ss = 0.f;
#pragma unroll
                for (int bj = 0; bj < 2; ++bj) { const size_t off = row * DM + col0 + bj * HALF;
                    const f32x4 v0 = xv[m][bj][0] + acc[ai][bj][m][0], v1 = xv[m][bj][1] + acc[ai][bj][m][1];
                    ss += (v0[0] * v0[0] + v0[1] * v0[1]) + (v0[2] * v0[2] + v0[3] * v0[3]) + (v1[0] * v1[0] + v1[1] * v1[1]) + (v1[2] * v1[2] + v1[3] * v1[3]);
                    v4u w; w.x = pk2(v0[0], v0[1]); w.y = pk2(v0[2], v0[3]); w.z = pk2(v1[0], v1[1]); w.w = pk2(v1[2], v1[3]);
                    *(v4u*)(X1B + off) = w; }
                ss += __shfl_xor(ss, 16); ss += __shfl_xor(ss, 32);
                if (fq == 0) SSQ[row * 16 + u.pn * 4 + wc] = ss; }
            asm volatile("" ::: "memory"); }
    }
};
__device__ __forceinline__ float dpp_shr1(float v) { return __int_as_float(__builtin_amdgcn_update_dpp(0, __float_as_int(v), 0x111, 0xf, 0xf, true)); }
__device__ __forceinline__ f32x4 dpp_shr1(f32x4 v) { f32x4 r; r[0] = dpp_shr1(v[0]); r[1] = dpp_shr1(v[1]); r[2] = dpp_shr1(v[2]); r[3] = dpp_shr1(v[3]); return r; }
struct EpiConv {
    static constexpr int BMODE = 1, AMODE = 1;
    const LAS float* rtab;
    const float* cw; const float* cb; bf16_t* HACT; float* Y01; float* HALO; int fl;
    struct State { f32x4 c0[4]; };
    __device__ __forceinline__ void ldcw(f32x4 (&d)[4], int colg, int it) const { const int c = (it >> 1) * DFF + colg + 4 * (it & 1); d[0] = *(const f32x4*)(cw + c); d[1] = *(const f32x4*)(cw + NUP + c); d[2] = *(const f32x4*)(cw + 2 * NUP + c); d[3] = *(const f32x4*)(cb + c); }
    __device__ __forceinline__ void prefetch(State& st, const Unit& u, int wr, int wc, int fr, int fq) const { ldcw(st.c0, u.pn * 128 + wc * 32 + 8 * fq, 0); }
    __device__ __forceinline__ void operator()(f32x4 (&acc)[2][2][4][2], const Unit& u, const Unit& nx, bool has_next, State& st, int wr, int wc, int fr, int fq) const {
        if (fl & 2) return;
#define AE(e, bj, n) acc[(e) >> 2][bj][(e) & 3][n]
        const int trow0 = u.pm * BM + 128 * wr + 8 * fr, q = u.pm * 2 + wr, colg = u.pn * 128 + wc * 32 + 8 * fq;
        f32x4 cwv[4][4];
#pragma unroll
        for (int k = 0; k < 4; ++k) cwv[0][k] = st.c0[k];
        const f32x4 ra = *(const LAS f32x4*)(rtab + u.idx * 256 + 128 * wr + 8 * fr), rb = *(const LAS f32x4*)(rtab + u.idx * 256 + 128 * wr + 8 * fr + 4);
        const float r2v[8] = {ra[0], ra[1], ra[2], ra[3], rb[0], rb[1], rb[2], rb[3]};
#pragma unroll
        for (int e = 0; e < 8; ++e) {
#pragma unroll
            for (int bj = 0; bj < 2; ++bj) { AE(e, bj, 0) *= r2v[e]; AE(e, bj, 1) *= r2v[e]; }
            asm volatile("" : "+v"(AE(e, 0, 0)), "+v"(AE(e, 0, 1)), "+v"(AE(e, 1, 0)), "+v"(AE(e, 1, 1))); }
        if (fr == 15) {
#pragma unroll
            for (int e = 6; e < 8; ++e)
#pragma unroll
                for (int bj = 0; bj < 2; ++bj) { float* hp = HALO + ((size_t)(q * 2 + (e - 6)) * NUP + bj * DFF + colg); *(f32x4*)hp = AE(e, bj, 0); *(f32x4*)(hp + 4) = AE(e, bj, 1); } }
#pragma unroll
        for (int it = 0; it < 4; ++it) { const int bj = it >> 1, n = it & 1;
            asm volatile("" ::: "memory");
            if (it < 3) ldcw(cwv[it + 1], colg, it + 1);
            asm volatile("" : "+v"(cwv[it][0]), "+v"(cwv[it][1]), "+v"(cwv[it][2]), "+v"(cwv[it][3]));
            const f32x4 w0 = cwv[it][0], w1 = cwv[it][1], w2 = cwv[it][2], bb = cwv[it][3];
            const f32x4 p6 = dpp_shr1(AE(6, bj, n)), p7 = dpp_shr1(AE(7, bj, n));
#pragma unroll
            for (int e = 7; e >= 2; --e) AE(e, bj, n) = w2 * AE(e, bj, n) + (w1 * AE(e - 1, bj, n) + (w0 * AE(e - 2, bj, n) + bb));
            AE(1, bj, n) = w2 * AE(1, bj, n) + (w1 * AE(0, bj, n) + (w0 * p7 + bb));
            AE(0, bj, n) = w2 * AE(0, bj, n) + (w1 * p7 + (w0 * p6 + bb));
            asm volatile("" : "+v"(AE(0, bj, n)), "+v"(AE(1, bj, n)), "+v"(AE(2, bj, n)), "+v"(AE(3, bj, n)), "+v"(AE(4, bj, n)), "+v"(AE(5, bj, n)), "+v"(AE(6, bj, n)), "+v"(AE(7, bj, n))); }
        asm volatile("" ::: "memory");
        if (has_next) prefetch(st, nx, wr, wc, fr, fq);
        if (fr == 0) {
#pragma unroll
            for (int e = 0; e < 2; ++e)
#pragma unroll
                for (int bj = 0; bj < 2; ++bj) { float* yp = Y01 + ((size_t)(q * 2 + e) * NUP + bj * DFF + colg); *(f32x4*)yp = AE(e, bj, 0); *(f32x4*)(yp + 4) = AE(e, bj, 1); } }
#pragma unroll
        for (int e = 0; e < 8; ++e) { const f32x4 g0 = AE(e, 0, 0), g1 = AE(e, 0, 1), v0 = AE(e, 1, 0), v1 = AE(e, 1, 1); float o[8];
#pragma unroll
            for (int j = 0; j < 4; ++j) { o[j] = g0[j] * sigmoidf_(g0[j]) * v0[j]; o[4 + j] = g1[j] * sigmoidf_(g1[j]) * v1[j]; }
            const v4u pw = pack8(o); if (!(fl & 1)) __builtin_nontemporal_store(pw, (v4u*)(HACT + (size_t)(trow0 + e) * DFF + colg)); else asm volatile("" :: "v"(pw)); asm volatile("" ::: "memory"); }
#undef AE
    }
};
}

constexpr int NWAVES = 8, NTHR = NWAVES * 64;
constexpr int N_PHASES = 13;
constexpr size_t MiB = 1u << 20;
constexpr size_t WS_CTL = 0, CTL_ZERO_BYTES = 1 * MiB;
constexpr size_t WS_R1 = 1 * MiB;
constexpr size_t WS_SSQ = 498 * MiB;
constexpr size_t WS_TAB = 2 * MiB;
constexpr size_t WS_WIN = 4 * MiB, WS_WP = 13 * MiB, WS_WO = 14 * MiB, WS_WU = 16 * MiB, WS_WD = 28 * MiB;
constexpr size_t WS_XB = 34 * MiB;
constexpr size_t WS_Z = 98 * MiB;
constexpr size_t WS_Y01 = WS_Z, WS_HALO = WS_Z + 16 * MiB, WS_HACT = WS_Z + 176 * MiB;
constexpr size_t WS_B = 370 * MiB;
constexpr size_t WS_AP = 434 * MiB;
constexpr size_t WS_END = 500 * MiB;
static_assert(WS_WIN + (size_t)NIN * DM * 2 <= WS_WP && WS_WU + (size_t)NUP * DM * 2 <= WS_WD && WS_WD + (size_t)DM * DFF * 2 <= WS_XB, "weights map");
static_assert(WS_Z + (size_t)M * NIN * 2 <= WS_B && WS_HACT + (size_t)M * DFF * 2 <= WS_SSQ && WS_AP + (size_t)M * DM * 2 <= WS_SSQ, "activation map");
constexpr int CW_BAR = 4096;
constexpr int RING_BYTES = 131072, LDSCTL_OFF = RING_BYTES, MISC_OFF = LDSCTL_OFF + 320, LDS_BYTES = 147456;

#define XB_TMO      128
#define XB_XCNT(j)  (256  + 64 * (j))
#define XB_XSUB(j)  (1280 + 64 * (j))
#define XB_XGEN(j)  (2304 + 64 * (j))
#define XB_TOP      3328
#define XB_TOPGEN   3392
#define XCD_BAR_WORDS 3456
#define XB_SPIN_CAP (1u << 18)
__device__ __forceinline__ unsigned xb_ld(unsigned* p)              { return __hip_atomic_load(p, __ATOMIC_RELAXED, __HIP_MEMORY_SCOPE_AGENT); }
__device__ __forceinline__ unsigned xb_add(unsigned* p, unsigned v) { return __hip_atomic_fetch_add(p, v, __ATOMIC_RELAXED, __HIP_MEMORY_SCOPE_AGENT); }
__device__ __forceinline__ unsigned xb_xcc_id() { return (unsigned)__builtin_amdgcn_s_getreg((3 << 11) | 20) & 0xFu; }
#define XB_SPIN(cond, bar) do { unsigned _sp = 0; while (cond) { __builtin_amdgcn_s_sleep(1); \
    if ((++_sp & 255u) == 0u) { if (xb_ld(&(bar)[XB_TMO])) break; if (_sp > XB_SPIN_CAP) { atomicAdd(&(bar)[XB_TMO], 1u); break; } } } } while (0)
struct XcdBarrier { unsigned* bar; unsigned x; volatile LAS unsigned* st; };
__device__ __forceinline__ XcdBarrier xcd_barrier_post(unsigned* bar, volatile LAS unsigned* st) {
    XcdBarrier b; b.bar = bar; b.x = xb_xcc_id(); b.st = st;
    if (threadIdx.x == 0) (void)xb_add(&bar[XB_XCNT(b.x)], 1u);
    return b;
}
__device__ __forceinline__ void xcd_barrier_complete(unsigned* bar, unsigned x, unsigned& nloc, unsigned& nx) {
    const unsigned G = gridDim.x * gridDim.y * gridDim.z;
    unsigned sum, cnt, mine, sp = 0u;
    for (;;) {
        sum = 0u; cnt = 0u; mine = 0u;
#pragma unroll
        for (unsigned j = 0; j < 16; ++j) { const unsigned c = xb_ld(&bar[XB_XCNT(j)]); sum += c; cnt += (c > 0u) ? 1u : 0u; mine = (j == x) ? c : mine; }
        if (sum == G) break;
        __builtin_amdgcn_s_sleep(1);
        if ((++sp & 255u) == 0u) { if (xb_ld(&bar[XB_TMO])) break; if (sp > XB_SPIN_CAP) { atomicAdd(&bar[XB_TMO], 1u); break; } }
    }
    nloc = mine > 0u ? mine : 1u; nx = cnt > 0u ? cnt : 1u;
}
__device__ __forceinline__ void xcd_barrier(const XcdBarrier& b) {
    asm volatile("s_waitcnt vmcnt(0)" ::: "memory");
    __syncthreads();
    if (threadIdx.x == 0) {
        unsigned* bar = b.bar;
        __builtin_amdgcn_s_waitcnt(0);
        unsigned nloc = b.st[0], nx = b.st[1];
        if (nloc == 0u) { xcd_barrier_complete(bar, b.x, nloc, nx); b.st[0] = nloc; b.st[1] = nx; }
        const unsigned old = xb_add(&bar[XB_XSUB(b.x)], 1u);
        const unsigned gen = old / nloc;
        if (old + 1u == (gen + 1u) * nloc) {
            __builtin_amdgcn_fence(__ATOMIC_RELEASE, "agent");
            asm volatile("s_waitcnt vmcnt(0)" ::: "memory");
            const unsigned og = xb_add(&bar[XB_TOP], 1u);
            const unsigned tg = og / nx;
            if (og + 1u == (tg + 1u) * nx) xb_add(&bar[XB_TOPGEN], 1u);
            else XB_SPIN(xb_ld(&bar[XB_TOPGEN]) == tg, bar);
            __builtin_amdgcn_fence(__ATOMIC_ACQUIRE, "agent");
            xb_add(&bar[XB_XGEN(b.x)], 1u);
            asm volatile("s_waitcnt vmcnt(0)" ::: "memory");
        } else {
            XB_SPIN(xb_ld(&bar[XB_XGEN(b.x)]) == gen, bar);
            __builtin_amdgcn_fence(__ATOMIC_ACQUIRE, "agent");
            asm volatile("s_waitcnt vmcnt(0)" ::: "memory");
        }
    }
    __syncthreads();
}

struct Frame {
    LAS unsigned char* lds; volatile LAS unsigned* MISC; gu32* ctl;
    int tid, lane, wave, vcu, G;
};
__device__ __forceinline__ float wave_sum(float v) {
#pragma unroll
    for (int o = 1; o < 64; o <<= 1) v += __shfl_xor(v, o);
    return v;
}

__device__ __forceinline__ void p0_transpose_item(const float* W, int K, int N, bf16_t* WT, const float* kscale, const float* nscale, LAS float* scr, int item, int lane) {
    const int nblk = N / 32, kb = item / nblk, nb = item % nblk, k0 = 64 * kb, n0 = 32 * nb;
    const float ns = nscale ? nscale[n0 + (lane & 31)] : 1.f;
    float wv[32];
#pragma unroll
    for (int i = 0; i < 32; ++i) wv[i] = W[(size_t)(k0 + 2 * i + (lane >> 5)) * N + n0 + (lane & 31)];
#pragma unroll
    for (int i = 0; i < 32; i += 8) asm volatile("" : "+v"(wv[i]), "+v"(wv[i + 1]), "+v"(wv[i + 2]), "+v"(wv[i + 3]), "+v"(wv[i + 4]), "+v"(wv[i + 5]), "+v"(wv[i + 6]), "+v"(wv[i + 7]));
#pragma unroll
    for (int i = 0; i < 32; ++i) { const int kk = 2 * i + (lane >> 5); const float ks = kscale ? kscale[k0 + kk] : 1.f; scr[kk * 33 + (lane & 31)] = wv[i] * ks * ns; }
    LDS_WAIT(); asm volatile("" ::: "memory");
    const int c = lane & 7;
#pragma unroll
    for (int j = 0; j < 4; ++j) { const int n = (lane >> 3) + 8 * j; const LAS float* s = scr + (8 * c) * 33 + n;
        v4u o; o.x = pk2(s[0 * 33], s[1 * 33]); o.y = pk2(s[2 * 33], s[3 * 33]); o.z = pk2(s[4 * 33], s[5 * 33]); o.w = pk2(s[6 * 33], s[7 * 33]);
        *(GAS v4u*)(WT + (size_t)(n0 + n) * K + k0 + 8 * c) = o; }
    LDS_WAIT(); asm volatile("" ::: "memory");
}
__device__ __forceinline__ void row_bf16_rs(int lane, const float* xrow, bf16_t* orow, float* rs) {
    const GAS f32x4* xr = (const GAS f32x4*)xrow + lane;
    f32x4 v[4]; float s = 0.f;
#pragma unroll
    for (int j = 0; j < 4; ++j) { v[j] = xr[64 * j]; s += (v[j].x * v[j].x + v[j].y * v[j].y) + (v[j].z * v[j].z + v[j].w * v[j].w); }
    s = wave_sum(s);
    if (lane == 0) *rs = __builtin_amdgcn_rsqf(s * (1.f / DM) + EPS);
    GAS unsigned long long* o8 = (GAS unsigned long long*)orow + lane;
#pragma unroll
    for (int j = 0; j < 4; ++j) o8[64 * j] = (unsigned long long)pk2(v[j].x, v[j].y) | ((unsigned long long)pk2(v[j].z, v[j].w) << 32);
}

typedef float f32x16 __attribute__((ext_vector_type(16)));
typedef short s16x4 __attribute__((ext_vector_type(4)));
constexpr int AT_KP = 72, AT_VP = 260;
constexpr int AT_K_OFF = 0, AT_V_OFF = 256 * AT_KP * 2, AT_W_OFF = 71680, AT_W_BYTES = 4608;
static_assert(AT_V_OFF + 64 * AT_VP * 2 <= AT_W_OFF && AT_W_OFF + 8 * AT_W_BYTES <= RING_BYTES, "attention LDS map");
__device__ __forceinline__ int crow16(int r, int hi) { return (r & 3) + 8 * (r >> 2) + 4 * hi; }
__device__ __forceinline__ void attn_chunk(int c, int nblk, int lane, bf16x8 q0, bf16x8 q1, bf16x8 q2, bf16x8 q3, f32x4 t0, f32x4 t1, f32x4 t2, f32x4 t3, float sinkv,
                                           const LAS bf16_t* Ks, const LAS bf16_t* Vt, LAS bf16_t* stg, LAS float* wsf, bf16_t* orow  ) {
    const int r32 = lane & 31, hi = lane >> 5; const float NEG = -INFINITY;
    {
        const v4u w = __builtin_bit_cast(v4u, q0); v4u pr; pr.x = __shfl_xor(w.x, 32); pr.y = __shfl_xor(w.y, 32); pr.z = __shfl_xor(w.z, 32); pr.w = __shfl_xor(w.w, 32);
        float a[8], p[8], o[8]; unpack8(w, a); unpack8(pr, p); const float sg = hi == 0 ? -1.f : 1.f;
#pragma unroll
        for (int j = 0; j < 4; ++j) { o[j] = a[j] * t0[j] + sg * p[j] * t2[j]; o[4 + j] = a[4 + j] * t1[j] + sg * p[4 + j] * t3[j]; }
        q0 = __builtin_bit_cast(bf16x8, pack8(o)); }
    f32x16 S[5];
#pragma unroll
    for (int t = 0; t < 5; ++t) {
#pragma unroll
        for (int r = 0; r < 16; ++r) S[t][r] = 0.f;
        const LAS bf16_t* kp = Ks + ((c + t) * 32 + r32) * AT_KP + 8 * hi;
        S[t] = __builtin_amdgcn_mfma_f32_32x32x16_bf16(*(const LAS bf16x8*)(kp), q0, S[t], 0, 0, 0);
        S[t] = __builtin_amdgcn_mfma_f32_32x32x16_bf16(*(const LAS bf16x8*)(kp + 16), q1, S[t], 0, 0, 0);
        S[t] = __builtin_amdgcn_mfma_f32_32x32x16_bf16(*(const LAS bf16x8*)(kp + 32), q2, S[t], 0, 0, 0);
        S[t] = __builtin_amdgcn_mfma_f32_32x32x16_bf16(*(const LAS bf16x8*)(kp + 48), q3, S[t], 0, 0, 0);
    }
#pragma unroll
    for (int r = 0; r < 16; ++r) { const int jj = crow16(r, hi); if (!(jj > r32)) S[0][r] = NEG; if (!(jj <= r32)) S[4][r] = NEG; }
#pragma unroll
    for (int t = 0; t < 5; ++t) { if (nblk == 0 && c + t < 4) {
#pragma unroll
        for (int r = 0; r < 16; ++r) S[t][r] = NEG; } }
    float mx = NEG;
#pragma unroll
    for (int t = 0; t < 5; ++t)
#pragma unroll
        for (int r = 0; r < 16; ++r) mx = fmaxf(mx, S[t][r]);
    mx = fmaxf(mx, __shfl_xor(mx, 32)); mx = fmaxf(mx, sinkv);
    float l = 0.f;
#pragma unroll
    for (int t = 0; t < 5; ++t)
#pragma unroll
        for (int r = 0; r < 16; ++r) { const float p = __builtin_amdgcn_exp2f(S[t][r] - mx); S[t][r] = p; l += p; }
    l += __shfl_xor(l, 32); l += __builtin_amdgcn_exp2f(sinkv - mx);
    f32x16 O[2];
#pragma unroll
    for (int r = 0; r < 16; ++r) { O[0][r] = 0.f; O[1][r] = 0.f; }
#pragma unroll
    for (int t = 0; t < 5; ++t)
#pragma unroll
        for (int s = 0; s < 2; ++s) {
            v4u pw; pw.x = pk2(S[t][8 * s + 0], S[t][8 * s + 1]); pw.y = pk2(S[t][8 * s + 2], S[t][8 * s + 3]); pw.z = pk2(S[t][8 * s + 4], S[t][8 * s + 5]); pw.w = pk2(S[t][8 * s + 6], S[t][8 * s + 7]);
            const bf16x8 xs = __builtin_bit_cast(bf16x8, pw);
#pragma unroll
            for (int d0 = 0; d0 < 2; ++d0) { const LAS bf16_t* vp = Vt + (32 * d0 + r32) * AT_VP + (c + t) * 32 + 16 * s + 4 * hi;
                const s16x4 lo = *(const LAS s16x4*)vp, hh = *(const LAS s16x4*)(vp + 8);
                const bf16x8 vf = __builtin_shufflevector(lo, hh, 0, 1, 2, 3, 4, 5, 6, 7);
                O[d0] = __builtin_amdgcn_mfma_f32_32x32x16_bf16(xs, vf, O[d0], 0, 0, 0); }
        }
    asm volatile("s_waitcnt lgkmcnt(0)" ::: "memory");
    if (hi == 0) wsf[r32] = 1.f / l;
    asm volatile("s_waitcnt lgkmcnt(0)" ::: "memory");
#pragma unroll
    for (int r = 0; r < 16; ++r) { const int qi = crow16(r, hi); const float inv = wsf[qi];
        stg[qi * 64 + r32] = (bf16_t)f2bf(O[0][r] * inv); stg[qi * 64 + 32 + r32] = (bf16_t)f2bf(O[1][r] * inv); }
    asm volatile("s_waitcnt lgkmcnt(0)" ::: "memory");
#pragma unroll
    for (int i = 0; i < 4; ++i) { const int row = i * 8 + (lane >> 3), ch = lane & 7; const v4u v = *(const LAS v4u*)(stg + row * 64 + ch * 8);
        *(v4u*)(orow + (size_t)row * DM + 8 * ch) = v; }
    asm volatile("s_waitcnt lgkmcnt(0)" ::: "memory");
}
__device__ __forceinline__ void attn_phase(Frame& F, int u_first, int u_step, int u_count, const bf16_t* Q, int ldq, const bf16_t* K, int ldk, const bf16_t* V, int ldv, const float* TAB, const float* sinks, bf16_t* BO) {
    LAS bf16_t* Ks = (LAS bf16_t*)(F.lds + AT_K_OFF); LAS bf16_t* Vt = (LAS bf16_t*)(F.lds + AT_V_OFF);
    LAS bf16_t* stg = (LAS bf16_t*)(F.lds + AT_W_OFF + F.wave * AT_W_BYTES); LAS float* wsf = (LAS float*)(F.lds + AT_W_OFF + F.wave * AT_W_BYTES + 4096);
    const int lane = F.lane, r32 = lane & 31, hi = lane >> 5;
    v4u kvr[4], vvr[4];
#define AT_LOAD_KV(un) do { const int kvh_ = (un) & 1, b_ = (un) >> 6; const long row0_ = (long)b_ * SEQ + (long)(((un) >> 1) & 31) * 128; \
        _Pragma("unroll") for (int i = 0; i < 4; ++i) { const int c_ = F.tid + i * NTHR, r_ = c_ >> 3, ch_ = c_ & 7; const long grow_ = row0_ - 128 + r_; kvr[i] = (v4u){0u, 0u, 0u, 0u}; vvr[i] = (v4u){0u, 0u, 0u, 0u}; \
            if (grow_ >= (long)b_ * SEQ) { kvr[i] = *(const v4u*)(K + (size_t)grow_ * ldk + 64 * kvh_ + 8 * ch_); vvr[i] = *(const v4u*)(V + (size_t)grow_ * ldv + 64 * kvh_ + 8 * ch_); } } } while (0)
#define AT_LOAD_Q(c, qq, tt) do { const size_t qrow_ = (size_t)(row0 + 32 * (c) + r32); const bf16_t* qp_ = Q + qrow_ * ldq + 64 * head + 8 * hi; const float* tb_ = TAB + qrow_ * 16; \
        qq[0] = *(const bf16x8*)qp_; qq[1] = *(const bf16x8*)(qp_ + 16); qq[2] = *(const bf16x8*)(qp_ + 32); qq[3] = *(const bf16x8*)(qp_ + 48); \
        tt[0] = *(const f32x4*)tb_; tt[1] = *(const f32x4*)(tb_ + 4); tt[2] = *(const f32x4*)(tb_ + 8); tt[3] = *(const f32x4*)(tb_ + 12); } while (0)
    int unit = u_first; const int u_end = u_first + u_count * u_step;
    if (unit < u_end) AT_LOAD_KV(unit);
    while (unit < u_end) {
        const int kvh = unit & 1, nblk = (unit >> 1) & 31, b = unit >> 6;
        const long row0 = (long)b * SEQ + (long)nblk * 128;
        const int head = kvh * 8 + F.wave;
        const float sinkv = sinks[head] * LOG2E;
        bf16x8 qa[4], qb[4]; f32x4 ta[4], tb[4];
        AT_LOAD_Q(0, qa, ta);
        __syncthreads();
#pragma unroll
        for (int i = 0; i < 4; ++i) { const int c = F.tid + i * NTHR, r = c >> 3, ch = c & 7;
            *(LAS v4u*)(Ks + r * AT_KP + 8 * ch) = kvr[i];
            LAS bf16_t* vp = Vt + (8 * ch) * AT_VP + r; const v4u vv = vvr[i];
            vp[0 * AT_VP] = (bf16_t)(vv.x & 0xffffu); vp[1 * AT_VP] = (bf16_t)(vv.x >> 16); vp[2 * AT_VP] = (bf16_t)(vv.y & 0xffffu); vp[3 * AT_VP] = (bf16_t)(vv.y >> 16);
            vp[4 * AT_VP] = (bf16_t)(vv.z & 0xffffu); vp[5 * AT_VP] = (bf16_t)(vv.z >> 16); vp[6 * AT_VP] = (bf16_t)(vv.w & 0xffffu); vp[7 * AT_VP] = (bf16_t)(vv.w >> 16); }
        __syncthreads();
        const int next = unit + u_step;
        if (next < u_end) AT_LOAD_KV(next);
        bf16_t* ob = BO + (size_t)row0 * DM + 64 * head;
        AT_LOAD_Q(1, qb, tb); attn_chunk(0, nblk, lane, qa[0], qa[1], qa[2], qa[3], ta[0], ta[1], ta[2], ta[3], sinkv, Ks, Vt, stg, wsf, ob);
        AT_LOAD_Q(2, qa, ta); attn_chunk(1, nblk, lane, qb[0], qb[1], qb[2], qb[3], tb[0], tb[1], tb[2], tb[3], sinkv, Ks, Vt, stg, wsf, ob + (size_t)32 * DM);
        AT_LOAD_Q(3, qb, tb); attn_chunk(2, nblk, lane, qa[0], qa[1], qa[2], qa[3], ta[0], ta[1], ta[2], ta[3], sinkv, Ks, Vt, stg, wsf, ob + (size_t)64 * DM);
        attn_chunk(3, nblk, lane, qb[0], qb[1], qb[2], qb[3], tb[0], tb[1], tb[2], tb[3], sinkv, Ks, Vt, stg, wsf, ob + (size_t)96 * DM);
        unit = next;
    }
#undef AT_LOAD_KV
#undef AT_LOAD_Q
    __syncthreads();
}

template <int G_> __device__ __forceinline__ void pool_prep_item(const bf16_t* U, bf16_t* P, int tb, int ch) {
    constexpr int W = 2 << G_, NR = 8 + W - 1;
    const int t0 = tb * 8, ts0 = t0 & (SEQ - 1);
    v4u rows[NR];
#pragma unroll
    for (int k = 0; k < NR; ++k) { const int tseq = ts0 - (W - 1) + k; rows[k] = (v4u){0u, 0u, 0u, 0u}; if (tseq >= 0) rows[k] = *(const v4u*)(U + (size_t)(t0 - (W - 1) + k) * DM + 8 * ch); }
    float s[8];
#pragma unroll
    for (int j = 0; j < 8; ++j) s[j] = 0.f;
#pragma unroll
    for (int k = 0; k < W; ++k) { float f[8]; unpack8(rows[k], f);
#pragma unroll
        for (int j = 0; j < 8; ++j) s[j] += f[j]; }
#pragma unroll
    for (int t = 0; t < 8; ++t) { float u[8]; unpack8(rows[t + W - 1], u);
        if (t > 0) { float o[8]; unpack8(rows[t - 1], o);
#pragma unroll
            for (int j = 0; j < 8; ++j) s[j] += u[j] - o[j]; }
        const int cnt = (ts0 + t + 1 < W) ? ts0 + t + 1 : W; const float ic = 1.f / (float)cnt; float r[8];
#pragma unroll
        for (int j = 0; j < 8; ++j) r[j] = s[j] * ic - u[j];
        *(v4u*)(P + (size_t)(t0 + t) * DM + 8 * ch) = pack8(r); }
}

__device__ __forceinline__ void rows4_bf16_rs(int lane, const float* xrow, bf16_t* orow, float* rs) {
    f32x4 v[4][4];
#pragma unroll
    for (int r = 0; r < 4; ++r)
#pragma unroll
        for (int j = 0; j < 4; ++j) v[r][j] = *((const GAS f32x4*)(xrow + (size_t)r * DM) + lane + 64 * j);
#pragma unroll
    for (int r = 0; r < 4; ++r) asm volatile("" : "+v"(v[r][0]), "+v"(v[r][1]), "+v"(v[r][2]), "+v"(v[r][3]));
#pragma unroll
    for (int r = 0; r < 4; ++r) { float s = 0.f;
#pragma unroll
        for (int j = 0; j < 4; ++j) s += (v[r][j].x * v[r][j].x + v[r][j].y * v[r][j].y) + (v[r][j].z * v[r][j].z + v[r][j].w * v[r][j].w);
        s = wave_sum(s);
        if (lane == 0) rs[r] = __builtin_amdgcn_rsqf(s * (1.f / DM) + EPS);
        GAS unsigned long long* o8 = (GAS unsigned long long*)(orow + (size_t)r * DM) + lane;
#pragma unroll
        for (int j = 0; j < 4; ++j) o8[64 * j] = (unsigned long long)pk2(v[r][j].x, v[r][j].y) | ((unsigned long long)pk2(v[r][j].z, v[r][j].w) << 32); }
}

constexpr int RTAB_OFF = LDSCTL_OFF + 512, RTAB_UNITS = 12;
static_assert(RTAB_OFF + RTAB_UNITS * 256 * 4 <= LDS_BYTES, "row-scale table fits behind the ring");
template <class Sched> __device__ __forceinline__ void fill_rtab(Frame& F, const Sched& S, const float* src, const float* ssq) {
    LAS float* rt = (LAS float*)(F.lds + RTAB_OFF);
    pg8::Unit u;
    if (src) { for (int i = 0; i < RTAB_UNITS && S.next(i, u); ++i) if (F.tid < 256) rt[i * 256 + F.tid] = src[u.pm * 256 + F.tid]; }
    else {
        const int row = F.tid >> 1, hf = F.tid & 1;
        for (int i0 = 0; i0 < RTAB_UNITS; i0 += 4) { f32x4 p[4][2]; bool ok[4];
#pragma unroll
            for (int k = 0; k < 4; ++k) { ok[k] = S.next(i0 + k, u); if (ok[k]) { const float* sp = ssq + (size_t)(u.pm * 256 + row) * 16 + 8 * hf; p[k][0] = *(const f32x4*)sp; p[k][1] = *(const f32x4*)(sp + 4); } else { p[k][0] = (f32x4){1.f, 1.f, 1.f, 1.f}; p[k][1] = p[k][0]; } }
#pragma unroll
            for (int k = 0; k < 4; ++k) { float t = ((p[k][0].x + p[k][0].y) + (p[k][0].z + p[k][0].w)) + ((p[k][1].x + p[k][1].y) + (p[k][1].z + p[k][1].w)); t += __shfl_xor(t, 1);
                if (ok[k] && hf == 0) rt[(i0 + k) * 256 + row] = __builtin_amdgcn_rsqf(t * (1.f / 1024.f) + EPS); }
        }
    }
    __syncthreads();
}

struct Args { const void* in[16]; float* out; unsigned char* ws; double invf[8]; int ph_lo, ph_hi, li, flags; };

__global__ void __launch_bounds__(NTHR, 2) mega_fwd(Args args) {
    extern __shared__ __attribute__((aligned(16))) unsigned char lds[];
    Frame F;
    F.lds = (LAS unsigned char*)lds;
    F.MISC = (volatile LAS unsigned*)(F.lds + MISC_OFF);
    F.tid = threadIdx.x; F.lane = F.tid & 63; F.wave = __builtin_amdgcn_readfirstlane(F.tid >> 6);
    F.G = gridDim.x; { const int bx = blockIdx.x; F.vcu = (F.G % 8 == 0) ? (bx % 8) * (F.G / 8) + bx / 8 : bx; }
    unsigned char* ws = args.ws;
    F.ctl = (gu32*)(ws + WS_CTL);
    const float* x = (const float*)args.in[0]; const int* positions = (const int*)args.in[1]; const float* attn_norm = (const float*)args.in[2];
    const float* w_in = (const float*)args.in[3]; const float* b_gate = (const float*)args.in[4]; const float* w_pool = (const float*)args.in[5];
    const float* pool_scale = (const float*)args.in[6]; const float* q_norm = (const float*)args.in[7]; const float* k_norm = (const float*)args.in[8];
    const float* sinks = (const float*)args.in[9]; const float* w_out = (const float*)args.in[10]; const float* ffn_norm = (const float*)args.in[11];
    const float* w_up = (const float*)args.in[12]; const float* conv_w = (const float*)args.in[13]; const float* conv_b = (const float*)args.in[14];
    const float* w_down = (const float*)args.in[15];
    float* out = args.out;
    float* R1 = (float*)(ws + WS_R1); float* SSQ = (float*)(ws + WS_SSQ); float* TAB = (float*)(ws + WS_TAB);
    bf16_t* Win_t = (bf16_t*)(ws + WS_WIN); bf16_t* Wp_t = (bf16_t*)(ws + WS_WP); bf16_t* Wo_t = (bf16_t*)(ws + WS_WO); bf16_t* Wu_t = (bf16_t*)(ws + WS_WU); bf16_t* Wd_t = (bf16_t*)(ws + WS_WD);
    bf16_t* XB = (bf16_t*)(ws + WS_XB); bf16_t* U = (bf16_t*)(ws + WS_Z); bf16_t* QB = (bf16_t*)(ws + WS_Z + 64 * MiB); bf16_t* KB = (bf16_t*)(ws + WS_Z + 128 * MiB); bf16_t* VB = (bf16_t*)(ws + WS_Z + 136 * MiB); bf16_t* GB = (bf16_t*)(ws + WS_Z + 144 * MiB); float* Y01 = (float*)(ws + WS_Y01); float* HALO = (float*)(ws + WS_HALO); bf16_t* HACT = (bf16_t*)(ws + WS_HACT);
    bf16_t* BO = (bf16_t*)(ws + WS_B); bf16_t* AP = (bf16_t*)(ws + WS_AP);

    for (int u = F.tid; u < (LDS_BYTES - LDSCTL_OFF) / 4; u += NTHR) ((LAS unsigned*)(F.lds + LDSCTL_OFF))[u] = 0u;
    __syncthreads();
    XcdBarrier bar; bar.bar = (unsigned*)(F.ctl + CW_BAR) + args.li * XCD_BAR_WORDS; bar.x = 0; bar.st = nullptr;
    if (MK_N_LAUNCHES == 1) bar = xcd_barrier_post((unsigned*)(F.ctl + CW_BAR) + args.li * XCD_BAR_WORDS, F.MISC + 8);
#define GRID_BAR() do { if (MK_N_LAUNCHES == 1) xcd_barrier(bar); } while (0)
    const int lo = args.ph_lo, hi = args.ph_hi;
#define IN(k) (lo <= (k) && (k) < hi)
#define BOTH(k) (IN(k) && IN((k) + 1))
    const int gt = F.vcu * NTHR + F.tid, GT = F.G * NTHR;
    const int gw = F.vcu * NWAVES + F.wave, NGW = F.G * NWAVES;

    if (IN(0)) {
        LAS float* scr = (LAS float*)(F.lds + F.wave * 16384);
        constexpr int I_IN = (DM / 64) * (NIN / 32);
        for (int it = gw; it < I_IN; it += NGW) p0_transpose_item(w_in, DM, NIN, Win_t, attn_norm, nullptr, scr, it, F.lane);
        for (int m = 4 * gw; m < M; m += 4 * NGW) rows4_bf16_rs(F.lane, x + (size_t)m * DM, XB + (size_t)m * DM, R1 + m);
        for (int idx = gt; idx < M * 8; idx += GT) { const int m = idx >> 3, j = idx & 7;
            double rev = (double)positions[m] * args.invf[j]; rev -= floor(rev); const float fr = (float)rev;
            TAB[(size_t)m * 16 + j] = __builtin_amdgcn_cosf(fr); TAB[(size_t)m * 16 + 8 + j] = __builtin_amdgcn_sinf(fr); }
        if (BOTH(0)) GRID_BAR();
    }
    if (IN(1)) {
        pg8::Gemm g{DM, DM, DM, (size_t)128 * DM * 2, (size_t)32 * DM * 2};
        pg8::TileOrder S; S.init(M / 256, NIN / 256, F.G, (int)blockIdx.x, XB, Win_t, (size_t)256 * DM * 2, (size_t)256 * DM * 2, 0);
        fill_rtab(F, S, R1, nullptr);
        pg8::EpiIn E{(const LAS float*)(F.lds + RTAB_OFF), q_norm, k_norm, b_gate, U, QB, KB, VB, GB, TAB, args.flags};
        pg8::gemm_phase<pg8::EpiIn, pg8::TileOrder, true>(F.lds, g, S, E);
        {
            constexpr int I_P = (256 / 64) * (256 / 32), I_O = (DM / 64) * (DM / 32), I_U = (DM / 64) * (NUP / 32), I_D = (DFF / 64) * (DM / 32), NREST = 4 * I_P + I_O + I_U + I_D;
            const int rem = ((M / 256) * (NIN / 256)) % F.G, sidx = rem ? (int)blockIdx.x - rem : (int)blockIdx.x, nshort = rem ? F.G - rem : F.G;
            if (sidx >= 0) { LAS float* scr = (LAS float*)(F.lds + F.wave * 16384);
                for (int it = sidx * NWAVES + F.wave; it < NREST; it += nshort * NWAVES) { int r = it;
                    if (r < 4 * I_P) { const int gq = r / I_P; p0_transpose_item(w_pool + (size_t)gq * 65536, 256, 256, Wp_t + (size_t)gq * 65536, nullptr, pool_scale + 256 * gq, scr, r % I_P, F.lane); continue; } r -= 4 * I_P;
                    if (r < I_O) { p0_transpose_item(w_out, DM, DM, Wo_t, nullptr, nullptr, scr, r, F.lane); continue; } r -= I_O;
                    if (r < I_U) { p0_transpose_item(w_up, DM, NUP, Wu_t, ffn_norm, nullptr, scr, r, F.lane); continue; } r -= I_U;
                    p0_transpose_item(w_down, DFF, DM, Wd_t, nullptr, nullptr, scr, r, F.lane); } } }
        if (BOTH(1)) GRID_BAR();
    }
    if (IN(2)) {
        bf16_t* P = XB;
        { const int cid = F.vcu;
            const int kvh = cid & 1, pr = (cid >> 1) & 15, b = cid >> 5, pm = b * 16 + pr;
            for (int wi = F.wave; wi < 32; wi += NWAVES) { const int g = 2 * kvh + (wi >> 4), tb = pm * 32 + 2 * (wi & 15) + (F.lane >> 5), ch = 32 * g + (F.lane & 31);
                if (g == 0) pool_prep_item<0>(U, P, tb, ch); else if (g == 1) pool_prep_item<1>(U, P, tb, ch); else if (g == 2) pool_prep_item<2>(U, P, tb, ch); else pool_prep_item<3>(U, P, tb, ch); }
            if (!(args.flags & 4)) attn_phase(F, (b << 6) | (pr << 2) | kvh, 2, 2, QB, DM, KB, 128, VB, 128, TAB, sinks, BO);
            VM_WAIT(); if (F.tid == 0) { __builtin_amdgcn_fence(__ATOMIC_ACQUIRE, "agent"); VM_WAIT(); } __syncthreads();
            pg8::Gemm g{DM, 256, 256, (size_t)128 * DM * 2, (size_t)128 * 256 * 2};
            pg8::PairOrder S{pm, 2 * kvh, (const char*)P, (const char*)Wp_t};
            pg8::EpiMix E{GB, BO, AP};
            pg8::gemm_phase<pg8::EpiMix, pg8::PairOrder, true>(F.lds, g, S, E);
        }
        if (BOTH(2)) GRID_BAR();
    }
    if (IN(6)) {
        pg8::Gemm g{DM, DM, DM, (size_t)128 * DM * 2, (size_t)128 * DM * 2};
        pg8::TileOrder S; S.init(M / 256, DM / 256, F.G, (int)blockIdx.x, AP, Wo_t, (size_t)256 * DM * 2, (size_t)256 * DM * 2, 0);
        pg8::EpiOut1 E{x, out, XB, SSQ};
        pg8::gemm_phase<pg8::EpiOut1, pg8::TileOrder, true>(F.lds, g, S, E);
        if (BOTH(6)) GRID_BAR();
    }
    if (IN(8)) {
        pg8::Gemm g{DM, DM, DM, (size_t)4 * DM * 2, (size_t)DFF * DM * 2};
        pg8::TileOrder S; S.init(M / 256, DFF / 128, F.G, (int)blockIdx.x, XB, Wu_t, (size_t)256 * DM * 2, (size_t)128 * DM * 2, 0);
        fill_rtab(F, S, nullptr, SSQ);
        pg8::EpiConv E{(const LAS float*)(F.lds + RTAB_OFF), conv_w, conv_b, HACT, Y01, HALO, args.flags};
        pg8::gemm_phase<pg8::EpiConv, pg8::TileOrder, true>(F.lds, g, S, E);
        if (BOTH(8)) GRID_BAR();
    }
    if (IN(12)) {
        pg8::Gemm g{DFF, DFF, DFF, (size_t)128 * DFF * 2, (size_t)128 * DFF * 2};
        pg8::TileOrder S; S.init(M / 256, DM / 256, F.G, (int)blockIdx.x, HACT, Wd_t, (size_t)256 * DFF * 2, (size_t)256 * DFF * 2, 0);
        { pg8::Unit fu;
          for (int ui = 0; S.next(ui, fu); ++ui)
            for (int idx = F.tid; idx < 2 * (DFF / 8); idx += NTHR) { const int q = fu.pm * 2 + idx / (DFF / 8), c8 = idx % (DFF / 8);
                if ((q & 31) == 0) continue;
                float y0[16], y1[16];
#pragma unroll
                for (int h = 0; h < 2; ++h)
#pragma unroll
                    for (int v = 0; v < 2; ++v) { const int c = h * DFF + 8 * c8 + 4 * v;
                        const f32x4 a0 = *(const f32x4*)(Y01 + (size_t)(q * 2 + 0) * NUP + c), a1 = *(const f32x4*)(Y01 + (size_t)(q * 2 + 1) * NUP + c);
                        const f32x4 h6 = *(const f32x4*)(HALO + (size_t)((q - 1) * 2 + 0) * NUP + c), h7 = *(const f32x4*)(HALO + (size_t)((q - 1) * 2 + 1) * NUP + c);
                        const f32x4 w0 = *(const f32x4*)(conv_w + c), w1 = *(const f32x4*)(conv_w + NUP + c);
                        const f32x4 r0 = a0 + w1 * h7 + w0 * h6, r1 = a1 + w0 * h7;
#pragma unroll
                        for (int j = 0; j < 4; ++j) { y0[8 * h + 4 * v + j] = r0[j]; y1[8 * h + 4 * v + j] = r1[j]; } }
                float o0[8], o1[8];
#pragma unroll
                for (int j = 0; j < 8; ++j) { o0[j] = y0[j] * sigmoidf_(y0[j]) * y0[8 + j]; o1[j] = y1[j] * sigmoidf_(y1[j]) * y1[8 + j]; }
                *(v4u*)(HACT + (size_t)(q * 128 + 0) * DFF + 8 * c8) = pack8(o0); *(v4u*)(HACT + (size_t)(q * 128 + 1) * DFF + 8 * c8) = pack8(o1); }
          VM_WAIT(); __syncthreads(); }
        pg8::EpiOut2 E{XB, out};
        pg8::gemm_phase<pg8::EpiOut2, pg8::TileOrder, true>(F.lds, g, S, E);
    }
#undef IN
#undef BOTH
}

extern "C" void kernel_launch(void* const* d_in, const int* in_sizes, int n_in, void* d_out, int out_size, void* d_ws, size_t ws_size, hipStream_t stream) {
    static int grid = 0;
    if (grid == 0) {
        if (n_in != 16 || in_sizes[0] != M * DM || out_size != M * DM || ws_size < WS_END) { fprintf(stderr, "kernel_launch: unexpected shapes (n_in %d, in0 %d, out %d, ws %zu); nothing launched\n", n_in, n_in > 0 ? in_sizes[0] : -1, out_size, ws_size); grid = -1; return; }
        int dev = 0, cus = 0, per_cu = 0;
        if (hipGetDevice(&dev) != hipSuccess || hipDeviceGetAttribute(&cus, hipDeviceAttributeMultiprocessorCount, dev) != hipSuccess) { grid = -1; return; }
        if (hipFuncSetAttribute((const void*)mega_fwd, hipFuncAttributeMaxDynamicSharedMemorySize, LDS_BYTES) != hipSuccess) { fprintf(stderr, "kernel_launch: hipFuncSetAttribute failed\n"); grid = -1; return; }
        if (hipOccupancyMaxActiveBlocksPerMultiprocessor(&per_cu, (const void*)mega_fwd, NTHR, LDS_BYTES) != hipSuccess || per_cu < 1) { fprintf(stderr, "kernel_launch: occupancy query reports %d blocks per CU\n", per_cu); (void)hipGetLastError(); grid = -1; return; }
        if (cus < 256) { fprintf(stderr, "kernel_launch: built for a 256-CU device (got %d CUs); nothing launched\n", cus); grid = -1; return; }
        grid = 256;
    }
    if (grid < 0) return;
    if (hipMemsetAsync((char*)d_ws + WS_CTL, 0, CTL_ZERO_BYTES, stream) != hipSuccess) return;
    Args a{};
    for (int i = 0; i < 16; ++i) a.in[i] = d_in[i];
    a.out = (float*)d_out; a.ws = (unsigned char*)d_ws;
    for (int j = 0; j < 8; ++j) a.invf[j] = std::pow(500000.0, -(double)j / 8.0) / 6.283185307179586476925;
#ifdef PROBE_PH
#define PROBE_AFTER 1
#endif
#ifdef PROBE_HI
    a.ph_lo = 0; a.ph_hi = PROBE_HI; a.li = 1; hipLaunchKernelGGL(mega_fwd, dim3(grid), dim3(NTHR), LDS_BYTES, stream, a);
#endif
    if (MK_N_LAUNCHES == 1) { a.ph_lo = 0; a.ph_hi = N_PHASES; a.li = 0; hipLaunchKernelGGL(mega_fwd, dim3(grid), dim3(NTHR), LDS_BYTES, stream, a);
#ifdef PROBE_AFTER
        a.ph_lo = PROBE_PH; a.ph_hi = PROBE_PH + 1; a.li = 1; a.flags = PROBE_FL; hipLaunchKernelGGL(mega_fwd, dim3(grid), dim3(NTHR), LDS_BYTES, stream, a);
#endif
    }
    else for (int p = 0; p < N_PHASES; ++p) { a.ph_lo = p; a.ph_hi = p + 1; a.li = p; hipLaunchKernelGGL(mega_fwd, dim3(grid), dim3(NTHR), LDS_BYTES, stream, a); }
}
```
